# Optimizing an MI355X kernel written in HIP

```python
import math
import jax, jax.numpy as jnp
from jax import lax
import numpy as np

D_MODEL = 1024
BATCH = 16
SEQ = 2048
DEPTH = 4

NORM_EPS = 1e-6
D_FF = 2816
FFN_RES_SCALE = 0.5
CONV_K = 4

SSD_HEADS = 16
SSD_HEAD_DIM = 64
SSD_WIDTH = SSD_HEADS * SSD_HEAD_DIM
SSD_GROUPS = 2
SSD_STATE = 128
SSD_CHUNK = 128
SSD_XBC = SSD_WIDTH + 2 * SSD_GROUPS * SSD_STATE

LRU_WIDTH = 1024
LRU_BLOCKS = 16
LRU_BLOCK_DIM = LRU_WIDTH // LRU_BLOCKS
LRU_C = 8.0

HYB_IN = SSD_WIDTH + SSD_XBC + SSD_HEADS + LRU_WIDTH + LRU_WIDTH
HYB_SPLITS = (SSD_WIDTH,
              SSD_WIDTH + SSD_XBC,
              SSD_WIDTH + SSD_XBC + SSD_HEADS,
              SSD_WIDTH + SSD_XBC + SSD_HEADS + LRU_WIDTH)
HYB_OUT = SSD_WIDTH + LRU_WIDTH

DIFF_HEADS = 8
DIFF_HEAD_DIM = 64
DIFF_WIDTH = DIFF_HEADS * 2 * DIFF_HEAD_DIM
Q_BLOCK = 128
ROPE_THETA = 500000.0
ROT_DIM = DIFF_HEAD_DIM // 4

N_EVEN = (DEPTH + 1) // 2
N_ODD = DEPTH // 2

kernel_name = "hybrid_ssd_rglru_diffattn_macaron"


def rms_norm(x, w, eps=NORM_EPS):
    xf = x.astype(jnp.float32)
    y = xf * lax.rsqrt(jnp.mean(xf * xf, axis=-1, keepdims=True) + eps)
    return (y * w.astype(jnp.float32)).astype(x.dtype)


def swiglu(x, w_gate, w_up, w_down):
    return (jax.nn.silu(x @ w_gate) * (x @ w_up)) @ w_down


def causal_dwconv(x, w, b):
    k = w.shape[0]
    y = lax.conv_general_dilated(x, w[:, None, :].astype(x.dtype), window_strides=(1,),
                                 padding=((k - 1, 0),),
                                 dimension_numbers=('NWC', 'WIO', 'NWC'),
                                 feature_group_count=x.shape[-1])
    return y + b


def ssd_chunked(x, dt, a, bmat, cmat):
    bsz, l, h, p = x.shape
    g, n = bmat.shape[-2:]
    r = h // g
    c = l // SSD_CHUNK
    q = SSD_CHUNK
    xs = (x.astype(jnp.float32) * dt[..., None]).reshape(bsz, c, q, g, r, p)
    bc = bmat.astype(jnp.float32).reshape(bsz, c, q, g, n)
    cc = cmat.astype(jnp.float32).reshape(bsz, c, q, g, n)
    cs = jnp.cumsum((dt * a).reshape(bsz, c, q, g, r), axis=2)
    mask = jnp.tril(jnp.ones((q, q), dtype=bool))[:, :, None, None]
    seg = cs[:, :, :, None] - cs[:, :, None, :]
    decay = jnp.exp(jnp.where(mask, seg, -jnp.inf))
    cb = jnp.einsum('bcign,bcjgn->bcijg', cc, bc)
    y_diag = jnp.einsum('bcijg,bcijgr,bcjgrp->bcigrp', cb, decay, xs)
    decay_to_end = jnp.exp(cs[:, :, -1:] - cs)
    states = jnp.einsum('bcjgn,bcjgr,bcjgrp->bcgrpn', bc, decay_to_end, xs)
    chunk_decay = jnp.exp(cs[:, :, -1])

    def step(s, inp):
        st, dec = inp
        return s * dec[..., None, None] + st, s

    s0 = jnp.zeros((bsz, g, r, p, n), jnp.float32)
    _, prev = lax.scan(step, s0, (jnp.swapaxes(states, 0, 1), jnp.swapaxes(chunk_decay, 0, 1)))
    prev = jnp.swapaxes(prev, 0, 1)
    y_off = jnp.einsum('bcign,bcgrpn,bcigr->bcigrp', cc, prev, jnp.exp(cs))
    return (y_diag + y_off).reshape(bsz, l, h, p)


def ssd_mixer(z, xbc, dt_raw, conv_w, conv_b, dt_bias, a_log, d_skip, norm_w):
    bsz, l, _ = xbc.shape
    xbc = jax.nn.silu(causal_dwconv(xbc, conv_w, conv_b))
    xa = xbc[..., :SSD_WIDTH].reshape(bsz, l, SSD_HEADS, SSD_HEAD_DIM)
    bm = xbc[..., SSD_WIDTH:SSD_WIDTH + SSD_GROUPS * SSD_STATE].reshape(bsz, l, SSD_GROUPS, SSD_STATE)
    cm = xbc[..., SSD_WIDTH + SSD_GROUPS * SSD_STATE:].reshape(bsz, l, SSD_GROUPS, SSD_STATE)
    dt = jax.nn.softplus(dt_raw.astype(jnp.float32) + dt_bias.astype(jnp.float32))
    a = -jnp.exp(a_log.astype(jnp.float32))
    y = ssd_chunked(xa, dt, a, bm, cm)
    y = y + d_skip.astype(jnp.float32)[:, None] * xa.astype(jnp.float32)
    y = y.reshape(bsz, l, SSD_WIDTH).astype(z.dtype)
    yg = (y * jax.nn.silu(z)).reshape(bsz, l, SSD_GROUPS, SSD_WIDTH // SSD_GROUPS)
    yg = rms_norm(yg, norm_w.reshape(SSD_GROUPS, SSD_WIDTH // SSD_GROUPS))
    return yg.reshape(bsz, l, SSD_WIDTH)


def rglru_mixer(gate, xb, conv_w, conv_b, w_ra, b_ra, w_ix, b_ix, lam):
    bsz, l, d = xb.shape
    xb = causal_dwconv(xb, conv_w, conv_b)
    xh = xb.reshape(bsz, l, LRU_BLOCKS, LRU_BLOCK_DIM)
    r_t = jax.nn.sigmoid(jnp.einsum('blhi,hij->blhj', xh, w_ra).reshape(bsz, l, d) + b_ra)
    i_t = jax.nn.sigmoid(jnp.einsum('blhi,hij->blhj', xh, w_ix).reshape(bsz, l, d) + b_ix)
    log_a = -LRU_C * r_t.astype(jnp.float32) * jax.nn.softplus(-lam.astype(jnp.float32))
    a_t = jnp.exp(log_a)
    mult = jnp.sqrt(-jnp.expm1(2.0 * log_a))
    u = mult * (i_t * xb).astype(jnp.float32)

    def combine(left, right):
        a1, b1 = left
        a2, b2 = right
        return a1 * a2, a2 * b1 + b2

    _, h = lax.associative_scan(combine, (a_t, u), axis=1)
    return jax.nn.gelu(gate) * h.astype(gate.dtype)


def rope_tables(seq):
    inv = ROPE_THETA ** (-jnp.arange(0, ROT_DIM, 2, dtype=jnp.float32) / ROT_DIM)
    ang = jnp.arange(seq, dtype=jnp.float32)[:, None] * inv[None, :]
    return jnp.cos(ang), jnp.sin(ang)


def apply_partial_rope(t, cos, sin):
    half = ROT_DIM // 2
    c = cos[None, :, None, None, :].astype(t.dtype)
    s = sin[None, :, None, None, :].astype(t.dtype)
    t1, t2, rest = t[..., :half], t[..., half:ROT_DIM], t[..., ROT_DIM:]
    return jnp.concatenate([t1 * c - t2 * s, t2 * c + t1 * s, rest], axis=-1)


def diff_attention(h, w_qkv, lq1, lk1, lq2, lk2, subln_w, w_o, lambda_init, cos, sin):
    bsz, s, _ = h.shape
    q, k, v = jnp.split(h @ w_qkv, 3, axis=-1)
    q = apply_partial_rope(q.reshape(bsz, s, DIFF_HEADS, 2, DIFF_HEAD_DIM), cos, sin) * (DIFF_HEAD_DIM ** -0.5)
    k = apply_partial_rope(k.reshape(bsz, s, DIFF_HEADS, 2, DIFF_HEAD_DIM), cos, sin)
    v = v.reshape(bsz, s, DIFF_HEADS, 2 * DIFF_HEAD_DIM)
    lam = (jnp.exp(jnp.sum(lq1.astype(jnp.float32) * lk1.astype(jnp.float32)))
           - jnp.exp(jnp.sum(lq2.astype(jnp.float32) * lk2.astype(jnp.float32))) + lambda_init)
    outs = []
    for qb in range(s // Q_BLOCK):
        lo = qb * Q_BLOCK
        hi = lo + Q_BLOCK
        scores = jnp.einsum('bqhcd,bkhcd->bhcqk', q[:, lo:hi], k[:, :hi]).astype(jnp.float32)
        mask = (lo + jnp.arange(Q_BLOCK))[:, None] >= jnp.arange(hi)[None, :]
        p = jax.nn.softmax(jnp.where(mask, scores, -jnp.inf), axis=-1)
        attn = p[:, :, 0] - lam * p[:, :, 1]
        outs.append(jnp.einsum('bhqk,bkhe->bqhe', attn.astype(v.dtype), v[:, :hi]))
    o = jnp.concatenate(outs, axis=1)
    o = rms_norm(o, subln_w) * (1.0 - lambda_init)
    return o.reshape(bsz, s, DIFF_WIDTH) @ w_o


def setup_inputs(seed: int = 0) -> dict:
    key = jax.random.key(seed)
    ks = iter(jax.random.split(key, 64))

    def normal(shape, scale):
        return scale * jax.random.normal(next(ks), shape, jnp.float32)

    def gain(shape):
        return 1.0 + normal(shape, 0.02)

    def uniform(shape, lo, hi):
        return jax.random.uniform(next(ks), shape, jnp.float32, lo, hi)

    dt0 = jnp.exp(uniform((N_EVEN, SSD_HEADS), math.log(1e-3), math.log(1e-1)))
    a_pow = uniform((N_EVEN, LRU_WIDTH), 0.9, 0.999)
    a_base = a_pow ** (1.0 / LRU_C)
    return {
        "x": normal((BATCH, SEQ, D_MODEL), 1.0),
        "norm_ff1": gain((DEPTH, D_MODEL)),
        "ffn1_gate": normal((DEPTH, D_MODEL, D_FF), D_MODEL ** -0.5),
        "ffn1_up": normal((DEPTH, D_MODEL, D_FF), D_MODEL ** -0.5),
        "ffn1_down": normal((DEPTH, D_FF, D_MODEL), D_FF ** -0.5),
        "norm_mix": gain((DEPTH, D_MODEL)),
        "norm_ff2": gain((DEPTH, D_MODEL)),
        "ffn2_gate": normal((DEPTH, D_MODEL, D_FF), D_MODEL ** -0.5),
        "ffn2_up": normal((DEPTH, D_MODEL, D_FF), D_MODEL ** -0.5),
        "ffn2_down": normal((DEPTH, D_FF, D_MODEL), D_FF ** -0.5),
        "hyb_w_in": normal((N_EVEN, D_MODEL, HYB_IN), D_MODEL ** -0.5),
        "ssd_conv_w": normal((N_EVEN, CONV_K, SSD_XBC), CONV_K ** -0.5),
        "ssd_conv_b": normal((N_EVEN, SSD_XBC), 0.02),
        "ssd_dt_bias": dt0 + jnp.log(-jnp.expm1(-dt0)),
        "ssd_a_log": jnp.log(uniform((N_EVEN, SSD_HEADS), 1.0, 16.0)),
        "ssd_d": gain((N_EVEN, SSD_HEADS)),
        "ssd_norm": gain((N_EVEN, SSD_WIDTH)),
        "lru_conv_w": normal((N_EVEN, CONV_K, LRU_WIDTH), CONV_K ** -0.5),
        "lru_conv_b": normal((N_EVEN, LRU_WIDTH), 0.02),
        "lru_w_ra": normal((N_EVEN, LRU_BLOCKS, LRU_BLOCK_DIM, LRU_BLOCK_DIM), LRU_BLOCK_DIM ** -0.5),
        "lru_b_ra": normal((N_EVEN, LRU_WIDTH), 0.02),
        "lru_w_ix": normal((N_EVEN, LRU_BLOCKS, LRU_BLOCK_DIM, LRU_BLOCK_DIM), LRU_BLOCK_DIM ** -0.5),
        "lru_b_ix": normal((N_EVEN, LRU_WIDTH), 0.02),
        "lru_lambda": jnp.log(a_base / (1.0 - a_base)),
        "hyb_w_out": normal((N_EVEN, HYB_OUT, D_MODEL), HYB_OUT ** -0.5),
        "dif_w_qkv": normal((N_ODD, D_MODEL, 3 * DIFF_WIDTH), D_MODEL ** -0.5),
        "dif_lq1": normal((N_ODD, DIFF_HEAD_DIM), 0.1),
        "dif_lk1": normal((N_ODD, DIFF_HEAD_DIM), 0.1),
        "dif_lq2": normal((N_ODD, DIFF_HEAD_DIM), 0.1),
        "dif_lk2": normal((N_ODD, DIFF_HEAD_DIM), 0.1),
        "dif_subln": gain((N_ODD, 2 * DIFF_HEAD_DIM)),
        "dif_w_o": normal((N_ODD, DIFF_WIDTH, D_MODEL), DIFF_WIDTH ** -0.5),
        "final_norm": gain((D_MODEL,)),
    }


def reference(x, norm_ff1, ffn1_gate, ffn1_up, ffn1_down, norm_mix, norm_ff2, ffn2_gate, ffn2_up, ffn2_down,
              hyb_w_in, ssd_conv_w, ssd_conv_b, ssd_dt_bias, ssd_a_log, ssd_d, ssd_norm,
              lru_conv_w, lru_conv_b, lru_w_ra, lru_b_ra, lru_w_ix, lru_b_ix, lru_lambda, hyb_w_out,
              dif_w_qkv, dif_lq1, dif_lk1, dif_lq2, dif_lk2, dif_subln, dif_w_o, final_norm):
    cos, sin = rope_tables(x.shape[1])
    h = x
    for i in range(DEPTH):
        j = i // 2
        h = h + FFN_RES_SCALE * swiglu(rms_norm(h, norm_ff1[i]), ffn1_gate[i], ffn1_up[i], ffn1_down[i])
        hn = rms_norm(h, norm_mix[i])
        if i % 2 == 0:
            z, xbc, dt_raw, gate_b, x_b = jnp.split(hn @ hyb_w_in[j], HYB_SPLITS, axis=-1)
            y_a = ssd_mixer(z, xbc, dt_raw, ssd_conv_w[j], ssd_conv_b[j], ssd_dt_bias[j],
                            ssd_a_log[j], ssd_d[j], ssd_norm[j])
            y_b = rglru_mixer(gate_b, x_b, lru_conv_w[j], lru_conv_b[j], lru_w_ra[j], lru_b_ra[j],
                              lru_w_ix[j], lru_b_ix[j], lru_lambda[j])
            h = h + jnp.concatenate([y_a, y_b], axis=-1) @ hyb_w_out[j]
        else:
            lambda_init = 0.8 - 0.6 * math.exp(-0.3 * i)
            h = h + diff_attention(hn, dif_w_qkv[j], dif_lq1[j], dif_lk1[j], dif_lq2[j], dif_lk2[j],
                                   dif_subln[j], dif_w_o[j], lambda_init, cos, sin)
        h = h + FFN_RES_SCALE * swiglu(rms_norm(h, norm_ff2[i]), ffn2_gate[i], ffn2_up[i], ffn2_down[i])
    return rms_norm(h, final_norm)
```

```cpp
#define RESID_LO 0
#include <hip/hip_runtime.h>
#include <hip/hip_cooperative_groups.h>
#include <hip/hip_bf16.h>
#include <cstdio>
#include <cstdint>
#include <cmath>
namespace cg = cooperative_groups;
namespace pg8 {
#define PG8_LAS __attribute__((address_space(3)))
typedef unsigned short bf16_t;
typedef short bf16x8 __attribute__((ext_vector_type(8)));
typedef float f32x4 __attribute__((ext_vector_type(4)));
typedef unsigned u32x4 __attribute__((ext_vector_type(4)));
constexpr int BM = 256, BK = 64, HALF = 128, HTB = HALF * BK * 2  , STAGE_BYTES = 8 * HTB, NXCD = 8, WGM = 8;

__host__ __device__ __forceinline__ int lds_byte(int r, int c) { const int st = (r >> 4) * 2 + (c >> 5), rr = r & 15, cc = c & 31, ob = rr * 64 + cc * 2; return st * 1024 + (ob ^ (((ob >> 9) & 1) << 5)); }
__host__ __device__ __forceinline__ void stage_rc(int b, int& R, int& C) { const int st = b / 1024, sb = b % 1024, swz = sb ^ (((sb >> 9) & 1) << 5); R = (st >> 1) * 16 + swz / 64; C = (st & 1) * 32 + (swz % 64) / 2; }
__host__ __device__ __forceinline__ int perm32(int rho) { const int n = rho >> 4, i = rho & 15; return 8 * (i >> 2) + 4 * n + (i & 3); }

struct Unit { int pm, pn; };
struct Gemm { const bf16_t* A; const bf16_t* Bt; int M, N, K, lda; };

struct StaticOrder {
    int nM, nN, nwg, G, c;
    __host__ __device__ void init(int M, int N, int G_, int c_) { nM = M / BM; nN = N / BM; nwg = nM * nN; G = G_; c = c_; }
    __host__ __device__ bool next(int i, Unit& u) const {
        const long L = (long)i * G + c; if (L >= nwg) return false;
        int wgid = (int)L; { const int q = nwg / NXCD, r = nwg % NXCD, xcd = wgid % NXCD, off = wgid / NXCD; wgid = (xcd < r ? xcd * (q + 1) : r * (q + 1) + (xcd - r) * q) + off; }
        const int nig = WGM * nN, gid = wgid / nig, fm = gid * WGM, gsz = (nM - fm) < WGM ? (nM - fm) : WGM;
        u.pm = fm + ((wgid % nig) % gsz); u.pn = (wgid % nig) / gsz; return true;
    }
    __device__ __forceinline__ void a_ready(const Unit&) const {}
    __device__ __forceinline__ void done(const Unit&) const {}
};

__device__ __forceinline__ unsigned cvt_pk_bf16(float lo, float hi) { unsigned r; asm volatile("v_cvt_pk_bf16_f32 %0, %1, %2" : "=v"(r) : "v"(lo), "v"(hi)); return r; }
typedef float f32x2 __attribute__((ext_vector_type(2)));
template <class Epi, class Sched, bool ALIGN_EPI = false, bool SP2 = false, int KC = 0, int LDAC = 0>
__device__ __forceinline__ void gemm_phase(PG8_LAS unsigned char* lds, const Gemm g, const Sched& S, const Epi& E) {
    int tid_ = threadIdx.x; asm volatile("" : "+v"(tid_));
    const int tid = tid_, wid = __builtin_amdgcn_readfirstlane(tid >> 6), lane = tid & 63, wr = wid >> 2, wc = wid & 3, fr = lane & 15, fq = lane >> 4;
    const int K = KC ? KC : g.K, nt = K / BK, LDA = LDAC ? LDAC : g.lda;
    unsigned voffA[2], voffB[2];
#pragma unroll
    for (int i = 0; i < 2; ++i) { int R, C; stage_rc(tid * 16 + i * 8192, R, C); const int Rb = Epi::PERM ? ((R & ~31) + perm32(R & 31)) : R;
        voffA[i] = (unsigned)(R * LDA + C) * 2u; voffB[i] = (unsigned)(Rb * K + C) * 2u; }
    const size_t kstep = (size_t)(BK * 2);
    const size_t hstep = (size_t)HALF * K * 2;
    const size_t tstep = 2 * hstep; const size_t hstepA = (size_t)HALF * LDA * 2, tstepA = 2 * hstepA;
    const unsigned ldsw = (unsigned)wid * 1024u;
    const int aoff = lds_byte(wr * 64 + fr, fq * 8), boff = lds_byte(wc * 32 + fr, fq * 8);
#define PG8_SA(b, h) (((b) * 2 + (h)) * HTB)
#define PG8_SB(b, h) ((4 + (b) * 2 + (h)) * HTB)
#define PG8_STAGE(bufoff, gbase, voff) do { _Pragma("unroll") for (int _i = 0; _i < 2; ++_i) \
        __builtin_amdgcn_global_load_lds((const unsigned*)((const char*)(gbase) + (voff)[_i]), (PG8_LAS unsigned*)(lds + (bufoff) + ldsw + _i * 8192), 16, 0, 0); } while (0)
#define PG8_LDA(dst, b, h) do { _Pragma("unroll") for (int m = 0; m < 4; ++m) _Pragma("unroll") for (int k = 0; k < 2; ++k) dst[m][k] = *(const PG8_LAS bf16x8*)(lds + PG8_SA(b, h) + aoff + m * 2048 + k * 1024); } while (0)
#define PG8_LDB(dst, b, h) do { _Pragma("unroll") for (int n = 0; n < 2; ++n) _Pragma("unroll") for (int k = 0; k < 2; ++k) dst[n][k] = *(const PG8_LAS bf16x8*)(lds + PG8_SB(b, h) + boff + n * 2048 + k * 1024); } while (0)
#define PG8_MMA(ai, bj, At, Bt) do { __builtin_amdgcn_s_setprio(1); _Pragma("unroll") for (int m = 0; m < 4; ++m) _Pragma("unroll") for (int n = 0; n < 2; ++n) _Pragma("unroll") for (int k = 0; k < 2; ++k) \
        acc[ai][bj][m][n] = __builtin_amdgcn_mfma_f32_16x16x32_bf16(Bt[n][k], At[m][k], acc[ai][bj][m][n], 0, 0, 0); __builtin_amdgcn_s_setprio(0); } while (0)
#define PG8_WAIT_V(n) asm volatile("s_waitcnt vmcnt(" #n ")" ::: "memory")
#define PG8_WAIT_L(n) asm volatile("s_waitcnt lgkmcnt(" #n ")" ::: "memory")
#define PG8_BAR __builtin_amdgcn_s_barrier()
#define PG8_SCHED __builtin_amdgcn_sched_barrier(0)
    Unit cur, nxt; int ui = 0;
    if (!S.next(0, cur)) return;
    f32x4 acc[2][2][4][2];
#pragma unroll
    for (int a = 0; a < 2; ++a)
#pragma unroll
        for (int b = 0; b < 2; ++b)
#pragma unroll
            for (int m = 0; m < 4; ++m)
#pragma unroll
                for (int n = 0; n < 2; ++n) acc[a][b][m][n] = (f32x4){0.f, 0.f, 0.f, 0.f};
    bf16x8 At[4][2], B0[2][2], B1[2][2];
    const char* cA = (const char*)g.A + (size_t)cur.pm * tstepA; const char* cB = (const char*)g.Bt + (size_t)cur.pn * tstep;
    S.a_ready(cur);
    if constexpr (SP2) {
        PG8_STAGE(PG8_SB(0, 0), cB, voffB); PG8_STAGE(PG8_SB(0, 1), cB + hstep, voffB); PG8_STAGE(PG8_SA(0, 0), cA, voffA); PG8_STAGE(PG8_SA(0, 1), cA + hstepA, voffA);
        if (wr == 1) PG8_BAR;
        PG8_WAIT_V(2); PG8_BAR;
        PG8_STAGE(PG8_SB(1, 0), cB + kstep, voffB); PG8_STAGE(PG8_SA(1, 0), cA + kstep, voffA); PG8_STAGE(PG8_SB(1, 1), cB + hstep + kstep, voffB);
        PG8_WAIT_V(6); PG8_BAR;
    } else {
        PG8_STAGE(PG8_SB(0, 0), cB, voffB); PG8_STAGE(PG8_SA(0, 0), cA, voffA); PG8_STAGE(PG8_SB(0, 1), cB + hstep, voffB); PG8_STAGE(PG8_SA(0, 1), cA + hstepA, voffA);
        if (wr == 1) PG8_BAR;
        PG8_WAIT_V(4); PG8_BAR;
        PG8_STAGE(PG8_SB(1, 0), cB + kstep, voffB); PG8_STAGE(PG8_SA(1, 0), cA + kstep, voffA); PG8_STAGE(PG8_SB(1, 1), cB + hstep + kstep, voffB);
        PG8_WAIT_V(6); PG8_BAR;
    }
    for (;;) {
        const bool has_next = S.next(ui + 1, nxt);
        const char* nA = has_next ? (const char*)g.A + (size_t)nxt.pm * tstepA : cA; const char* nB = has_next ? (const char*)g.Bt + (size_t)nxt.pn * tstep : cB;
        for (int t = 0; t < nt; t += 2) {
            const bool last = (t == nt - 2);
            const char* a1 = cA + (size_t)(t + 1) * kstep;
            const char* a2 = last ? nA : cA + (size_t)(t + 2) * kstep; const char* b2 = last ? nB : cB + (size_t)(t + 2) * kstep;
            const char* a3 = a2 + kstep; const char* b3 = b2 + kstep;
            if (last && has_next) S.a_ready(nxt);
            if constexpr (SP2) {
            PG8_LDB(B0, 0, 0); PG8_LDB(B1, 0, 1); PG8_SCHED; PG8_LDA(At, 0, 0); PG8_STAGE(PG8_SA(1, 1), a1 + hstepA, voffA);
            PG8_WAIT_V(8); PG8_WAIT_L(0); PG8_BAR; PG8_MMA(0, 0, At, B0); PG8_MMA(0, 1, At, B1); PG8_BAR; PG8_SCHED;
            PG8_LDA(At, 0, 1); PG8_STAGE(PG8_SB(0, 0), b2, voffB); PG8_STAGE(PG8_SB(0, 1), b2 + hstep, voffB); PG8_STAGE(PG8_SA(0, 0), a2, voffA);
            PG8_WAIT_V(8); PG8_WAIT_L(0); PG8_BAR; PG8_MMA(1, 0, At, B0); PG8_MMA(1, 1, At, B1); PG8_BAR; PG8_SCHED;
            PG8_LDB(B0, 1, 0); PG8_LDB(B1, 1, 1); PG8_SCHED; PG8_LDA(At, 1, 0); PG8_STAGE(PG8_SA(0, 1), a2 + hstepA, voffA);
            PG8_WAIT_V(8); PG8_WAIT_L(0); PG8_BAR; PG8_MMA(0, 0, At, B0); PG8_MMA(0, 1, At, B1); PG8_BAR; PG8_SCHED;
            PG8_LDA(At, 1, 1); PG8_STAGE(PG8_SB(1, 0), b3, voffB); PG8_STAGE(PG8_SB(1, 1), b3 + hstep, voffB); PG8_STAGE(PG8_SA(1, 0), a3, voffA);
            PG8_WAIT_V(8); PG8_WAIT_L(0); PG8_BAR; PG8_MMA(1, 0, At, B0); PG8_MMA(1, 1, At, B1); PG8_BAR; PG8_SCHED;
            } else {
            PG8_LDB(B0, 0, 0); PG8_SCHED; PG8_LDA(At, 0, 0); PG8_STAGE(PG8_SA(1, 1), a1 + hstepA, voffA);
            PG8_WAIT_L(8); PG8_BAR; PG8_WAIT_L(0); PG8_MMA(0, 0, At, B0); PG8_BAR; PG8_SCHED;
            PG8_LDB(B1, 0, 1); PG8_STAGE(PG8_SB(0, 0), b2, voffB);
            PG8_BAR; PG8_WAIT_L(0); PG8_MMA(0, 1, At, B1); PG8_BAR;
            PG8_LDA(At, 0, 1); PG8_STAGE(PG8_SA(0, 0), a2, voffA);
            PG8_BAR; PG8_WAIT_L(0); PG8_MMA(1, 0, At, B0); PG8_BAR; PG8_SCHED;
            PG8_STAGE(PG8_SB(0, 1), b2 + hstep, voffB);
            PG8_WAIT_V(6); PG8_BAR; PG8_MMA(1, 1, At, B1); PG8_BAR;
            PG8_LDB(B0, 1, 0); PG8_SCHED; PG8_LDA(At, 1, 0); PG8_STAGE(PG8_SA(0, 1), a2 + hstepA, voffA);
            PG8_WAIT_L(8); PG8_BAR; PG8_WAIT_L(0); PG8_MMA(0, 0, At, B0); PG8_BAR; PG8_SCHED;
            PG8_LDB(B1, 1, 1); PG8_STAGE(PG8_SB(1, 0), b3, voffB);
            PG8_BAR; PG8_WAIT_L(0); PG8_MMA(0, 1, At, B1); PG8_BAR;
            PG8_LDA(At, 1, 1); PG8_STAGE(PG8_SA(1, 0), a3, voffA);
            PG8_BAR; PG8_WAIT_L(0); PG8_MMA(1, 0, At, B0); PG8_BAR; PG8_SCHED;
            PG8_STAGE(PG8_SB(1, 1), b3 + hstep, voffB);
            PG8_WAIT_V(6); PG8_BAR; PG8_MMA(1, 1, At, B1); PG8_BAR;
            }
        }
        if constexpr (ALIGN_EPI) { if (wr == 0) PG8_BAR; }
        if constexpr (!Epi::AFTER_DRAIN) { E(acc, cur, wr, wc, fr, fq); S.done(cur); }
        if (!has_next) break;
#pragma unroll
        for (int a = 0; a < 2; ++a)
#pragma unroll
            for (int b = 0; b < 2; ++b)
#pragma unroll
                for (int m = 0; m < 4; ++m)
#pragma unroll
                    for (int n = 0; n < 2; ++n) acc[a][b][m][n] = (f32x4){0.f, 0.f, 0.f, 0.f};
        cur = nxt; cA = nA; cB = nB; ++ui;
        if constexpr (ALIGN_EPI) { if (wr == 1) PG8_BAR; }
    }
    PG8_WAIT_V(0);
    if constexpr (!ALIGN_EPI) { if (wr == 0) PG8_BAR; }
    PG8_BAR;
    if constexpr (Epi::AFTER_DRAIN) { E.fused(acc, cur, wr, wc, fr, fq, lds, wid, lane); S.done(cur); }
#undef PG8_SA
#undef PG8_SB
#undef PG8_STAGE
#undef PG8_LDA
#undef PG8_LDB
#undef PG8_MMA
#undef PG8_WAIT_V
#undef PG8_WAIT_L
#undef PG8_BAR
#undef PG8_SCHED
}
}
namespace pg8 {
constexpr float NORM_EPS = 1e-6f;
#define PG8_GAS __attribute__((address_space(1)))
typedef PG8_GAS f32x4 gf32x4; typedef PG8_GAS u32x4 gu32x4; typedef PG8_GAS float gfloat;
__device__ __forceinline__ float rstd_of(const float* rowss, int row) { const gf32x4* p = (const gf32x4*)(rowss + (size_t)row * 16); const f32x4 a = p[0], b = p[1], c = p[2], d = p[3];
    const float s = (((a[0] + a[1]) + (a[2] + a[3])) + ((b[0] + b[1]) + (b[2] + b[3]))) + (((c[0] + c[1]) + (c[2] + c[3])) + ((d[0] + d[1]) + (d[2] + d[3]))); return __builtin_amdgcn_rsqf(s * (1.0f / 1024.0f) + NORM_EPS); }
struct RstdTab {
    int p0, p1, p2, p3; const PG8_LAS float* tab; const float* rowss;
    __device__ __forceinline__ float get(int pm, int row) const {
        if (pm == p0) return tab[(row & 255)]; if (pm == p1) return tab[256 + (row & 255)]; if (pm == p2) return tab[512 + (row & 255)]; if (pm == p3) return tab[768 + (row & 255)];
        return rstd_of(rowss, row); }
};
template <class Sched> __device__ __forceinline__ RstdTab build_rstd(PG8_LAS unsigned char* lds_free, const float* rowss, const Sched& S) {
    RstdTab t; t.p0 = t.p1 = t.p2 = t.p3 = -1; t.tab = (const PG8_LAS float*)lds_free; t.rowss = rowss;
    Unit u;
    for (int i = 0; S.next(i, u); ++i) { const int pm = u.pm;
        if (pm != t.p0 && pm != t.p1 && pm != t.p2 && pm != t.p3) { if (t.p0 < 0) t.p0 = pm; else if (t.p1 < 0) t.p1 = pm; else if (t.p2 < 0) t.p2 = pm; else if (t.p3 < 0) t.p3 = pm; } }
    int tid_ = threadIdx.x; asm volatile("" : "+v"(tid_));
    for (int e = tid_; e < 1024; e += 512) { const int k = e >> 8, r = e & 255; const int pm = (k == 0) ? t.p0 : (k == 1) ? t.p1 : (k == 2) ? t.p2 : t.p3;
        if (pm >= 0) ((PG8_LAS float*)lds_free)[e] = rstd_of(rowss, pm * 256 + r); }
    asm volatile("s_waitcnt vmcnt(0) lgkmcnt(0)" ::: "memory"); __builtin_amdgcn_s_barrier(); asm volatile("" ::: "memory");
    return t;
}
__device__ __forceinline__ float silu_f(float x) { return x * __builtin_amdgcn_rcpf(1.0f + __expf(-x)); }
struct EpiSwiglu {
    static constexpr bool PERM = true, AFTER_DRAIN = false;
    bf16_t* O; RstdTab rt;
    __device__ __forceinline__ void operator()(const f32x4 (&acc)[2][2][4][2], const Unit& u, int wr, int wc, int fr, int fq) const {
        const int row0 = u.pm * BM + wr * 64 + fr, col0 = u.pn * 128 + wc * 32 + 8 * fq;
#pragma unroll
        for (int ai = 0; ai < 2; ++ai)
#pragma unroll
            for (int m = 0; m < 4; ++m) { const int row = row0 + ai * HALF + m * 16; const float rs = rt.get(u.pm, row);
                float o[8];
#pragma unroll
                for (int n = 0; n < 2; ++n)
#pragma unroll
                    for (int j = 0; j < 4; ++j) { const float g = acc[ai][0][m][n][j] * rs, up = acc[ai][1][m][n][j] * rs; o[n * 4 + j] = silu_f(g) * up; }
                u32x4 w; w.x = cvt_pk_bf16(o[0], o[1]); w.y = cvt_pk_bf16(o[2], o[3]); w.z = cvt_pk_bf16(o[4], o[5]); w.w = cvt_pk_bf16(o[6], o[7]);
                *(gu32x4*)(O + (size_t)row * 2816 + col0) = w; }
    }
};
#ifndef RESID_LO
#define RESID_LO 1
#endif
struct EpiResid {
    static constexpr bool PERM = true, AFTER_DRAIN = false;
    bf16_t* HB; unsigned* LO; float* rowss_next; float scale;
    static __device__ __forceinline__ float dec_lo(unsigned hw, unsigned nib) { return __uint_as_float(((hw << 16) | (nib << 12)) - (RESID_LO ? 0x7800u : 0u)); }
    static __device__ __forceinline__ float dec_hi(unsigned hw, unsigned nib) { return __uint_as_float(((hw & 0xffff0000u) | (nib << 12)) - (RESID_LO ? 0x7800u : 0u)); }
    static __device__ __forceinline__ unsigned enc(float h) { return __float_as_uint(h) + 0x8000u; }
    static __device__ __forceinline__ void dec8(const u32x4 hb, const unsigned lq, float (&f)[8]) {
        f[0] = dec_lo(hb.x, lq & 0xfu); f[1] = dec_hi(hb.x, (lq >> 4) & 0xfu); f[2] = dec_lo(hb.y, (lq >> 8) & 0xfu); f[3] = dec_hi(hb.y, (lq >> 12) & 0xfu);
        f[4] = dec_lo(hb.z, (lq >> 16) & 0xfu); f[5] = dec_hi(hb.z, (lq >> 20) & 0xfu); f[6] = dec_lo(hb.w, (lq >> 24) & 0xfu); f[7] = dec_hi(hb.w, lq >> 28);
    }
    static __device__ __forceinline__ unsigned nib8(const unsigned (&e)[8]) {
        return ((e[0] >> 12) & 0xfu) | ((e[1] >> 8) & 0xf0u) | ((e[2] >> 4) & 0xf00u) | (e[3] & 0xf000u) | ((e[4] << 4) & 0xf0000u) | ((e[5] << 8) & 0xf00000u) | ((e[6] << 12) & 0xf000000u) | ((e[7] << 16) & 0xf0000000u);
    }
    __device__ __forceinline__ void operator()(const f32x4 (&acc)[2][2][4][2], const Unit& u, int wr, int wc, int fr, int fq) const {
        const int row0 = u.pm * BM + wr * 64 + fr, col0 = u.pn * BM + wc * 32 + 8 * fq;
#pragma unroll
        for (int ai = 0; ai < 2; ++ai)
#pragma unroll
            for (int m = 0; m < 4; ++m) { const int row = row0 + ai * HALF + m * 16; bf16_t* bp = HB + (size_t)row * 1024 + col0; unsigned* lp = LO + (size_t)row * 128 + (col0 >> 3); float ss = 0.f;
#pragma unroll
                for (int bj = 0; bj < 2; ++bj) { const u32x4 old = *(const gu32x4*)(bp + bj * HALF);
#if RESID_LO
                    const unsigned lq = lp[bj * (HALF / 8)];
#else
                    const unsigned lq = 0u;
#endif
                    float h[8]; dec8(old, lq, h);
#pragma unroll
                    for (int j = 0; j < 4; ++j) { h[j] += acc[ai][bj][m][0][j] * scale; h[4 + j] += acc[ai][bj][m][1][j] * scale; }
#pragma unroll
                    for (int j = 0; j < 8; ++j) ss += h[j] * h[j];
#if RESID_LO
                    unsigned e[8];
#pragma unroll
                    for (int j = 0; j < 8; ++j) e[j] = enc(h[j]);
                    u32x4 w; w.x = (e[0] >> 16) | (e[1] & 0xffff0000u); w.y = (e[2] >> 16) | (e[3] & 0xffff0000u); w.z = (e[4] >> 16) | (e[5] & 0xffff0000u); w.w = (e[6] >> 16) | (e[7] & 0xffff0000u);
                    *(u32x4*)(bp + bj * HALF) = w;
                    lp[bj * (HALF / 8)] = nib8(e);
#else
                    u32x4 w; w.x = cvt_pk_bf16(h[0], h[1]); w.y = cvt_pk_bf16(h[2], h[3]); w.z = cvt_pk_bf16(h[4], h[5]); w.w = cvt_pk_bf16(h[6], h[7]);
                    *(gu32x4*)(bp + bj * HALF) = w;
#endif
                }
                ss += __shfl_xor(ss, 16); ss += __shfl_xor(ss, 32);
                if (fq == 0) ((gfloat*)rowss_next)[(size_t)row * 16 + u.pn * 4 + wc] = ss; }
    }
};
struct EpiProj {
    static constexpr bool PERM = true, AFTER_DRAIN = false;
    bf16_t* P; float* DT; RstdTab rt;
    __device__ __forceinline__ void operator()(const f32x4 (&acc)[2][2][4][2], const Unit& u, int wr, int wc, int fr, int fq) const {
        const int row0 = u.pm * BM + wr * 64 + fr, col0 = u.pn * BM + wc * 32 + 8 * fq;
#pragma unroll
        for (int ai = 0; ai < 2; ++ai)
#pragma unroll
            for (int m = 0; m < 4; ++m) { const int row = row0 + ai * HALF + m * 16; const float rs = rt.get(u.pm, row);
                if (u.pn < 18) {
#pragma unroll
                    for (int bj = 0; bj < 2; ++bj) { const f32x4 v0 = acc[ai][bj][m][0] * rs, v1 = acc[ai][bj][m][1] * rs;
                        u32x4 w; w.x = cvt_pk_bf16(v0[0], v0[1]); w.y = cvt_pk_bf16(v0[2], v0[3]); w.z = cvt_pk_bf16(v1[0], v1[1]); w.w = cvt_pk_bf16(v1[2], v1[3]);
                        *(gu32x4*)(P + (size_t)row * 4608 + col0 + bj * HALF) = w; }
                } else if (wc == 0 && fq < 2) {
                    *(gf32x4*)(DT + (size_t)row * 16 + 8 * fq) = acc[ai][0][m][0] * rs; *(gf32x4*)(DT + (size_t)row * 16 + 8 * fq + 4) = acc[ai][0][m][1] * rs; }
            }
    }
};
struct EpiQkv {
    static constexpr bool PERM = true, AFTER_DRAIN = false;
    bf16_t* QKV; RstdTab rt; const float* rope; float qscale;
    __device__ __forceinline__ void operator()(const f32x4 (&acc)[2][2][4][2], const Unit& u, int wr, int wc, int fr, int fq) const {
        const int sect = u.pn >> 2; bf16_t* base = QKV + (size_t)sect * ((size_t)32768 * 1024);
        const int row0 = u.pm * BM + wr * 64 + fr, col0 = (u.pn & 3) * BM + wc * 32 + 8 * fq;
        const float sc = sect == 0 ? qscale : 1.0f; const bool rot = (sect < 2), mine = ((wc & 1) == 0) && (fq < 2);
#pragma unroll
        for (int ai = 0; ai < 2; ++ai)
#pragma unroll
            for (int m = 0; m < 4; ++m) { const int row = row0 + ai * HALF + m * 16; const float rs = rt.get(u.pm, row);
                f32x4 c0 = {1.f, 1.f, 1.f, 1.f}, c1 = c0, s0 = {0.f, 0.f, 0.f, 0.f}, s1 = s0;
                if (rot && mine) { const float* rp = rope + (size_t)(row & 2047) * 16; c0 = *(const gf32x4*)rp; c1 = *(const gf32x4*)(rp + 4); s0 = *(const gf32x4*)(rp + 8); s1 = *(const gf32x4*)(rp + 12);
                    if (fq == 0) { s0 = -s0; s1 = -s1; } }
#pragma unroll
                for (int bj = 0; bj < 2; ++bj) { f32x4 v0 = acc[ai][bj][m][0] * rs, v1 = acc[ai][bj][m][1] * rs;
                    if (rot) { f32x4 p0, p1;
#pragma unroll
                        for (int j = 0; j < 4; ++j) { p0[j] = __shfl_xor(v0[j], 16); p1[j] = __shfl_xor(v1[j], 16); }
                        v0 = v0 * c0 + p0 * s0; v1 = v1 * c1 + p1 * s1; }
                    v0 = v0 * sc; v1 = v1 * sc;
                    u32x4 w; w.x = cvt_pk_bf16(v0[0], v0[1]); w.y = cvt_pk_bf16(v0[2], v0[3]); w.z = cvt_pk_bf16(v1[0], v1[1]); w.w = cvt_pk_bf16(v1[2], v1[3]);
                    *(gu32x4*)(base + (size_t)row * 1024 + col0 + bj * HALF) = w; }
            }
    }
};
}
#include <hip/hip_bf16.h>
#include <cmath>
namespace attn_body {
using bf16=__hip_bfloat16;
using bf16x8=__attribute__((ext_vector_type(8)))short;
using s16x4=__attribute__((ext_vector_type(4)))short;
using f32x16=__attribute__((ext_vector_type(16)))float;
using u32x4=__attribute__((ext_vector_type(4)))unsigned;
constexpr int BATCH=16,SEQ=2048,D=64,DM=1024,OP=2048;
constexpr int NW=8,QBLK=32,QB=QBLK*NW,KVBLK=64,NQB=SEQ/QB;
constexpr int ATTN_PITCH=DM, ATTN_UNIT_ROWS=QB;
__device__ __forceinline__ int crow(int r,int hi){return (r&3)+8*(r>>2)+4*hi;}
#define SBAR() __builtin_amdgcn_sched_barrier(0)
__device__ __forceinline__ void cmask(f32x16&p0,f32x16&p1,int jb,int qrel,int hi){
  const float NEG=-INFINITY; int kb=64*jb+4*hi;
  #pragma unroll
  for(int r=0;r<16;++r){int kv=kb+(r&3)+8*(r>>2); if(kv>qrel)p0[r]=NEG; if(kv+32>qrel)p1[r]=NEG;}
}

constexpr int NSLOT=3, SLOTB=8192;
constexpr int LDS_K=0, LDS_V=NSLOT*SLOTB, LDS_WS=2*NSLOT*SLOTB, LDS_OST=LDS_WS+NW*64*4, LDS_BYTES=LDS_OST+NW*4096;
constexpr float C2=0.125f*1.4426950408889634f;
__device__ __forceinline__ void glds16(const void*gsrc,unsigned lds_dst){unsigned keep;
  asm volatile("s_mov_b32 %0, m0\n\ts_mov_b32 m0, %2\n\ts_nop 0\n\tglobal_load_lds_dwordx4 %1, off\n\ts_mov_b32 m0, %0":"=&s"(keep):"v"(gsrc),"s"(lds_dst):"memory");}
__device__ __forceinline__ float max3f(float a,float b,float c){float r;asm("v_max3_f32 %0, %1, %2, %3":"=v"(r):"v"(a),"v"(b),"v"(c));return r;}
__device__ __forceinline__ float max2f(float a,float b){float r;asm("v_max_f32_e32 %0, %1, %2":"=v"(r):"v"(a),"v"(b));return r;}
__device__ __forceinline__ float fadd_s(float a,float b){float r;asm("v_add_f32_e32 %0, %1, %2":"=v"(r):"v"(a),"v"(b));return r;}
__device__ __forceinline__ float fsub_s(float a,float b){float r;asm("v_sub_f32_e32 %0, %1, %2":"=v"(r):"v"(a),"v"(b));return r;}
typedef float f32x2_t __attribute__((ext_vector_type(2))); typedef __bf16 bf16x2_t __attribute__((ext_vector_type(2)));
__device__ __forceinline__ unsigned cvtpk_s(float lo,float hi){f32x2_t v={lo,hi};bf16x2_t b=__builtin_convertvector(v,bf16x2_t);return __builtin_bit_cast(unsigned,b);}
#define WAIT_BAR(N) asm volatile("s_waitcnt vmcnt(" #N ") lgkmcnt(0)\n\ts_barrier":::"memory")

__device__ __forceinline__ void qkt(f32x16&p0,f32x16&p1,const char*Kslot,const bf16x8*qr,const f32x16&negm,int r32,int hi){
  const char*kb=Kslot+hi*1024+r32*16;
  #pragma unroll
  for(int d0=0;d0<4;++d0){
    const bf16x8 b0=*reinterpret_cast<const bf16x8*>(kb+d0*2048);
    const bf16x8 b1=*reinterpret_cast<const bf16x8*>(kb+d0*2048+512);
    if(d0==0){p0=__builtin_amdgcn_mfma_f32_32x32x16_bf16(b0,qr[0],negm,0,0,0);p1=__builtin_amdgcn_mfma_f32_32x32x16_bf16(b1,qr[0],negm,0,0,0);}
    else{p0=__builtin_amdgcn_mfma_f32_32x32x16_bf16(b0,qr[d0],p0,0,0,0);p1=__builtin_amdgcn_mfma_f32_32x32x16_bf16(b1,qr[d0],p1,0,0,0);}}
}
typedef __attribute__((address_space(3))) const char* lds_cptr;
typedef short v4i16_t __attribute__((ext_vector_type(4)));
__device__ __forceinline__ void kload8(bf16x8*kf,lds_cptr kp){
  kf[0]=*(const __attribute__((address_space(3))) bf16x8*)(kp);      kf[1]=*(const __attribute__((address_space(3))) bf16x8*)(kp+512);
  kf[2]=*(const __attribute__((address_space(3))) bf16x8*)(kp+2048); kf[3]=*(const __attribute__((address_space(3))) bf16x8*)(kp+2560);
  kf[4]=*(const __attribute__((address_space(3))) bf16x8*)(kp+4096); kf[5]=*(const __attribute__((address_space(3))) bf16x8*)(kp+4608);
  kf[6]=*(const __attribute__((address_space(3))) bf16x8*)(kp+6144); kf[7]=*(const __attribute__((address_space(3))) bf16x8*)(kp+6656);
}
__device__ __forceinline__ void kload2(bf16x8*kf,lds_cptr kp,int j){ kf[2*j]=*(const __attribute__((address_space(3))) bf16x8*)(kp+j*2048); kf[2*j+1]=*(const __attribute__((address_space(3))) bf16x8*)(kp+j*2048+512); }
__device__ __forceinline__ s16x4 vtr(lds_cptr p){ return __builtin_bit_cast(s16x4,__builtin_amdgcn_ds_read_tr16_b64_v4i16((__attribute__((address_space(3))) v4i16_t*)p)); }
__device__ __forceinline__ float rowmax(const f32x16&p0,const f32x16&p1){
  float a=max3f(p0[0],p0[1],p1[0]),b=max3f(p0[2],p0[3],p1[1]);a=max3f(a,p1[2],p1[3]);
  #pragma unroll
  for(int r=4;r<16;r+=4){a=max3f(a,p0[r],p0[r+1]);b=max3f(b,p0[r+2],p0[r+3]);a=max3f(a,p1[r],p1[r+1]);b=max3f(b,p1[r+2],p1[r+3]);}
  const float m=max2f(a,b);
  auto rr=__builtin_amdgcn_permlane32_swap(__float_as_uint(m),__float_as_uint(m),false,false);
  return max2f(__uint_as_float(rr[0]),__uint_as_float(rr[1]));
}
__device__ __forceinline__ void pv(f32x16*o,int vb,bf16x8 pa0,bf16x8 pa1,bf16x8 pa2,bf16x8 pa3){
  #pragma unroll
  for(int d0=0;d0<2;++d0){s16x4 lo[4],hi[4];
    #pragma unroll
    for(int ks=0;ks<4;++ks){
      asm volatile("ds_read_b64_tr_b16 %0,%1 offset:%c2":"=&v"(lo[ks]):"v"(vb),"i"(d0*4096+ks*1024):"memory");
      asm volatile("ds_read_b64_tr_b16 %0,%1 offset:%c2":"=&v"(hi[ks]):"v"(vb),"i"(d0*4096+ks*1024+512):"memory");}
    asm volatile("s_waitcnt lgkmcnt(0)":::"memory");SBAR();
    #define PK(k) (bf16x8){lo[k][0],lo[k][1],lo[k][2],lo[k][3],hi[k][0],hi[k][1],hi[k][2],hi[k][3]}
    o[d0]=__builtin_amdgcn_mfma_f32_32x32x16_bf16(pa0,PK(0),o[d0],0,0,0);
    o[d0]=__builtin_amdgcn_mfma_f32_32x32x16_bf16(pa1,PK(1),o[d0],0,0,0);
    o[d0]=__builtin_amdgcn_mfma_f32_32x32x16_bf16(pa2,PK(2),o[d0],0,0,0);
    o[d0]=__builtin_amdgcn_mfma_f32_32x32x16_bf16(pa3,PK(3),o[d0],0,0,0);
    #undef PK
  }
}

#ifndef ATTN_STORE16
#define ATTN_STORE16(p,v) (*(u32x4*)(p)=(v))
#endif
template<int THRL> __device__ __forceinline__ void attn_unit(int b,int qcol,int vcol,int ocol,int qb,const bf16*Q,const bf16*__restrict__ K,const bf16*__restrict__ V,bf16*O,char*shm){
  int tid_=threadIdx.x; asm volatile("":"+v"(tid_)); const int tid=tid_,lane=tid&63,r32=lane&31,hi=lane>>5; const int wid=__builtin_amdgcn_readfirstlane(tid>>6);
  const long rowbase=(long)b*SEQ; const int q0=qb*QB;
  const bf16*Qw=Q+(rowbase+q0+wid*QBLK)*DM+qcol;
  const bf16*Kh=K+rowbase*DM+qcol,*Vh=V+rowbase*DM+vcol;
  const unsigned lds0=(unsigned)(uintptr_t)shm;
  float*wsf=(float*)(shm+LDS_WS)+wid*64;
  const bf16*ksrc=Kh+(long)lane*DM+wid*8;
  const bf16*vsrc=Vh+(long)(16*(wid&3)+(lane>>2))*DM+(wid>>2)*32+(lane&3)*8;
  const unsigned kdst=lds0+LDS_K+wid*1024, vdst=lds0+LDS_V+wid*1024;
  #define DMA_K(t,slot) glds16(ksrc+(long)(t)*KVBLK*DM,(unsigned)__builtin_amdgcn_readfirstlane(kdst+(slot)))
  #define DMA_V(t,slot) glds16(vsrc+(long)(t)*KVBLK*DM,(unsigned)__builtin_amdgcn_readfirstlane(vdst+(slot)))
  const int vb0=(int)(lds0+LDS_V)+((lane>>4)&1)*32+(lane&3)*8+(4*hi+((lane&15)>>2))*64;
  const char*Kbase=shm+LDS_K; bf16x8 kf[8];
  const lds_cptr shm3=(lds_cptr)shm; const lds_cptr kp0=shm3+LDS_K+hi*1024+r32*16; const lds_cptr vp0=shm3+LDS_V+((lane>>4)&1)*32+(lane&3)*8+(4*hi+((lane&15)>>2))*64;
  const int NT=(q0+QB)/KVBLK;
  DMA_K(0,0);DMA_V(0,0);DMA_K(1,SLOTB);
  bf16x8 qr[4];
  #pragma unroll
  for(int d0=0;d0<4;++d0)qr[d0]=*reinterpret_cast<const bf16x8*>(&Qw[(long)r32*DM+d0*16+hi*8]);
  float mhat=0.f,l_reg=0.f;f32x16 o[2];o[0]=f32x16{};o[1]=f32x16{};f32x16 negm=f32x16{};asm volatile("":"+v"(negm));
  const int qrel=wid*QBLK+r32;
  #define CMASK(P0,P1,t) do{int jb_=(t)-(NT-4); if(jb_>=0)cmask(P0,P1,jb_,qrel,hi);}while(0)
  bool resc=false;
  #define START(P0,P1) do{ const float rm=rowmax(P0,P1); resc=false; \
    { const float dl=rm; mhat=fadd_s(mhat,dl); \
      _Pragma("unroll") for(int r=0;r<16;++r){P0[r]=fsub_s(P0[r],dl);P1[r]=fsub_s(P1[r],dl);} \
      _Pragma("unroll") for(int r=0;r<16;++r)negm[r]=-mhat; asm volatile("":"+v"(negm)); } \
    _Pragma("unroll") for(int r=0;r<16;++r)P0[r]=__builtin_amdgcn_exp2f(P0[r]); }while(0)
  #define RESC() do{ if(resc){ asm volatile("s_waitcnt lgkmcnt(0)":::"memory"); \
      _Pragma("unroll") for(int d_=0;d_<2;++d_) _Pragma("unroll") for(int r=0;r<16;++r)o[d_][r]*=wsf[crow(r,hi)]; } }while(0)
  f32x16 pA0,pA1,pB0,pB1;
  int sl_prev=0,sl_cur=0,sl_next=SLOTB;
  #define ROT() do{sl_prev=sl_cur;sl_cur=sl_next;sl_next=(sl_next==(NSLOT-1)*SLOTB)?0:sl_next+SLOTB;}while(0)
  DMA_K(2,2*SLOTB);
  WAIT_BAR(3);
  qkt(pA0,pA1,Kbase,qr,negm,r32,hi);asm volatile("s_nop 15\n\ts_nop 7":"+v"(pA0),"+v"(pA1));CMASK(pA0,pA1,0);
  START(pA0,pA1);
  _Pragma("unroll") for(int r=0;r<16;++r)pA1[r]=__builtin_amdgcn_exp2f(pA1[r]);
  WAIT_BAR(0);
  DMA_K(3,0);DMA_V(1,SLOTB);
  ROT();
  kload8(kf,kp0+sl_cur);
  WAIT_BAR(2);
  s16x4 vlo[8],vhi[8]; u32x4 pw0,pw1,pw2,pw3;
  #define PKW(P,B) cvtpk_s(P[B],P[B+1])
  #define PAF(k) __builtin_bit_cast(bf16x8,pw##k)
  #define VFR(i) (bf16x8){vlo[i][0],vlo[i][1],vlo[i][2],vlo[i][3],vhi[i][0],vhi[i][1],vhi[i][2],vhi[i][3]}
  #define PIN(x) asm volatile("":"+v"(x))
  #define MX3(a,b,c) __builtin_fmaxf(__builtin_fmaxf((a),(b)),(c))
  #define GAPA(MF,A0,A1,A2,A3,W0,W1,PW) do{ MF; sacc+=A0; sacc+=A1; sacc+=A2; sacc+=A3; PIN(sacc); W0; W1; PIN(PW); SBAR(); }while(0)
  #define EX(v) __builtin_amdgcn_exp2f(v)
  #define GAPB(MF,X,B) do{ MF; X[B]=EX(X[B]); X[B+1]=EX(X[B+1]); X[B+2]=EX(X[B+2]); X[B+3]=EX(X[B+3]); PIN(X); SBAR(); }while(0)
  #define VRD(i) do{ vlo[i]=vtr(vp_+(((i)>>2)*4096+((i)&3)*1024)); vhi[i]=vtr(vp_+(((i)>>2)*4096+((i)&3)*1024+512)); }while(0)
  #define KRD(G,j) do{ if(G){ kload2(kf,kp0+sl_next,j); SBAR(); } }while(0)
  #define STEP(C0,C1,P0,P1,t,GK,GV,GL) do{ SBAR(); \
    const lds_cptr vp_=vp0+sl_prev; \
    VRD(0); SBAR(); float sacc=(P0[0]+P0[1]); \
    GAPA(C0=__builtin_amdgcn_mfma_f32_32x32x16_bf16(kf[0],qr[0],negm,0,0,0), P0[2],P0[3],P0[4],P0[5],     pw0[0]=PKW(P0,0), pw0[1]=PKW(P0,2), pw0); \
    VRD(4); SBAR(); GAPA(C1=__builtin_amdgcn_mfma_f32_32x32x16_bf16(kf[1],qr[0],negm,0,0,0), P0[6],P0[7],P0[8],P0[9],     pw0[2]=PKW(P0,4), pw0[3]=PKW(P0,6), pw0); \
    VRD(1); SBAR(); GAPA(C0=__builtin_amdgcn_mfma_f32_32x32x16_bf16(kf[2],qr[1],C0,0,0,0),   P0[10],P0[11],P0[12],P0[13], pw1[0]=PKW(P0,8), pw1[1]=PKW(P0,10), pw1); \
    VRD(5); SBAR(); GAPA(C1=__builtin_amdgcn_mfma_f32_32x32x16_bf16(kf[3],qr[1],C1,0,0,0),   P0[14],P0[15],P1[0],P1[1],   pw1[2]=PKW(P0,12),pw1[3]=PKW(P0,14), pw1); \
    VRD(2); SBAR(); GAPA(C0=__builtin_amdgcn_mfma_f32_32x32x16_bf16(kf[4],qr[2],C0,0,0,0),   P1[2],P1[3],P1[4],P1[5],     pw2[0]=PKW(P1,0), pw2[1]=PKW(P1,2), pw2); \
    VRD(6); SBAR(); GAPA(C1=__builtin_amdgcn_mfma_f32_32x32x16_bf16(kf[5],qr[2],C1,0,0,0),   P1[6],P1[7],P1[8],P1[9],     pw2[2]=PKW(P1,4), pw2[3]=PKW(P1,6), pw2); \
    VRD(3); SBAR(); GAPA(C0=__builtin_amdgcn_mfma_f32_32x32x16_bf16(kf[6],qr[3],C0,0,0,0),   P1[10],P1[11],P1[12],P1[13], pw3[0]=PKW(P1,8), pw3[1]=PKW(P1,10), pw3); \
    VRD(7); SBAR(); GAPA(C1=__builtin_amdgcn_mfma_f32_32x32x16_bf16(kf[7],qr[3],C1,0,0,0),   P1[14],P1[15],0.f,0.f,       pw3[2]=PKW(P1,12),pw3[3]=PKW(P1,14), pw3); \
    l_reg+=sacc; \
    if(GK){DMA_K((t)+3,sl_cur);} if(GV){DMA_V((t)+1,sl_next);} \
    CMASK(C0,C1,t); \
    { float a=MX3(C0[0],C0[1],C1[0]),b=MX3(C0[2],C0[3],C1[1]); a=MX3(a,C1[2],C1[3]); \
      _Pragma("unroll") for(int r=4;r<16;r+=4){a=MX3(a,C0[r],C0[r+1]);b=MX3(b,C0[r+2],C0[r+3]);a=MX3(a,C1[r],C1[r+1]);b=MX3(b,C1[r+2],C1[r+3]);} \
      float rm=__builtin_fmaxf(a,b); { auto rr=__builtin_amdgcn_permlane32_swap(__float_as_uint(rm),__float_as_uint(rm),false,false); rm=__builtin_fmaxf(__uint_as_float(rr[0]),__uint_as_float(rr[1])); } \
      resc=false; \
      if(__builtin_expect(__any(rm>(float)THRL),0)){ const float dl=__builtin_fmaxf(rm,0.f); mhat+=dl; \
        _Pragma("unroll") for(int r=0;r<16;++r){C0[r]-=dl;C1[r]-=dl;} \
        _Pragma("unroll") for(int r=0;r<16;++r)negm[r]=-mhat; asm volatile("":"+v"(negm)); \
        const float f=__builtin_amdgcn_exp2f(-dl); l_reg*=f; if(hi==0)wsf[r32]=f; resc=true; } } \
    SBAR(); \
    GAPB(o[0]=__builtin_amdgcn_mfma_f32_32x32x16_bf16(PAF(0),VFR(0),o[0],0,0,0), C0,0); \
    GAPB(o[1]=__builtin_amdgcn_mfma_f32_32x32x16_bf16(PAF(0),VFR(4),o[1],0,0,0), C0,4); \
    KRD(GL,0); GAPB(o[0]=__builtin_amdgcn_mfma_f32_32x32x16_bf16(PAF(1),VFR(1),o[0],0,0,0), C0,8); \
    KRD(GL,1); GAPB(o[1]=__builtin_amdgcn_mfma_f32_32x32x16_bf16(PAF(1),VFR(5),o[1],0,0,0), C0,12); \
    KRD(GL,2); GAPB(o[0]=__builtin_amdgcn_mfma_f32_32x32x16_bf16(PAF(2),VFR(2),o[0],0,0,0), C1,0); \
    KRD(GL,3); GAPB(o[1]=__builtin_amdgcn_mfma_f32_32x32x16_bf16(PAF(2),VFR(6),o[1],0,0,0), C1,4); \
    GAPB(o[0]=__builtin_amdgcn_mfma_f32_32x32x16_bf16(PAF(3),VFR(3),o[0],0,0,0), C1,8); \
    GAPB(o[1]=__builtin_amdgcn_mfma_f32_32x32x16_bf16(PAF(3),VFR(7),o[1],0,0,0), C1,12); \
    }while(0)
  int t=1;
  #undef CMASK
  #define CMASK(P0,P1,t) do{}while(0)
  for(;t+5<NT;t+=2){
    STEP(pB0,pB1,pA0,pA1,t,true,true,true);     WAIT_BAR(2); RESC(); ROT();
    STEP(pA0,pA1,pB0,pB1,t+1,true,true,true);   WAIT_BAR(2); RESC(); ROT();
  }
  #undef CMASK
  #define CMASK(P0,P1,t) do{int jb_=(t)-(NT-4); if(jb_>=0)cmask(P0,P1,jb_,qrel,hi);}while(0)
  #define ENDW(tt) do{ if((tt)+3<NT){WAIT_BAR(2);} else if((tt)+2<NT){WAIT_BAR(1);} else {WAIT_BAR(0);} }while(0)
  for(;t+1<NT;t+=2){
    STEP(pB0,pB1,pA0,pA1,t,(t+3<NT),(t+1<NT),(t+1<NT));       ENDW(t);   RESC(); ROT();
    STEP(pA0,pA1,pB0,pB1,t+1,(t+4<NT),(t+2<NT),(t+2<NT));     ENDW(t+1); RESC(); ROT();
  }
  STEP(pB0,pB1,pA0,pA1,NT-1,false,false,false); RESC();
  { float sacc=pB0[0]+pB0[1]; _Pragma("unroll") for(int r=2;r<16;++r)sacc+=pB0[r]; _Pragma("unroll") for(int r=0;r<16;++r)sacc+=pB1[r]; l_reg+=sacc;
    pw0=(u32x4){PKW(pB0,0),PKW(pB0,2),PKW(pB0,4),PKW(pB0,6)};pw1=(u32x4){PKW(pB0,8),PKW(pB0,10),PKW(pB0,12),PKW(pB0,14)};pw2=(u32x4){PKW(pB1,0),PKW(pB1,2),PKW(pB1,4),PKW(pB1,6)};pw3=(u32x4){PKW(pB1,8),PKW(pB1,10),PKW(pB1,12),PKW(pB1,14)};
    SBAR(); pv(o,vb0+sl_cur,PAF(0),PAF(1),PAF(2),PAF(3)); }
  #undef PKW
  #undef PAF
  #undef VFR
  #undef PIN
  #undef MX3
  #undef GAPA
  #undef GAPB
  #undef EX
  #undef VRD
  #undef KRD
  #undef STEP
  #undef ENDW
  {auto rr=__builtin_amdgcn_permlane32_swap(__float_as_uint(l_reg),__float_as_uint(l_reg),false,false);l_reg=__uint_as_float(rr[0])+__uint_as_float(rr[1]);}
  if(hi==0)wsf[32+r32]=l_reg;asm volatile("s_waitcnt lgkmcnt(0)":::"memory");
  float rli[16];
  #pragma unroll
  for(int r=0;r<16;++r)rli[r]=__builtin_amdgcn_rcpf(wsf[32+crow(r,hi)]);
  bf16*Ow=O+(rowbase+q0+wid*QBLK)*OP+ocol;
  { bf16*stg=(bf16*)(shm+LDS_OST)+wid*2048;
    #pragma unroll
    for(int r=0;r<16;++r){const int orow=crow(r,hi);
      #pragma unroll
      for(int d0=0;d0<2;++d0)stg[orow*64+d0*32+r32]=__float2bfloat16(o[d0][r]*rli[r]);}
    asm volatile("s_waitcnt lgkmcnt(0)":::"memory");
    #pragma unroll
    for(int i=0;i<4;++i){const int row=i*8+(lane>>3),ch=lane&7; const u32x4 v=*(const u32x4*)(stg+row*64+ch*8); ATTN_STORE16(Ow+(long)row*OP+ch*8,v);} }
  asm volatile("s_waitcnt lgkmcnt(0)\n\ts_barrier":::"memory");
  #undef DMA_K
  #undef DMA_V
  #undef CMASK
  #undef START
  #undef RESC
  #undef ROT
}
constexpr int ATTN_LDS_BYTES=LDS_BYTES;
struct AttnTensors { const bf16* Q; const bf16* K; const bf16* V; bf16* O; };
struct AttnUnit { int b, qcol, vcol, ocol, qb; };
template<int THRL=8> __device__ __forceinline__ void attn_phase(char*lds,const AttnTensors&T,int vcu,int G){
  for(int su=vcu;su<256;su+=G){ const int b=su>>4,h=(su>>1)&7,c=su&1;
    for(int i=0;i<16;++i){ const int half=i>>3,qb=7-(i&7);
      attn_unit<THRL>(b,(h*2+c)*64,h*128+half*64,c*1024+h*128+half*64,qb,T.Q,T.K,T.V,T.O,lds); } }
}
#undef SBAR
#undef WAIT_BAR
}
constexpr int NWAVES = 8;
constexpr int BATCH = 16, SEQ = 2048, DM_ = 1024, M = BATCH * SEQ, DFF = 2816, DEPTH = 4;
constexpr int PL = 4608;
constexpr int OFF_Z = 0, OFF_GATE = 1024, OFF_XA = 2048, OFF_B = 3072, OFF_C = 3328, OFF_XB = 3584;
constexpr float EPS = 1e-6f;
constexpr size_t MiB = 1u << 20;
constexpr size_t WS_ROWSS = 1 * MiB;
constexpr size_t WS_GSS = 5 * MiB;
constexpr size_t WS_ROPE = 7 * MiB;
constexpr size_t WS_DT = 7 * MiB + 512 * 1024;
constexpr size_t WS_WB = 10 * MiB;
constexpr size_t WB_GU1 = 0, WB_D1 = 11 * MiB, WB_GU2 = WB_D1 + 5 * MiB + 512 * 1024, WB_D2 = WB_GU2 + 11 * MiB, WB_MI = WB_D2 + 5 * MiB + 512 * 1024, WB_MO = WB_MI + 9 * MiB + 512 * 1024;
static_assert(WB_MO + 4 * MiB <= 48 * MiB, "weights");
constexpr size_t WS_HB = 58 * MiB;
constexpr size_t WS_BIG = 122 * MiB;
constexpr size_t WS_LO = 442 * MiB;
constexpr size_t WS_END = 474 * MiB;
constexpr int LDS_BYTES = 163840;

#define GAS __attribute__((address_space(1)))
#define LAS __attribute__((address_space(3)))
typedef unsigned short bf16;
typedef unsigned v4u __attribute__((ext_vector_type(4)));
typedef unsigned v2u __attribute__((ext_vector_type(2)));
typedef float f32x4 __attribute__((ext_vector_type(4)));
typedef short bf16x8 __attribute__((ext_vector_type(8)));
#define LDS_WAIT() asm volatile("s_waitcnt lgkmcnt(0)" ::: "memory")
__device__ __forceinline__ unsigned pk2(float lo, float hi) { return pg8::cvt_pk_bf16(lo, hi); }
__device__ __forceinline__ float bflo(unsigned w) { return __uint_as_float(w << 16); }
__device__ __forceinline__ float bfhi(unsigned w) { return __uint_as_float(w & 0xffff0000u); }
__device__ __forceinline__ float bf1(bf16 v) { return __uint_as_float((unsigned)v << 16); }
__device__ __forceinline__ float wave_sum(float v) {
#pragma unroll
    for (int o = 1; o < 64; o <<= 1) v += __shfl_xor(v, o);
    return v;
}
__device__ __forceinline__ float silu_f(float x) { return x * __builtin_amdgcn_rcpf(1.0f + __expf(-x)); }
__device__ __forceinline__ float sigmoid_f(float x) { return __builtin_amdgcn_rcpf(1.0f + __expf(-x)); }

struct Args { const float* in[33]; float* out; unsigned char* ws; };
struct FromArgs { const Args& a; __device__ __forceinline__ const float* operator()(int i) const { return a.in[i]; } };
struct FromTab { const float* const* t; __device__ __forceinline__ const float* operator()(int i) const { return t[i]; } };
constexpr size_t WS_TAB = 512 * 1024;

__device__ __forceinline__ void cvt_item(const float* W, int K, int Nsrc, int c0, int ncols, bf16* WT, int drow0, int mode, const float* kscale, LAS float* scr, int item, int lane) {
    const int nblk = (ncols + 63) / 64, kb = item / nblk, nb = item % nblk, k0 = 64 * kb, n0 = 64 * nb;
    const int l16 = lane & 15, kr = lane >> 4; const bool cok = (n0 + 4 * l16) < ncols;
    const float* src = W + (size_t)(k0 + kr) * Nsrc + c0 + n0 + 4 * l16;
    f32x4 v[16];
#pragma unroll
    for (int i = 0; i < 16; ++i) v[i] = cok ? __builtin_nontemporal_load((const f32x4*)(src + (size_t)(4 * i) * Nsrc)) : (f32x4){0.f, 0.f, 0.f, 0.f};
    const int c = lane & 7;
    f32x4 ks0 = {1.f, 1.f, 1.f, 1.f}, ks1 = ks0;
    if (kscale) { ks0 = *(const f32x4*)(kscale + k0 + 8 * c); ks1 = *(const f32x4*)(kscale + k0 + 8 * c + 4); }
#pragma unroll
    for (int i = 0; i < 16; ++i) { LAS float* d = scr + (4 * i + kr) * 65 + 4 * l16; d[0] = v[i][0]; d[1] = v[i][1]; d[2] = v[i][2]; d[3] = v[i][3]; }
    LDS_WAIT(); asm volatile("" ::: "memory");
    const int dbase = (mode == 0) ? (drow0 + n0) : ((n0 >> 7) * 256 + (n0 & 127) + (mode == 2 ? 128 : 0));
#pragma unroll
    for (int jj = 0; jj < 8; ++jj) { const int n = (lane >> 3) + 8 * jj; const LAS float* sp = scr + (8 * c) * 65 + n;
        v4u o; o.x = pk2(sp[0 * 65] * ks0[0], sp[1 * 65] * ks0[1]); o.y = pk2(sp[2 * 65] * ks0[2], sp[3 * 65] * ks0[3]); o.z = pk2(sp[4 * 65] * ks1[0], sp[5 * 65] * ks1[1]); o.w = pk2(sp[6 * 65] * ks1[2], sp[7 * 65] * ks1[3]);
        if (n0 + n < ncols) *(v4u*)(WT + (size_t)(dbase + n) * K + k0 + 8 * c) = o; }
    LDS_WAIT(); asm volatile("" ::: "memory");
}
#define CVT_SEC(W, K, Nsrc, c0, ncols, WT, drow0, mode, ksc) { const int cnt_ = ((K) / 64) * (((ncols) + 63) / 64); if (r < cnt_) { cvt_item(W, K, Nsrc, c0, ncols, WT, drow0, mode, ksc, scr, r, lane); continue; } r -= cnt_; }
template <class PS> __device__ __forceinline__ void convert_layer(const PS& P, unsigned char* wsb, int l, LAS unsigned char* lds, int gw, int NGW, int wave, int lane) {
    LAS float* scr = (LAS float*)(lds + wave * 16896);
    unsigned char* wb = wsb + WS_WB; const int j = l >> 1;
    const size_t FW = (size_t)1024 * 2816;
    const float* g1 = P(2) + l * FW; const float* u1 = P(3) + l * FW; const float* d1 = P(4) + l * FW;
    const float* g2 = P(7) + l * FW; const float* u2 = P(8) + l * FW; const float* d2 = P(9) + l * FW;
    const float* n1 = P(1) + l * 1024; const float* nm = P(5) + l * 1024; const float* n2 = P(6) + l * 1024;
    const float* win = P(10) + (size_t)j * 1024 * 4624; const float* wout = P(24) + (size_t)j * 2048 * 1024;
    const float* wqkv = P(25) + (size_t)j * 1024 * 3072; const float* wo = P(31) + (size_t)j * 1024 * 1024;
    bf16* GU1 = (bf16*)(wb + WB_GU1); bf16* D1 = (bf16*)(wb + WB_D1); bf16* GU2 = (bf16*)(wb + WB_GU2); bf16* D2 = (bf16*)(wb + WB_D2); bf16* MI = (bf16*)(wb + WB_MI); bf16* MO = (bf16*)(wb + WB_MO);
    const bool even = (l & 1) == 0;
    for (int it = gw; ; it += NGW) {
        int r = it;
        CVT_SEC(g1, 1024, 2816, 0, 2816, GU1, 0, 1, n1)
        CVT_SEC(u1, 1024, 2816, 0, 2816, GU1, 0, 2, n1)
        CVT_SEC(d1, 2816, 1024, 0, 1024, D1, 0, 0, nullptr)
        CVT_SEC(g2, 1024, 2816, 0, 2816, GU2, 0, 1, n2)
        CVT_SEC(u2, 1024, 2816, 0, 2816, GU2, 0, 2, n2)
        CVT_SEC(d2, 2816, 1024, 0, 1024, D2, 0, 0, nullptr)
        if (even) {
            CVT_SEC(win, 1024, 4624, 0, 1024, MI, 0, 0, nm)
            CVT_SEC(win, 1024, 4624, 1024, 1536, MI, 2048, 0, nm)
            CVT_SEC(win, 1024, 4624, 2560, 16, MI, 4608, 0, nm)
            CVT_SEC(win, 1024, 4624, 2576, 1024, MI, 1024, 0, nm)
            CVT_SEC(win, 1024, 4624, 3600, 1024, MI, 3584, 0, nm)
            CVT_SEC(wout, 2048, 1024, 0, 1024, MO, 0, 0, nullptr)
        } else {
            CVT_SEC(wqkv, 1024, 3072, 0, 3072, MI, 0, 0, nm)
            CVT_SEC(wo, 1024, 1024, 0, 1024, MO, 0, 0, nullptr)
        }
        break;
    }
}
__device__ __forceinline__ void prologue(const Args& a, LAS unsigned char* lds, int gw, int NGW, int wave, int lane, int gtid, int NGT) {
    float* rowss = (float*)(a.ws + WS_ROWSS); bf16* HB = (bf16*)(a.ws + WS_HB);
    for (int m = gw; m < M; m += NGW) {
        const f32x4* xr = (const f32x4*)(a.in[0] + (size_t)m * 1024) + lane; v2u* hb = (v2u*)(HB + (size_t)m * 1024) + lane;
        float s = 0.f;
#pragma unroll
        for (int j = 0; j < 4; ++j) { const f32x4 v = __builtin_nontemporal_load(xr + 64 * j); s += (v.x * v.x + v.y * v.y) + (v.z * v.z + v.w * v.w);
#if RESID_LO
            const unsigned e0 = pg8::EpiResid::enc(v.x), e1 = pg8::EpiResid::enc(v.y), e2 = pg8::EpiResid::enc(v.z), e3 = pg8::EpiResid::enc(v.w);
            v2u w; w.x = (e0 >> 16) | (e1 & 0xffff0000u); w.y = (e2 >> 16) | (e3 & 0xffff0000u); hb[64 * j] = w;
            const unsigned n4 = ((e0 >> 12) & 0xfu) | ((e1 >> 8) & 0xf0u) | ((e2 >> 4) & 0xf00u) | (e3 & 0xf000u);
            const unsigned nn = __shfl_xor(n4, 1);
            if ((lane & 1) == 0) ((unsigned*)(a.ws + WS_LO))[(size_t)m * 128 + ((lane + 64 * j) >> 1)] = n4 | (nn << 16);
#else
            v2u w; w.x = pk2(v.x, v.y); w.y = pk2(v.z, v.w); hb[64 * j] = w;
#endif
        }
        s = wave_sum(s); if (lane < 16) rowss[(size_t)m * 16 + lane] = (lane == 0) ? s : 0.f;
    }
    { float* rope = (float*)(a.ws + WS_ROPE);
      for (int i = gtid; i < 2048 * 8; i += NGT) { const int t = i >> 3, k = i & 7; const float inv = exp2f(-(float)k * (18.931568569324174f / 8.0f)); const float ang = (float)t * inv;
          float rev = ang * 0.15915494309189535f; rev -= floorf(rev); rope[t * 16 + k] = __builtin_amdgcn_cosf(rev); rope[t * 16 + 8 + k] = __builtin_amdgcn_sinf(rev); } }
    if (threadIdx.x == 0) { const float** tab = (const float**)(a.ws + WS_TAB);
#pragma unroll
        for (int i = 0; i < 33; ++i) tab[i] = a.in[i];
        tab[33] = a.out; }
    convert_layer(FromArgs{a}, a.ws, 0, lds, gw, NGW, wave, lane);
}

#define WG_BAR() do { asm volatile("s_waitcnt lgkmcnt(0)" ::: "memory"); __builtin_amdgcn_s_barrier(); asm volatile("" ::: "memory"); } while (0)
#define MFMA16(a, b, c) __builtin_amdgcn_mfma_f32_16x16x32_bf16(a, b, c, 0, 0, 0)
#define LDF(off) (*(const LAS bf16x8*)(lds + (off)))
constexpr int P2 = 272;
constexpr int L_C = 0, L_B = 34816, L_BWT = 69632, L_XT = 104448, L_S = 121856, L_CSALL = 139264  , L_DTALL = 147456  ;
__device__ __forceinline__ void unpack8(const v4u r, float (&f)[8]) { f[0] = bflo(r.x); f[1] = bfhi(r.x); f[2] = bflo(r.y); f[3] = bfhi(r.y); f[4] = bflo(r.z); f[5] = bfhi(r.z); f[6] = bflo(r.w); f[7] = bfhi(r.w); }

constexpr size_t BC2_OFF = (size_t)M * PL;
__device__ __forceinline__ void bc_preconv_pass(bf16* BIG, const float* cw, const float* cb, int gtid, int NGT) {
    for (int it = gtid; it < 64 * 4096; it += NGT) { const int cg = it & 63, strip = it >> 6; const int ch = 1024 + cg * 8, r0 = strip * 8, tb = r0 & (SEQ - 1);
        float w[4][8], bias[8];
#pragma unroll
        for (int k = 0; k < 4; ++k) { const f32x4 wa = *(const f32x4*)(cw + k * 1536 + ch), wb = *(const f32x4*)(cw + k * 1536 + ch + 4);
            w[k][0] = wa.x; w[k][1] = wa.y; w[k][2] = wa.z; w[k][3] = wa.w; w[k][4] = wb.x; w[k][5] = wb.y; w[k][6] = wb.z; w[k][7] = wb.w; }
        { const f32x4 ba = *(const f32x4*)(cb + ch), bb = *(const f32x4*)(cb + ch + 4); bias[0] = ba.x; bias[1] = ba.y; bias[2] = ba.z; bias[3] = ba.w; bias[4] = bb.x; bias[5] = bb.y; bias[6] = bb.z; bias[7] = bb.w; }
        v4u raw[11];
#pragma unroll
        for (int s = 0; s < 11; ++s) { const bool ok = (tb + s - 3 >= 0); const v4u t_ = __builtin_nontemporal_load((const GAS v4u*)(BIG + (size_t)(ok ? r0 + s - 3 : r0) * PL + OFF_B + cg * 8)); const unsigned mk = ok ? 0xffffffffu : 0u; raw[s] = (v4u){t_.x & mk, t_.y & mk, t_.z & mk, t_.w & mk}; }
#pragma unroll
        for (int s = 0; s < 8; ++s) { float val[8];
#pragma unroll
            for (int c = 0; c < 8; ++c) val[c] = bias[c];
#pragma unroll
            for (int k = 0; k < 4; ++k) { float f[8]; unpack8(raw[s + k], f);
#pragma unroll
                for (int c = 0; c < 8; ++c) val[c] += w[k][c] * f[c]; }
#pragma unroll
            for (int c = 0; c < 8; ++c) val[c] = silu_f(val[c]);
            v4u o; o.x = pk2(val[0], val[1]); o.y = pk2(val[2], val[3]); o.z = pk2(val[4], val[5]); o.w = pk2(val[6], val[7]);
            *(GAS v4u*)(BIG + BC2_OFF + (size_t)(r0 + s) * 512 + cg * 8) = o; }
    }
}
__device__ __forceinline__ void ssd_unit(LAS unsigned char* lds, int b, int h, int j, unsigned char* ws, const bool DRY) {
    int tid_ = threadIdx.x; asm volatile("" : "+v"(tid_));
    const int tid = tid_, wid = __builtin_amdgcn_readfirstlane(tid >> 6), lane = tid & 63, fr = lane & 15, fq = lane >> 4;
    const int g = h >> 3;
    { unsigned zz = 0u; asm volatile("" : "+v"(zz)); for (int i = tid; i < 17408 / 16; i += 512) *(LAS v4u*)(lds + L_S + i * 16) = (v4u){zz, zz, zz, zz}; }
    f32x4 S[4];
#pragma unroll
    for (int i = 0; i < 4; ++i) S[i] = (f32x4){0.f, 0.f, 0.f, 0.f};
    const int p0 = (wid & 3) * 16, n0 = (wid >> 2) * 64;
    const int xcg8 = tid & 7, xts = tid >> 3;
    float dt_bias, a_h, d_h; { const float* const* tab0 = (const float* const*)(ws + WS_TAB); dt_bias = tab0[13][j * 16 + h]; a_h = -__expf(tab0[14][j * 16 + h]); d_h = tab0[15][j * 16 + h]; }
    float xw[4][8], xbias[8];
    { const float* const* tab0 = (const float* const*)(ws + WS_TAB); const float* cw = tab0[11] + (size_t)j * 4 * 1536; const float* cb = tab0[12] + (size_t)j * 1536; const int ch = h * 64 + xcg8 * 8;
#pragma unroll
      for (int k = 0; k < 4; ++k) { const f32x4 wa = *(const f32x4*)(cw + k * 1536 + ch), wb = *(const f32x4*)(cw + k * 1536 + ch + 4);
          xw[k][0] = wa.x; xw[k][1] = wa.y; xw[k][2] = wa.z; xw[k][3] = wa.w; xw[k][4] = wb.x; xw[k][5] = wb.y; xw[k][6] = wb.z; xw[k][7] = wb.w; }
      const f32x4 ba = *(const f32x4*)(cb + ch), bb = *(const f32x4*)(cb + ch + 4); xbias[0] = ba.x; xbias[1] = ba.y; xbias[2] = ba.z; xbias[3] = ba.w; xbias[4] = bb.x; xbias[5] = bb.y; xbias[6] = bb.z; xbias[7] = bb.w; }
    {
        const GAS float* dtp = (const GAS float*)(ws + WS_DT) + ((size_t)b * SEQ + 4 * tid) * 16 + h;
        float d[4], p[4];
#pragma unroll
        for (int i = 0; i < 4; ++i) { const float x = dtp[i * 16] + dt_bias; d[i] = x > 20.f ? x : log1pf(__expf(x)); }
        p[0] = d[0] * a_h; p[1] = p[0] + d[1] * a_h; p[2] = p[1] + d[2] * a_h; p[3] = p[2] + d[3] * a_h;
        float sc = p[3];
#pragma unroll
        for (int o = 1; o < 32; o <<= 1) { const float v = __shfl_up(sc, o); if ((lane & 31) >= o) sc += v; }
        const float ex = sc - p[3];
        *(LAS f32x4*)(lds + L_CSALL + tid * 16) = (f32x4){ex + p[0], ex + p[1], ex + p[2], ex + p[3]}; *(LAS f32x4*)(lds + L_DTALL + tid * 16) = (f32x4){d[0], d[1], d[2], d[3]};
    }
    WG_BAR();
    for (int chunk = 0; chunk < 16; ++chunk) {
        const int t0 = chunk * 128; const size_t row0 = (size_t)b * SEQ + t0;
        unsigned char* wsl = ws; asm volatile("" : "+s"(wsl));
        bf16* proj = (bf16*)(wsl + WS_BIG); const float* const* tab = (const float* const*)(wsl + WS_TAB);
        const LAS float* csA = (const LAS float*)(lds + L_CSALL) + t0; const LAS float* dtA = (const LAS float*)(lds + L_DTALL) + t0;
        {
            int tl = tid; asm volatile("" : "+v"(tl)); const int cgp = tl & 31, ts = tl >> 5; const bool isB = cgp < 16;
            const bf16* src = proj + BC2_OFF + (row0 + 8 * ts) * 512 + (isB ? 0 : 256) + g * 128 + (cgp & 15) * 8;
            v4u raw[8];
#pragma unroll
            for (int s = 0; s < 8; ++s) raw[s] = *(const GAS v4u*)(src + (size_t)s * 512);
#pragma unroll
            for (int s = 0; s < 8; ++s) *(LAS v4u*)(lds + (isB ? L_B : L_C) + (8 * ts + s) * P2 + (cgp & 15) * 16) = raw[s];
            if (isB) {
                float val[8][8], wj[8];
#pragma unroll
                for (int s = 0; s < 8; ++s) { unpack8(raw[s], val[s]); wj[s] = dtA[8 * ts + s] * __expf(csA[127] - csA[8 * ts + s]); }
#pragma unroll
                for (int c = 0; c < 8; ++c) { v4u o; o.x = pk2(val[0][c] * wj[0], val[1][c] * wj[1]); o.y = pk2(val[2][c] * wj[2], val[3][c] * wj[3]); o.z = pk2(val[4][c] * wj[4], val[5][c] * wj[5]); o.w = pk2(val[6][c] * wj[6], val[7][c] * wj[7]);
                    *(LAS v4u*)(lds + L_BWT + ((cgp & 15) * 8 + c) * P2 + (8 * ts) * 2) = o; }
            }
        }
        {
            const int cg8 = xcg8, ts = xts, col = OFF_XA + h * 64 + cg8 * 8;
            v4u raw[5];
#pragma unroll
            for (int s = 0; s < 5; ++s) { const int t = t0 + 2 * ts + s - 3; const v4u t_ = *(const GAS v4u*)(proj + ((size_t)b * SEQ + (t >= 0 ? t : 0)) * PL + col); const unsigned mk = (t >= 0) ? 0xffffffffu : 0u; raw[s] = (v4u){t_.x & mk, t_.y & mk, t_.z & mk, t_.w & mk}; }
            float val[2][8];
#pragma unroll
            for (int s = 0; s < 2; ++s) {
#pragma unroll
                for (int c = 0; c < 8; ++c) val[s][c] = xbias[c];
#pragma unroll
                for (int k = 0; k < 4; ++k) { float f[8]; unpack8(raw[s + k], f);
#pragma unroll
                    for (int c = 0; c < 8; ++c) val[s][c] += xw[k][c] * f[c]; }
#pragma unroll
                for (int c = 0; c < 8; ++c) val[s][c] = silu_f(val[s][c]);
            }
#pragma unroll
            for (int c = 0; c < 8; ++c) *(LAS unsigned*)(lds + L_XT + (cg8 * 8 + c) * P2 + (2 * ts) * 2) = pk2(val[0][c], val[1][c]);
        }
        WG_BAR();
        const int irow = 16 * wid + fr;
        v2u zr[4];
#pragma unroll
        for (int pt = 0; pt < 4; ++pt) zr[pt] = *(const GAS v2u*)(proj + (row0 + irow) * PL + OFF_Z + h * 64 + 16 * pt + 4 * fq);
        f32x4 cbv[8], yo[4];
#pragma unroll
        for (int i = 0; i < 8; ++i) cbv[i] = (f32x4){0.f, 0.f, 0.f, 0.f};
#pragma unroll
        for (int i = 0; i < 4; ++i) yo[i] = (f32x4){0.f, 0.f, 0.f, 0.f};
        { const float cd = __expf(csA[127]);
#pragma unroll
          for (int i = 0; i < 4; ++i) S[i] = S[i] * cd; }
#pragma unroll
        for (int kk = 0; kk < 4; ++kk) {
            const bf16x8 cf = LDF(L_C + irow * P2 + kk * 64 + fq * 16);
#pragma unroll
            for (int jt = 0; jt < 8; ++jt) cbv[jt] = MFMA16(LDF(L_B + (16 * jt + fr) * P2 + kk * 64 + fq * 16), cf, cbv[jt]);
#pragma unroll
            for (int pt = 0; pt < 4; ++pt) yo[pt] = MFMA16(LDF(L_S + (16 * pt + fr) * P2 + kk * 64 + fq * 16), cf, yo[pt]);
            const bf16x8 xf = LDF(L_XT + (p0 + fr) * P2 + kk * 64 + fq * 16);
#pragma unroll
            for (int nt = 0; nt < 4; ++nt) S[nt] = MFMA16(LDF(L_BWT + (n0 + 16 * nt + fr) * P2 + kk * 64 + fq * 16), xf, S[nt]);
        }
        WG_BAR();
        const float csi = csA[irow];
#pragma unroll
        for (int jt = 0; jt < 8; ++jt) { const int j0 = 16 * jt + 4 * fq; const f32x4 csj = *(const LAS f32x4*)(csA + j0), dtj = *(const LAS f32x4*)(dtA + j0); float gv[4];
#pragma unroll
            for (int r = 0; r < 4; ++r) gv[r] = (j0 + r <= irow) ? cbv[jt][r] * __expf(csi - csj[r]) * dtj[r] : 0.f;
            v2u o; o.x = pk2(gv[0], gv[1]); o.y = pk2(gv[2], gv[3]); *(LAS v2u*)(lds + L_B + irow * P2 + j0 * 2) = o; }
#pragma unroll
        for (int nt = 0; nt < 4; ++nt) { v2u o; o.x = pk2(S[nt][0], S[nt][1]); o.y = pk2(S[nt][2], S[nt][3]); *(LAS v2u*)(lds + L_S + (p0 + fr) * P2 + (n0 + 16 * nt + 4 * fq) * 2) = o; }
        WG_BAR();
        { const float ei = __expf(csi); f32x4 y[4]; float* gss = (float*)(wsl + WS_GSS);
#pragma unroll
          for (int pt = 0; pt < 4; ++pt) y[pt] = yo[pt] * ei;
#pragma unroll
          for (int kk = 0; kk < 4; ++kk) { const bf16x8 gf = LDF(L_B + irow * P2 + kk * 64 + fq * 16);
#pragma unroll
              for (int pt = 0; pt < 4; ++pt) y[pt] = MFMA16(LDF(L_XT + (16 * pt + fr) * P2 + kk * 64 + fq * 16), gf, y[pt]); }
          float ss = 0.f;
#pragma unroll
          for (int pt = 0; pt < 4; ++pt) { float o[4]; const float zf[4] = {bflo(zr[pt].x), bfhi(zr[pt].x), bflo(zr[pt].y), bfhi(zr[pt].y)};
#pragma unroll
              for (int r = 0; r < 4; ++r) { const int p = 16 * pt + 4 * fq + r; const float xv = bf1(*(const LAS bf16*)(lds + L_XT + p * P2 + irow * 2));
                  const float yv = (y[pt][r] + d_h * xv) * silu_f(zf[r]); o[r] = yv; ss += yv * yv; }
              v2u w; w.x = pk2(o[0], o[1]); w.y = pk2(o[2], o[3]); if (!DRY) *(GAS v2u*)(proj + (row0 + irow) * PL + OFF_Z + h * 64 + 16 * pt + 4 * fq) = w; }
          ss += __shfl_xor(ss, 16); ss += __shfl_xor(ss, 32);
          if (fq == 0 && !DRY) ((GAS float*)gss)[(row0 + irow) * 16 + h] = ss; }
        WG_BAR();
    }
}
constexpr int P1 = 144;
constexpr int L_WRA = 0, L_WIX = 9216, L_XBM = 18432, L_AS = 36864, L_US = 71680, L_SEGA = 106496, L_SEGH = 108544, L_CARRY = 110592;
__device__ __forceinline__ void lru_unit(LAS unsigned char* lds, int b, int blk, int j, unsigned char* ws, const bool DRY) {
    int tid_ = threadIdx.x; asm volatile("" : "+v"(tid_));
    const int tid = tid_, wid = __builtin_amdgcn_readfirstlane(tid >> 6), lane = tid & 63, fr = lane & 15, fq = lane >> 4;
    const int cbase = blk * 64;
    const float* const* tab = (const float* const*)(ws + WS_TAB);
    const float* cw = tab[17] + (size_t)j * 4 * 1024; const float* cb = tab[18] + (size_t)j * 1024; const float* wra = tab[19] + ((size_t)j * 16 + blk) * 4096; const float* wix = tab[21] + ((size_t)j * 16 + blk) * 4096;
    const float* bra = tab[20] + (size_t)j * 1024; const float* bix = tab[22] + (size_t)j * 1024; const float* lam = tab[23] + (size_t)j * 1024;
    for (int q = 0; q < 8; ++q) { const int e = tid + 512 * q, i = e >> 6, j = e & 63;
        *(LAS bf16*)(lds + L_WRA + j * P1 + i * 2) = (bf16)(pk2(wra[e], 0.f) & 0xffffu); *(LAS bf16*)(lds + L_WIX + j * P1 + i * 2) = (bf16)(pk2(wix[e], 0.f) & 0xffffu); }
    if (tid < 128) ((LAS float*)(lds + L_CARRY))[tid] = 0.f;
    f32x4 braV[4], bixV[4], spV[4];
#pragma unroll
    for (int jt = 0; jt < 4; ++jt) { const int j0 = cbase + 16 * jt + 4 * fq; braV[jt] = *(const f32x4*)(bra + j0); bixV[jt] = *(const f32x4*)(bix + j0); const f32x4 lv = *(const f32x4*)(lam + j0);
#pragma unroll
        for (int r = 0; r < 4; ++r) { const float x = -lv[r]; spV[jt][r] = -8.0f * (x > 20.f ? x : log1pf(__expf(x))); } }
    const int cg8 = tid & 7, ts = tid >> 3, cch = cbase + cg8 * 8;
    float w[4][8], bias[8];
#pragma unroll
    for (int k = 0; k < 4; ++k) { const f32x4 wa = *(const f32x4*)(cw + k * 1024 + cch), wb = *(const f32x4*)(cw + k * 1024 + cch + 4);
        w[k][0] = wa.x; w[k][1] = wa.y; w[k][2] = wa.z; w[k][3] = wa.w; w[k][4] = wb.x; w[k][5] = wb.y; w[k][6] = wb.z; w[k][7] = wb.w; }
    { const f32x4 ba = *(const f32x4*)(cb + cch), bb = *(const f32x4*)(cb + cch + 4); bias[0] = ba.x; bias[1] = ba.y; bias[2] = ba.z; bias[3] = ba.w; bias[4] = bb.x; bias[5] = bb.y; bias[6] = bb.z; bias[7] = bb.w; }
    WG_BAR();
    for (int tile = 0; tile < 16; ++tile) {
        const int t0 = tile * 128; const size_t row0 = (size_t)b * SEQ + t0;
        unsigned char* wsl = ws; asm volatile("" : "+s"(wsl)); bf16* proj = (bf16*)(wsl + WS_BIG);
        {
            v4u raw[5];
#pragma unroll
            for (int s = 0; s < 5; ++s) { const int t = t0 + 2 * ts + s - 3; const v4u t_ = *(const GAS v4u*)(proj + ((size_t)b * SEQ + (t >= 0 ? t : 0)) * PL + OFF_XB + cch); const unsigned mk = (t >= 0) ? 0xffffffffu : 0u; raw[s] = (v4u){t_.x & mk, t_.y & mk, t_.z & mk, t_.w & mk}; }
#pragma unroll
            for (int s = 0; s < 2; ++s) { float val[8];
#pragma unroll
                for (int c = 0; c < 8; ++c) val[c] = bias[c];
#pragma unroll
                for (int k = 0; k < 4; ++k) { float f[8]; unpack8(raw[s + k], f);
#pragma unroll
                    for (int c = 0; c < 8; ++c) val[c] += w[k][c] * f[c]; }
                v4u o; o.x = pk2(val[0], val[1]); o.y = pk2(val[2], val[3]); o.z = pk2(val[4], val[5]); o.w = pk2(val[6], val[7]);
                *(LAS v4u*)(lds + L_XBM + (2 * ts + s) * P1 + cg8 * 16) = o; }
        }
        WG_BAR();
        {
            const int trow = 16 * wid + fr; f32x4 R[4], I[4];
#pragma unroll
            for (int i = 0; i < 4; ++i) { R[i] = (f32x4){0.f, 0.f, 0.f, 0.f}; I[i] = R[i]; }
#pragma unroll
            for (int kk = 0; kk < 2; ++kk) { const bf16x8 xf = LDF(L_XBM + trow * P1 + kk * 64 + fq * 16);
#pragma unroll
                for (int jt = 0; jt < 4; ++jt) { R[jt] = MFMA16(LDF(L_WRA + (16 * jt + fr) * P1 + kk * 64 + fq * 16), xf, R[jt]); I[jt] = MFMA16(LDF(L_WIX + (16 * jt + fr) * P1 + kk * 64 + fq * 16), xf, I[jt]); } }
#pragma unroll
            for (int jt = 0; jt < 4; ++jt) { const v2u xw = *(const LAS v2u*)(lds + L_XBM + trow * P1 + (16 * jt + 4 * fq) * 2); const float xb[4] = {bflo(xw.x), bfhi(xw.x), bflo(xw.y), bfhi(xw.y)}; f32x4 av, uv;
#pragma unroll
                for (int r = 0; r < 4; ++r) { const float rg = sigmoid_f(R[jt][r] + braV[jt][r]), ig = sigmoid_f(I[jt][r] + bixV[jt][r]); const float la = rg * spV[jt][r];
                    av[r] = __expf(la); uv[r] = __builtin_amdgcn_sqrtf(fmaxf(1.0f - __expf(2.0f * la), 0.f)) * ig * xb[r]; }
                *(LAS f32x4*)(lds + L_AS + trow * P2 + (16 * jt + 4 * fq) * 4) = av; *(LAS f32x4*)(lds + L_US + trow * P2 + (16 * jt + 4 * fq) * 4) = uv; }
        }
        WG_BAR();
        {
            const int c = lane; bf16 gv[16];
#pragma unroll
            for (int s = 0; s < 16; ++s) gv[s] = ((const GAS bf16*)proj)[(row0 + 16 * wid + s) * PL + OFF_GATE + cbase + c];
            float hl = 0.f, ap = 1.f;
#pragma unroll
            for (int s = 0; s < 16; ++s) { LAS float* pa = (LAS float*)(lds + L_AS + (16 * wid + s) * P2) + c; LAS float* pu = (LAS float*)(lds + L_US + (16 * wid + s) * P2) + c;
                const float av = *pa, uv = *pu; hl = av * hl + uv; ap *= av; *pu = hl; *pa = ap; }
            ((LAS float*)(lds + L_SEGA))[wid * 64 + c] = ap; ((LAS float*)(lds + L_SEGH))[wid * 64 + c] = hl;
            WG_BAR();
            float hin = ((LAS float*)(lds + L_CARRY))[(tile & 1) * 64 + c];
            for (int q = 0; q < wid; ++q) hin = ((LAS float*)(lds + L_SEGA))[q * 64 + c] * hin + ((LAS float*)(lds + L_SEGH))[q * 64 + c];
            if (wid == 7) ((LAS float*)(lds + L_CARRY))[((tile + 1) & 1) * 64 + c] = ap * hin + hl;
#pragma unroll
            for (int s = 0; s < 16; ++s) { const float hv = ((LAS float*)(lds + L_US + (16 * wid + s) * P2))[c] + ((LAS float*)(lds + L_AS + (16 * wid + s) * P2))[c] * hin;
                const float x = bf1(gv[s]); const float ge = x * sigmoid_f(1.5957691216057308f * (x + 0.044715f * x * x * x));
                if (!DRY) ((GAS bf16*)proj)[(row0 + 16 * wid + s) * PL + OFF_GATE + cbase + c] = (bf16)(pk2(ge * hv, 0.f) & 0xffffu); }
        }
        WG_BAR();
    }
}
__device__ __forceinline__ void ssd_norm_pass(bf16* proj, const float* gss, const float* nw, int gw, int NGW, int lane) {
    const f32x4 w0a = *(const f32x4*)(nw + lane * 8), w0b = *(const f32x4*)(nw + lane * 8 + 4), w1a = *(const f32x4*)(nw + 512 + lane * 8), w1b = *(const f32x4*)(nw + 512 + lane * 8 + 4);
    for (int m0 = gw; m0 < M; m0 += 4 * NGW) {
        f32x4 ga[4], gb[4], gc[4], gd[4]; v4u a[4], c[4];
#pragma unroll
        for (int q = 0; q < 4; ++q) { const int m = m0 + q * NGW; if (m < M) { const f32x4* gp = (const f32x4*)(gss + (size_t)m * 16); ga[q] = gp[0]; gb[q] = gp[1]; gc[q] = gp[2]; gd[q] = gp[3];
            const bf16* rp = proj + (size_t)m * PL; a[q] = *(const v4u*)(rp + lane * 8); c[q] = *(const v4u*)(rp + 512 + lane * 8); } }
#pragma unroll
        for (int q = 0; q < 4; ++q) { const int m = m0 + q * NGW; if (m < M) { bf16* rp = proj + (size_t)m * PL;
            const float r0 = __builtin_amdgcn_rsqf((((ga[q][0] + ga[q][1]) + (ga[q][2] + ga[q][3])) + ((gb[q][0] + gb[q][1]) + (gb[q][2] + gb[q][3]))) * (1.0f / 512.0f) + EPS), r1 = __builtin_amdgcn_rsqf((((gc[q][0] + gc[q][1]) + (gc[q][2] + gc[q][3])) + ((gd[q][0] + gd[q][1]) + (gd[q][2] + gd[q][3]))) * (1.0f / 512.0f) + EPS);
            float f[8]; v4u o;
            unpack8(a[q], f); o.x = pk2(f[0] * r0 * w0a.x, f[1] * r0 * w0a.y); o.y = pk2(f[2] * r0 * w0a.z, f[3] * r0 * w0a.w); o.z = pk2(f[4] * r0 * w0b.x, f[5] * r0 * w0b.y); o.w = pk2(f[6] * r0 * w0b.z, f[7] * r0 * w0b.w); *(v4u*)(rp + lane * 8) = o;
            unpack8(c[q], f); o.x = pk2(f[0] * r1 * w1a.x, f[1] * r1 * w1a.y); o.y = pk2(f[2] * r1 * w1a.z, f[3] * r1 * w1a.w); o.z = pk2(f[4] * r1 * w1b.x, f[5] * r1 * w1b.y); o.w = pk2(f[6] * r1 * w1b.z, f[7] * r1 * w1b.w); *(v4u*)(rp + 512 + lane * 8) = o; } }
    }
}
__device__ __forceinline__ void diff_combine_pass(bf16* O, const float* lq1, const float* lk1, const float* lq2, const float* lk2, const float* subln, float lambda_init, int gw, int NGW, int lane) {
    const float lamv = __expf(wave_sum(lq1[lane] * lk1[lane])) - __expf(wave_sum(lq2[lane] * lk2[lane])) + lambda_init;
    const int e0 = (lane & 15) * 8; const f32x4 wa = *(const f32x4*)(subln + e0), wb = *(const f32x4*)(subln + e0 + 4); const float os = 1.0f - lambda_init;
    for (int m0 = gw; m0 < M; m0 += 4 * NGW) {
        v4u a[4][2], c[4][2];
#pragma unroll
        for (int q = 0; q < 4; ++q) { const int m = m0 + q * NGW; if (m < M) { const bf16* rp = O + (size_t)m * 2048;
#pragma unroll
            for (int hf = 0; hf < 2; ++hf) { a[q][hf] = *(const v4u*)(rp + hf * 512 + lane * 8); c[q][hf] = *(const v4u*)(rp + 1024 + hf * 512 + lane * 8); } } }
#pragma unroll
        for (int q = 0; q < 4; ++q) { const int m = m0 + q * NGW; if (m < M) { bf16* rp = O + (size_t)m * 2048;
#pragma unroll
            for (int hf = 0; hf < 2; ++hf) { const int col = hf * 512 + lane * 8; float f1[8], f2[8], o[8]; unpack8(a[q][hf], f1); unpack8(c[q][hf], f2); float ss = 0.f;
#pragma unroll
                for (int i = 0; i < 8; ++i) { o[i] = f1[i] - lamv * f2[i]; ss += o[i] * o[i]; }
                ss += __shfl_xor(ss, 1); ss += __shfl_xor(ss, 2); ss += __shfl_xor(ss, 4); ss += __shfl_xor(ss, 8);
                const float rs = os * __builtin_amdgcn_rsqf(ss * (1.0f / 128.0f) + EPS);
                v4u w; w.x = pk2(o[0] * rs * wa.x, o[1] * rs * wa.y); w.y = pk2(o[2] * rs * wa.z, o[3] * rs * wa.w); w.z = pk2(o[4] * rs * wb.x, o[5] * rs * wb.y); w.w = pk2(o[6] * rs * wb.z, o[7] * rs * wb.w);
                *(v4u*)(rp + col) = w; } } }
    }
}
__device__ __forceinline__ void final_norm_pass(float* out, const bf16* HB, const unsigned* LO, const float* rowss, const float* nw, int gw, int NGW, int lane) {
    const f32x4 wa = *(const f32x4*)(nw + lane * 8), wb = *(const f32x4*)(nw + lane * 8 + 4), wc = *(const f32x4*)(nw + 512 + lane * 8), wd = *(const f32x4*)(nw + 512 + lane * 8 + 4);
    for (int m0 = gw; m0 < M; m0 += 4 * NGW) {
        v4u a[4], c[4]; unsigned la[4], lc[4]; float rs[4];
#pragma unroll
        for (int q = 0; q < 4; ++q) { const int m = m0 + q * NGW; if (m < M) { const bf16* hp = HB + (size_t)m * 1024; a[q] = *(const v4u*)(hp + lane * 8); c[q] = *(const v4u*)(hp + 512 + lane * 8);
#if RESID_LO
            const unsigned* lp = LO + (size_t)m * 128; la[q] = lp[lane]; lc[q] = lp[64 + lane];
#else
            la[q] = 0u; lc[q] = 0u;
#endif
            rs[q] = pg8::rstd_of(rowss, m); } }
#pragma unroll
        for (int q = 0; q < 4; ++q) { const int m = m0 + q * NGW; if (m < M) { float* op = out + (size_t)m * 1024; float f[8]; const float r = rs[q];
            pg8::EpiResid::dec8(a[q], la[q], f); __builtin_nontemporal_store((f32x4){f[0] * r * wa.x, f[1] * r * wa.y, f[2] * r * wa.z, f[3] * r * wa.w}, (f32x4*)(op + lane * 8)); __builtin_nontemporal_store((f32x4){f[4] * r * wb.x, f[5] * r * wb.y, f[6] * r * wb.z, f[7] * r * wb.w}, (f32x4*)(op + lane * 8 + 4));
            pg8::EpiResid::dec8(c[q], lc[q], f); __builtin_nontemporal_store((f32x4){f[0] * r * wc.x, f[1] * r * wc.y, f[2] * r * wc.z, f[3] * r * wc.w}, (f32x4*)(op + 512 + lane * 8)); __builtin_nontemporal_store((f32x4){f[4] * r * wd.x, f[5] * r * wd.y, f[6] * r * wd.z, f[7] * r * wd.w}, (f32x4*)(op + 512 + lane * 8 + 4)); } }
    }
}
typedef GAS unsigned gu32;
constexpr size_t WS_CTL = 0, CTL_ZERO_BYTES = 64 * 1024;
constexpr int XB_MISC_OFF = LDS_BYTES - 64;
#define XB_TMO      128
#define XB_XCNT(j)  (256  + 64 * (j))
#define XB_XSUB(j)  (1280 + 64 * (j))
#define XB_XGEN(j)  (2304 + 64 * (j))
#define XB_TOP      3328
#define XB_TOPGEN   3392
#define XCD_BAR_WORDS 3456
#define XB_SPIN_CAP (1u << 18)

__device__ __forceinline__ unsigned xb_ld(unsigned* p)              { return __hip_atomic_load(p, __ATOMIC_RELAXED, __HIP_MEMORY_SCOPE_AGENT); }
__device__ __forceinline__ unsigned xb_add(unsigned* p, unsigned v) { return __hip_atomic_fetch_add(p, v, __ATOMIC_RELAXED, __HIP_MEMORY_SCOPE_AGENT); }
__device__ __forceinline__ unsigned xb_xcc_id() { return (unsigned)__builtin_amdgcn_s_getreg((3 << 11) | 20) & 0xFu; }
#define XB_SPIN(cond, bar) do { unsigned _sp = 0; while (cond) { __builtin_amdgcn_s_sleep(1); \
    if ((++_sp & 255u) == 0u) { if (xb_ld(&(bar)[XB_TMO])) break; if (_sp > XB_SPIN_CAP) { atomicAdd(&(bar)[XB_TMO], 1u); break; } } } } while (0)

struct XcdBarrier {
    unsigned* bar; unsigned x;
    volatile LAS unsigned* st;
};

__device__ __forceinline__ XcdBarrier xcd_barrier_post(unsigned* bar, volatile LAS unsigned* st) {
    XcdBarrier b; b.bar = bar; b.x = xb_xcc_id(); b.st = st;
    if (threadIdx.x == 0) (void)xb_add(&bar[XB_XCNT(b.x)], 1u);
    return b;
}
__device__ __forceinline__ void xcd_barrier_complete(unsigned* bar, unsigned x, unsigned& nloc, unsigned& nx) {
    const unsigned G = gridDim.x * gridDim.y * gridDim.z;
    unsigned sum, cnt, mine, sp = 0u;
    for (;;) {
        sum = 0u; cnt = 0u; mine = 0u;
#pragma unroll
        for (unsigned j = 0; j < 16; ++j) { const unsigned c = xb_ld(&bar[XB_XCNT(j)]); sum += c; cnt += (c > 0u) ? 1u : 0u; mine = (j == x) ? c : mine; }
        if (sum == G) break;
        __builtin_amdgcn_s_sleep(1);
        if ((++sp & 255u) == 0u) { if (xb_ld(&bar[XB_TMO])) break; if (sp > XB_SPIN_CAP) { atomicAdd(&bar[XB_TMO], 1u); break; } }
    }
    nloc = mine > 0u ? mine : 1u; nx = cnt > 0u ? cnt : 1u;
}

__device__ __forceinline__ void xcd_barrier(const XcdBarrier& b) {
    asm volatile("s_waitcnt vmcnt(0)" ::: "memory");
    __syncthreads();
    if (threadIdx.x == 0) {
        unsigned* bar = b.bar;
        __builtin_amdgcn_s_waitcnt(0);
        unsigned nloc = b.st[0], nx = b.st[1];
        if (nloc == 0u) { xcd_barrier_complete(bar, b.x, nloc, nx); b.st[0] = nloc; b.st[1] = nx; }
        const unsigned old = xb_add(&bar[XB_XSUB(b.x)], 1u);
        const unsigned gen = old / nloc;
        if (old + 1u == (gen + 1u) * nloc) {
            __builtin_amdgcn_fence(__ATOMIC_RELEASE, "agent");
            asm volatile("s_waitcnt vmcnt(0)" ::: "memory");
            const unsigned og = xb_add(&bar[XB_TOP], 1u);
            const unsigned tg = og / nx;
            if (og + 1u == (tg + 1u) * nx) xb_add(&bar[XB_TOPGEN], 1u);
            else XB_SPIN(xb_ld(&bar[XB_TOPGEN]) == tg, bar);
            __builtin_amdgcn_fence(__ATOMIC_ACQUIRE, "agent");
            xb_add(&bar[XB_XGEN(b.x)], 1u);
            asm volatile("s_waitcnt vmcnt(0)" ::: "memory");
        } else {
            XB_SPIN(xb_ld(&bar[XB_XGEN(b.x)]) == gen, bar);
            __builtin_amdgcn_fence(__ATOMIC_ACQUIRE, "agent");
            asm volatile("s_waitcnt vmcnt(0)" ::: "memory");
        }
    }
    __syncthreads();
}
__global__ void __launch_bounds__(NWAVES * 64, 2) mega_fwd(Args a) {
    extern __shared__ __attribute__((aligned(16))) unsigned char lds_raw[];
    LAS unsigned char* lds = (LAS unsigned char*)lds_raw;
    cg::grid_group grid = cg::this_grid();
    if (threadIdx.x < 16) ((LAS unsigned*)(lds + XB_MISC_OFF))[threadIdx.x] = 0u;
    __syncthreads();
    { XcdBarrier b0 = xcd_barrier_post((unsigned*)(a.ws + WS_CTL), (volatile LAS unsigned*)(lds + XB_MISC_OFF)); (void)b0; }
#define GSYNC() do { XcdBarrier xb_; xb_.bar = (unsigned*)(a.ws + WS_CTL); xb_.x = xb_xcc_id(); xb_.st = (volatile LAS unsigned*)(lds + XB_MISC_OFF); xcd_barrier(xb_); } while (0)
#define PHASE_ENV() \
    int tidL = threadIdx.x; asm volatile("" : "+v"(tidL)); const int tid = tidL, lane = tid & 63, wave = __builtin_amdgcn_readfirstlane(tid >> 6); \
    int G = gridDim.x, bx = blockIdx.x; asm volatile("" : "+s"(G), "+s"(bx)); const int vcu = (G % 8 == 0) ? (bx % 8) * (G / 8) + bx / 8 : bx; \
    const int gw = vcu * NWAVES + wave, NGW = G * NWAVES, gtid = bx * (NWAVES * 64) + tid, NGT = G * NWAVES * 64; \
    unsigned char* ws = a.ws; asm volatile("" : "+s"(ws)); \
    float* rowss = (float*)(ws + WS_ROWSS); float* gssb = (float*)(ws + WS_GSS); const float* rope = (const float*)(ws + WS_ROPE); float* dtb = (float*)(ws + WS_DT); \
    bf16* HB = (bf16*)(ws + WS_HB); bf16* BIG = (bf16*)(ws + WS_BIG); \
    bf16* GU1 = (bf16*)(ws + WS_WB + WB_GU1); bf16* D1 = (bf16*)(ws + WS_WB + WB_D1); bf16* GU2 = (bf16*)(ws + WS_WB + WB_GU2); bf16* D2 = (bf16*)(ws + WS_WB + WB_D2); \
    bf16* MI = (bf16*)(ws + WS_WB + WB_MI); bf16* MO = (bf16*)(ws + WS_WB + WB_MO); \
    (void)gw; (void)NGW; (void)gtid; (void)NGT; (void)rowss; (void)gssb; (void)rope; (void)dtb; (void)HB; (void)BIG; (void)GU1; (void)D1; (void)GU2; (void)D2; (void)MI; (void)MO; (void)lane; (void)vcu;
    grid.sync();
    { PHASE_ENV()
    prologue(a, lds, gw, NGW, wave, lane, gtid, NGT); }
    GSYNC();
    for (int lo = 0; lo < DEPTH; ++lo) {
#ifdef DUP_MIX
      for (int opx = (lo == 0) ? 1 : 0; opx < 10; ++opx) { const int op = opx < 5 ? opx : opx - 1; bool dry = (opx == 4);
        if (dry && (lo & 1)) continue;
#else
      for (int op = (lo == 0) ? 1 : 0; op < 10; ++op) { const bool dry = false;
#endif
        int l = lo; asm volatile("" : "+s"(l));
        const int j = l >> 1; const bool even = (l & 1) == 0;
        switch (op) {
        case 0: { PHASE_ENV() const float* const* tab = (const float* const*)(ws + WS_TAB);
            convert_layer(FromTab{tab}, ws, l, lds, gw, NGW, wave, lane); } break;
        case 1: case 8: { PHASE_ENV() const int hf = (op == 8);
            pg8::Gemm g{HB, hf ? GU2 : GU1, M, 2 * DFF, 1024, 1024}; pg8::StaticOrder S; S.init(M, 2 * DFF, G, bx);
            pg8::EpiSwiglu E{BIG, pg8::build_rstd(lds + 131072, rowss + (size_t)((3 * l + 2 * hf) & 1) * M * 16, S)};
#ifdef DUP_GU
            for (int rp = 0; rp < 2; ++rp)
#endif
            pg8::gemm_phase<pg8::EpiSwiglu, pg8::StaticOrder, true, true, 1024, 1024>(lds, g, S, E); } break;
        case 2: case 9: { PHASE_ENV() const float* const* tab = (const float* const*)(ws + WS_TAB);
            pg8::Gemm g{BIG, (op == 2) ? D1 : D2, M, 1024, DFF, DFF}; pg8::StaticOrder S; S.init(M, 1024, G, bx);
            pg8::EpiResid E{HB, (unsigned*)(ws + WS_LO), rowss + (size_t)(((op == 2) ? 3 * l + 1 : 3 * l + 3) & 1) * M * 16, 0.5f};
#ifdef DUP_RESID
            for (int rp = 0; rp < 2; ++rp) { E.scale = rp ? 0.5f : 0.f;
#endif
            pg8::gemm_phase<pg8::EpiResid, pg8::StaticOrder, true, false, DFF, DFF>(lds, g, S, E);
#ifdef DUP_RESID
            }
#endif
            } break;
        case 3: { PHASE_ENV()
            if (even) { pg8::Gemm g{HB, MI, M, 4864, 1024, 1024}; pg8::StaticOrder S; S.init(M, 4864, G, bx);
                pg8::EpiProj E{BIG, dtb, pg8::build_rstd(lds + 131072, rowss + (size_t)((3 * l + 1) & 1) * M * 16, S)};
                pg8::gemm_phase<pg8::EpiProj, pg8::StaticOrder, true, true, 1024, 1024>(lds, g, S, E); }
            else { pg8::Gemm g{HB, MI, M, 3072, 1024, 1024}; pg8::StaticOrder S; S.init(M, 3072, G, bx);
                pg8::EpiQkv E{BIG, pg8::build_rstd(lds + 131072, rowss + (size_t)((3 * l + 1) & 1) * M * 16, S), rope, attn_body::C2};
                pg8::gemm_phase<pg8::EpiQkv, pg8::StaticOrder, true, true, 1024, 1024>(lds, g, S, E); } } break;
        case 4: { if (!even) continue;
            PHASE_ENV() const float* const* tab = (const float* const*)(ws + WS_TAB);
            bc_preconv_pass(BIG, tab[11] + (size_t)j * 4 * 1536, tab[12] + (size_t)j * 1536, gtid, NGT); } break;
        case 5: {
            if (even) { int G = gridDim.x, bx = blockIdx.x; asm volatile("" : "+s"(G), "+s"(bx)); const int vcu = (G % 8 == 0) ? (bx % 8) * (G / 8) + bx / 8 : bx;
                for (int u = vcu; u < 256; u += G) { const int b = u >> 4, h = u & 15; unsigned char* wsu = a.ws; asm volatile("" : "+s"(wsu));
#if defined(DUP_SSD) || defined(DUP_LRU)
                    for (int rp = 0; rp < 2; ++rp) { int dr = (rp == 0); asm volatile("" : "+s"(dr));
#ifndef DUP_LRU
                    ssd_unit(lds, b, h, j, wsu, dr != 0);
#else
                    if (!dr) ssd_unit(lds, b, h, j, wsu, false);
#endif
#ifndef DUP_SSD
                    lru_unit(lds, b, h, j, wsu, dr != 0);
#else
                    if (!dr) lru_unit(lds, b, h, j, wsu, false);
#endif
                    }
#else
                    ssd_unit(lds, b, h, j, wsu, dry);
                    lru_unit(lds, b, h, j, wsu, dry);
#endif
                } }
            else {
#ifndef NO_ATTN
                int G = gridDim.x, bx = blockIdx.x; asm volatile("" : "+s"(G), "+s"(bx)); const int vcu = (G % 8 == 0) ? (bx % 8) * (G / 8) + bx / 8 : bx;
                unsigned char* wsu = a.ws; asm volatile("" : "+s"(wsu)); bf16* BIG = (bf16*)(wsu + WS_BIG);
                const attn_body::AttnTensors AT{(const attn_body::bf16*)BIG, (const attn_body::bf16*)(BIG + (size_t)M * 1024), (const attn_body::bf16*)(BIG + (size_t)2 * M * 1024), (attn_body::bf16*)(BIG + (size_t)3 * M * 1024)};
                attn_body::attn_phase<8>((char*)lds_raw, AT, vcu, G);
#ifdef DUP_ATTN
                attn_body::attn_phase<8>((char*)lds_raw, AT, vcu, G);
#endif
#endif
            } } break;
        case 6: { PHASE_ENV() const float* const* tab = (const float* const*)(ws + WS_TAB);
            if (even) ssd_norm_pass(BIG, gssb, tab[16] + (size_t)j * 1024, gw, NGW, lane);
            else diff_combine_pass(BIG + (size_t)3 * M * 1024, tab[26] + j * 64, tab[27] + j * 64, tab[28] + j * 64, tab[29] + j * 64, tab[30] + j * 128, 0.8f - 0.6f * expf(-0.3f * (float)l), gw, NGW, lane); } break;
        default: { PHASE_ENV() const float* const* tab = (const float* const*)(ws + WS_TAB);
            pg8::StaticOrder S; S.init(M, 1024, G, bx);
            pg8::EpiResid E{HB, (unsigned*)(ws + WS_LO), rowss + (size_t)((3 * l + 2) & 1) * M * 16, 1.0f};
            if (even) { pg8::Gemm g{BIG, MO, M, 1024, 2048, PL}; pg8::gemm_phase<pg8::EpiResid, pg8::StaticOrder, true, true, 2048, PL>(lds, g, S, E); }
            else { pg8::Gemm g{BIG + (size_t)3 * M * 1024, MO, M, 1024, 1024, 2048}; pg8::gemm_phase<pg8::EpiResid, pg8::StaticOrder, true, true, 1024, 2048>(lds, g, S, E); } } break;
        }
        GSYNC();
#ifdef DUP_SYNC
        GSYNC(); GSYNC();
#endif
      }
    }
    { PHASE_ENV()
    const float* const* tab = (const float* const*)(ws + WS_TAB);
    final_norm_pass((float*)tab[33], HB, (const unsigned*)(ws + WS_LO), rowss, tab[32], gw, NGW, lane); }
}

extern "C" void kernel_launch(void* const* d_in, const int* in_sizes, int n_in, void* d_out, int out_size, void* d_ws, size_t ws_size, hipStream_t stream) {
    static int grid = 0;
    if (grid == 0) {
        if (n_in != 33 || out_size != M * 1024 || ws_size < WS_END) { fprintf(stderr, "kernel_launch: unexpected problem (n_in %d, out %d, ws %zu)\n", n_in, out_size, ws_size); grid = -1; return; }
        int dev = 0, cus = 0, per_cu = 0;
        if (hipGetDevice(&dev) != hipSuccess || hipDeviceGetAttribute(&cus, hipDeviceAttributeMultiprocessorCount, dev) != hipSuccess) { grid = -1; return; }
        if (hipFuncSetAttribute((const void*)mega_fwd, hipFuncAttributeMaxDynamicSharedMemorySize, LDS_BYTES) != hipSuccess) { fprintf(stderr, "kernel_launch: hipFuncSetAttribute failed\n"); grid = -1; return; }
        if (hipOccupancyMaxActiveBlocksPerMultiprocessor(&per_cu, (const void*)mega_fwd, NWAVES * 64, LDS_BYTES) != hipSuccess || per_cu < 1) { fprintf(stderr, "kernel_launch: occupancy query says %d\n", per_cu); per_cu = 1; }
        (void)hipGetLastError();
        grid = cus;
    }
    if (grid < 0) return;
    Args a{};
    for (int i = 0; i < 33; ++i) a.in[i] = (const float*)d_in[i];
    a.out = (float*)d_out; a.ws = (unsigned char*)d_ws;
    if (hipMemsetAsync((char*)d_ws + WS_CTL, 0, CTL_ZERO_BYTES, stream) != hipSuccess) { fprintf(stderr, "kernel_launch: memset failed\n"); return; }
    void* args[] = {&a};
    hipError_t e = hipLaunchCooperativeKernel((const void*)mega_fwd, dim3(grid), dim3(NWAVES * 64), args, LDS_BYTES, stream);
    if (e != hipSuccess) fprintf(stderr, "kernel_launch: cooperative launch failed: %s (grid %d)\n", hipGetErrorString(e), grid);
}
```

```cpp
#define RESID_LO 0
#include <hip/hip_runtime.h>
#include <hip/hip_cooperative_groups.h>
#include <hip/hip_bf16.h>
#include <cstdio>
#include <cstdint>
#include <cmath>
namespace cg = cooperative_groups;
namespace pg8 {
#define PG8_LAS __attribute__((address_space(3)))
typedef unsigned short bf16_t;
typedef short bf16x8 __attribute__((ext_vector_type(8)));
typedef float f32x4 __attribute__((ext_vector_type(4)));
typedef unsigned u32x4 __attribute__((ext_vector_type(4)));
constexpr int BM = 256, BK = 64, HALF = 128, HTB = HALF * BK * 2  , STAGE_BYTES = 8 * HTB, NXCD = 8, WGM = 8;

__host__ __device__ __forceinline__ int lds_byte(int r, int c) { const int st = (r >> 4) * 2 + (c >> 5), rr = r & 15, cc = c & 31, ob = rr * 64 + cc * 2; return st * 1024 + (ob ^ (((ob >> 9) & 1) << 5)); }
__host__ __device__ __forceinline__ void stage_rc(int b, int& R, int& C) { const int st = b / 1024, sb = b % 1024, swz = sb ^ (((sb >> 9) & 1) << 5); R = (st >> 1) * 16 + swz / 64; C = (st & 1) * 32 + (swz % 64) / 2; }
__host__ __device__ __forceinline__ int perm32(int rho) { const int n = rho >> 4, i = rho & 15; return 8 * (i >> 2) + 4 * n + (i & 3); }

struct Unit { int pm, pn; };
struct Gemm { const bf16_t* A; const bf16_t* Bt; int M, N, K, lda; };

struct StaticOrder {
    int nM, nN, nwg, G, c;
    __host__ __device__ void init(int M, int N, int G_, int c_) { nM = M / BM; nN = N / BM; nwg = nM * nN; G = G_; c = c_; }
    __host__ __device__ bool next(int i, Unit& u) const {
        const long L = (long)i * G + c; if (L >= nwg) return false;
        int wgid = (int)L; { const int q = nwg / NXCD, r = nwg % NXCD, xcd = wgid % NXCD, off = wgid / NXCD; wgid = (xcd < r ? xcd * (q + 1) : r * (q + 1) + (xcd - r) * q) + off; }
        const int nig = WGM * nN, gid = wgid / nig, fm = gid * WGM, gsz = (nM - fm) < WGM ? (nM - fm) : WGM;
        u.pm = fm + ((wgid % nig) % gsz); u.pn = (wgid % nig) / gsz; return true;
    }
    __device__ __forceinline__ void a_ready(const Unit&) const {}
    __device__ __forceinline__ void done(const Unit&) const {}
};

__device__ __forceinline__ unsigned cvt_pk_bf16(float lo, float hi) { unsigned r; asm volatile("v_cvt_pk_bf16_f32 %0, %1, %2" : "=v"(r) : "v"(lo), "v"(hi)); return r; }
typedef float f32x2 __attribute__((ext_vector_type(2)));
template <class Epi, class Sched, bool ALIGN_EPI = false, bool SP2 = false, int KC = 0, int LDAC = 0>
__device__ __forceinline__ void gemm_phase(PG8_LAS unsigned char* lds, const Gemm g, const Sched& S, const Epi& E) {
    int tid_ = threadIdx.x; asm volatile("" : "+v"(tid_));
    const int tid = tid_, wid = __builtin_amdgcn_readfirstlane(tid >> 6), lane = tid & 63, wr = wid >> 2, wc = wid & 3, fr = lane & 15, fq = lane >> 4;
    const int K = KC ? KC : g.K, nt = K / BK, LDA = LDAC ? LDAC : g.lda;
    unsigned voffA[2], voffB[2];
#pragma unroll
    for (int i = 0; i < 2; ++i) { int R, C; stage_rc(tid * 16 + i * 8192, R, C); const int Rb = Epi::PERM ? ((R & ~31) + perm32(R & 31)) : R;
        voffA[i] = (unsigned)(R * LDA + C) * 2u; voffB[i] = (unsigned)(Rb * K + C) * 2u; }
    const size_t kstep = (size_t)(BK * 2);
    const size_t hstep = (size_t)HALF * K * 2;
    const size_t tstep = 2 * hstep; const size_t hstepA = (size_t)HALF * LDA * 2, tstepA = 2 * hstepA;
    const unsigned ldsw = (unsigned)wid * 1024u;
    const int aoff = lds_byte(wr * 64 + fr, fq * 8), boff = lds_byte(wc * 32 + fr, fq * 8);
#define PG8_SA(b, h) (((b) * 2 + (h)) * HTB)
#define PG8_SB(b, h) ((4 + (b) * 2 + (h)) * HTB)
#define PG8_STAGE(bufoff, gbase, voff) do { _Pragma("unroll") for (int _i = 0; _i < 2; ++_i) \
        __builtin_amdgcn_global_load_lds((const unsigned*)((const char*)(gbase) + (voff)[_i]), (PG8_LAS unsigned*)(lds + (bufoff) + ldsw + _i * 8192), 16, 0, 0); } while (0)
#define PG8_LDA(dst, b, h) do { _Pragma("unroll") for (int m = 0; m < 4; ++m) _Pragma("unroll") for (int k = 0; k < 2; ++k) dst[m][k] = *(const PG8_LAS bf16x8*)(lds + PG8_SA(b, h) + aoff + m * 2048 + k * 1024); } while (0)
#define PG8_LDB(dst, b, h) do { _Pragma("unroll") for (int n = 0; n < 2; ++n) _Pragma("unroll") for (int k = 0; k < 2; ++k) dst[n][k] = *(const PG8_LAS bf16x8*)(lds + PG8_SB(b, h) + boff + n * 2048 + k * 1024); } while (0)
#define PG8_MMA(ai, bj, At, Bt) do { __builtin_amdgcn_s_setprio(1); _Pragma("unroll") for (int m = 0; m < 4; ++m) _Pragma("unroll") for (int n = 0; n < 2; ++n) _Pragma("unroll") for (int k = 0; k < 2; ++k) \
        acc[ai][bj][m][n] = __builtin_amdgcn_mfma_f32_16x16x32_bf16(Bt[n][k], At[m][k], acc[ai][bj][m][n], 0, 0, 0); __builtin_amdgcn_s_setprio(0); } while (0)
#define PG8_WAIT_V(n) asm volatile("s_waitcnt vmcnt(" #n ")" ::: "memory")
#define PG8_WAIT_L(n) asm volatile("s_waitcnt lgkmcnt(" #n ")" ::: "memory")
#define PG8_BAR __builtin_amdgcn_s_barrier()
#define PG8_SCHED __builtin_amdgcn_sched_barrier(0)
    Unit cur, nxt; int ui = 0;
    if (!S.next(0, cur)) return;
    f32x4 acc[2][2][4][2];
#pragma unroll
    for (int a = 0; a < 2; ++a)
#pragma unroll
        for (int b = 0; b < 2; ++b)
#pragma unroll
            for (int m = 0; m < 4; ++m)
#pragma unroll
                for (int n = 0; n < 2; ++n) acc[a][b][m][n] = (f32x4){0.f, 0.f, 0.f, 0.f};
    bf16x8 At[4][2], B0[2][2], B1[2][2];
    const char* cA = (const char*)g.A + (size_t)cur.pm * tstepA; const char* cB = (const char*)g.Bt + (size_t)cur.pn * tstep;
    S.a_ready(cur);
    if constexpr (SP2) {
        PG8_STAGE(PG8_SB(0, 0), cB, voffB); PG8_STAGE(PG8_SB(0, 1), cB + hstep, voffB); PG8_STAGE(PG8_SA(0, 0), cA, voffA); PG8_STAGE(PG8_SA(0, 1), cA + hstepA, voffA);
        if (wr == 1) PG8_BAR;
        PG8_WAIT_V(2); PG8_BAR;
        PG8_STAGE(PG8_SB(1, 0), cB + kstep, voffB); PG8_STAGE(PG8_SA(1, 0), cA + kstep, voffA); PG8_STAGE(PG8_SB(1, 1), cB + hstep + kstep, voffB);
        PG8_WAIT_V(6); PG8_BAR;
    } else {
        PG8_STAGE(PG8_SB(0, 0), cB, voffB); PG8_STAGE(PG8_SA(0, 0), cA, voffA); PG8_STAGE(PG8_SB(0, 1), cB + hstep, voffB); PG8_STAGE(PG8_SA(0, 1), cA + hstepA, voffA);
        if (wr == 1) PG8_BAR;
        PG8_WAIT_V(4); PG8_BAR;
        PG8_STAGE(PG8_SB(1, 0), cB + kstep, voffB); PG8_STAGE(PG8_SA(1, 0), cA + kstep, voffA); PG8_STAGE(PG8_SB(1, 1), cB + hstep + kstep, voffB);
        PG8_WAIT_V(6); PG8_BAR;
    }
    for (;;) {
        const bool has_next = S.next(ui + 1, nxt);
        const char* nA = has_next ? (const char*)g.A + (size_t)nxt.pm * tstepA : cA; const char* nB = has_next ? (const char*)g.Bt + (size_t)nxt.pn * tstep : cB;
        for (int t = 0; t < nt; t += 2) {
            const bool last = (t == nt - 2);
            const char* a1 = cA + (size_t)(t + 1) * kstep;
            const char* a2 = last ? nA : cA + (size_t)(t + 2) * kstep; const char* b2 = last ? nB : cB + (size_t)(t + 2) * kstep;
            const char* a3 = a2 + kstep; const char* b3 = b2 + kstep;
            if (last && has_next) S.a_ready(nxt);
            if constexpr (SP2) {
            PG8_LDB(B0, 0, 0); PG8_LDB(B1, 0, 1); PG8_SCHED; PG8_LDA(At, 0, 0); PG8_STAGE(PG8_SA(1, 1), a1 + hstepA, voffA);
            PG8_WAIT_V(8); PG8_WAIT_L(0); PG8_BAR; PG8_MMA(0, 0, At, B0); PG8_MMA(0, 1, At, B1); PG8_BAR; PG8_SCHED;
            PG8_LDA(At, 0, 1); PG8_STAGE(PG8_SB(0, 0), b2, voffB); PG8_STAGE(PG8_SB(0, 1), b2 + hstep, voffB); PG8_STAGE(PG8_SA(0, 0), a2, voffA);
            PG8_WAIT_V(8); PG8_WAIT_L(0); PG8_BAR; PG8_MMA(1, 0, At, B0); PG8_MMA(1, 1, At, B1); PG8_BAR; PG8_SCHED;
            PG8_LDB(B0, 1, 0); PG8_LDB(B1, 1, 1); PG8_SCHED; PG8_LDA(At, 1, 0); PG8_STAGE(PG8_SA(0, 1), a2 + hstepA, voffA);
            PG8_WAIT_V(8); PG8_WAIT_L(0); PG8_BAR; PG8_MMA(0, 0, At, B0); PG8_MMA(0, 1, At, B1); PG8_BAR; PG8_SCHED;
            PG8_LDA(At, 1, 1); PG8_STAGE(PG8_SB(1, 0), b3, voffB); PG8_STAGE(PG8_SB(1, 1), b3 + hstep, voffB); PG8_STAGE(PG8_SA(1, 0), a3, voffA);
            PG8_WAIT_V(8); PG8_WAIT_L(0); PG8_BAR; PG8_MMA(1, 0, At, B0); PG8_MMA(1, 1, At, B1); PG8_BAR; PG8_SCHED;
            } else {
            PG8_LDB(B0, 0, 0); PG8_SCHED; PG8_LDA(At, 0, 0); PG8_STAGE(PG8_SA(1, 1), a1 + hstepA, voffA);
            PG8_WAIT_L(8); PG8_BAR; PG8_WAIT_L(0); PG8_MMA(0, 0, At, B0); PG8_BAR; PG8_SCHED;
            PG8_LDB(B1, 0, 1); PG8_STAGE(PG8_SB(0, 0), b2, voffB);
            PG8_BAR; PG8_WAIT_L(0); PG8_MMA(0, 1, At, B1); PG8_BAR;
            PG8_LDA(At, 0, 1); PG8_STAGE(PG8_SA(0, 0), a2, voffA);
            PG8_BAR; PG8_WAIT_L(0); PG8_MMA(1, 0, At, B0); PG8_BAR; PG8_SCHED;
            PG8_STAGE(PG8_SB(0, 1), b2 + hstep, voffB);
            PG8_WAIT_V(6); PG8_BAR; PG8_MMA(1, 1, At, B1); PG8_BAR;
            PG8_LDB(B0, 1, 0); PG8_SCHED; PG8_LDA(At, 1, 0); PG8_STAGE(PG8_SA(0, 1), a2 + hstepA, voffA);
            PG8_WAIT_L(8); PG8_BAR; PG8_WAIT_L(0); PG8_MMA(0, 0, At, B0); PG8_BAR; PG8_SCHED;
            PG8_LDB(B1, 1, 1); PG8_STAGE(PG8_SB(1, 0), b3, voffB);
            PG8_BAR; PG8_WAIT_L(0); PG8_MMA(0, 1, At, B1); PG8_BAR;
            PG8_LDA(At, 1, 1); PG8_STAGE(PG8_SA(1, 0), a3, voffA);
            PG8_BAR; PG8_WAIT_L(0); PG8_MMA(1, 0, At, B0); PG8_BAR; PG8_SCHED;
            PG8_STAGE(PG8_SB(1, 1), b3 + hstep, voffB);
            PG8_WAIT_V(6); PG8_BAR; PG8_MMA(1, 1, At, B1); PG8_BAR;
            }
        }
        if constexpr (ALIGN_EPI) { if (wr == 0) PG8_BAR; }
        if constexpr (!Epi::AFTER_DRAIN) { E(acc, cur, wr, wc, fr, fq); S.done(cur); }
        if (!has_next) break;
#pragma unroll
        for (int a = 0; a < 2; ++a)
#pragma unroll
            for (int b = 0; b < 2; ++b)
#pragma unroll
                for (int m = 0; m < 4; ++m)
#pragma unroll
                    for (int n = 0; n < 2; ++n) acc[a][b][m][n] = (f32x4){0.f, 0.f, 0.f, 0.f};
        cur = nxt; cA = nA; cB = nB; ++ui;
        if constexpr (ALIGN_EPI) { if (wr == 1) PG8_BAR; }
    }
    PG8_WAIT_V(0);
    if constexpr (!ALIGN_EPI) { if (wr == 0) PG8_BAR; }
    PG8_BAR;
    if constexpr (Epi::AFTER_DRAIN) { E.fused(acc, cur, wr, wc, fr, fq, lds, wid, lane); S.done(cur); }
#undef PG8_SA
#undef PG8_SB
#undef PG8_STAGE
#undef PG8_LDA
#undef PG8_LDB
#undef PG8_MMA
#undef PG8_WAIT_V
#undef PG8_WAIT_L
#undef PG8_BAR
#undef PG8_SCHED
}
}
namespace pg8 {
constexpr float NORM_EPS = 1e-6f;
#define PG8_GAS __attribute__((address_space(1)))
typedef PG8_GAS f32x4 gf32x4; typedef PG8_GAS u32x4 gu32x4; typedef PG8_GAS float gfloat;
__device__ __forceinline__ float rstd_of(const float* rowss, int row) { const gf32x4* p = (const gf32x4*)(rowss + (size_t)row * 16); const f32x4 a = p[0], b = p[1], c = p[2], d = p[3];
    const float s = (((a[0] + a[1]) + (a[2] + a[3])) + ((b[0] + b[1]) + (b[2] + b[3]))) + (((c[0] + c[1]) + (c[2] + c[3])) + ((d[0] + d[1]) + (d[2] + d[3]))); return __builtin_amdgcn_rsqf(s * (1.0f / 1024.0f) + NORM_EPS); }
struct RstdTab {
    int p0, p1, p2, p3; const PG8_LAS float* tab; const float* rowss;
    __device__ __forceinline__ float get(int pm, int row) const {
        if (pm == p0) return tab[(row & 255)]; if (pm == p1) return tab[256 + (row & 255)]; if (pm == p2) return tab[512 + (row & 255)]; if (pm == p3) return tab[768 + (row & 255)];
        return rstd_of(rowss, row); }
};
template <class Sched> __device__ __forceinline__ RstdTab build_rstd(PG8_LAS unsigned char* lds_free, const float* rowss, const Sched& S) {
    RstdTab t; t.p0 = t.p1 = t.p2 = t.p3 = -1; t.tab = (const PG8_LAS float*)lds_free; t.rowss = rowss;
    Unit u;
    for (int i = 0; S.next(i, u); ++i) { const int pm = u.pm;
        if (pm != t.p0 && pm != t.p1 && pm != t.p2 && pm != t.p3) { if (t.p0 < 0) t.p0 = pm; else if (t.p1 < 0) t.p1 = pm; else if (t.p2 < 0) t.p2 = pm; else if (t.p3 < 0) t.p3 = pm; } }
    int tid_ = threadIdx.x; asm volatile("" : "+v"(tid_));
    for (int e = tid_; e < 1024; e += 512) { const int k = e >> 8, r = e & 255; const int pm = (k == 0) ? t.p0 : (k == 1) ? t.p1 : (k == 2) ? t.p2 : t.p3;
        if (pm >= 0) ((PG8_LAS float*)lds_free)[e] = rstd_of(rowss, pm * 256 + r); }
    asm volatile("s_waitcnt vmcnt(0) lgkmcnt(0)" ::: "memory"); __builtin_amdgcn_s_barrier(); asm volatile("" ::: "memory");
    return t;
}
__device__ __forceinline__ float silu_f(float x) { return x * __builtin_amdgcn_rcpf(1.0f + __expf(-x)); }
struct EpiSwiglu {
    static constexpr bool PERM = true, AFTER_DRAIN = false;
    bf16_t* O; RstdTab rt;
    __device__ __forceinline__ void operator()(const f32x4 (&acc)[2][2][4][2], const Unit& u, int wr, int wc, int fr, int fq) const {
        const int row0 = u.pm * BM + wr * 64 + fr, col0 = u.pn * 128 + wc * 32 + 8 * fq;
#pragma unroll
        for (int ai = 0; ai < 2; ++ai)
#pragma unroll
            for (int m = 0; m < 4; ++m) { const int row = row0 + ai * HALF + m * 16; const float rs = rt.get(u.pm, row);
                float o[8];
#pragma unroll
                for (int n = 0; n < 2; ++n)
#pragma unroll
                    for (int j = 0; j < 4; ++j) { const float g = acc[ai][0][m][n][j] * rs, up = acc[ai][1][m][n][j] * rs; o[n * 4 + j] = silu_f(g) * up; }
                u32x4 w; w.x = cvt_pk_bf16(o[0], o[1]); w.y = cvt_pk_bf16(o[2], o[3]); w.z = cvt_pk_bf16(o[4], o[5]); w.w = cvt_pk_bf16(o[6], o[7]);
                *(gu32x4*)(O + (size_t)row * 2816 + col0) = w; }
    }
};
#ifndef RESID_LO
#define RESID_LO 1
#endif
struct EpiResid {
    static constexpr bool PERM = true, AFTER_DRAIN = false;
    bf16_t* HB; unsigned* LO; float* rowss_next; float scale;
    static __device__ __forceinline__ float dec_lo(unsigned hw, unsigned nib) { return __uint_as_float(((hw << 16) | (nib << 12)) - (RESID_LO ? 0x7800u : 0u)); }
    static __device__ __forceinline__ float dec_hi(unsigned hw, unsigned nib) { return __uint_as_float(((hw & 0xffff0000u) | (nib << 12)) - (RESID_LO ? 0x7800u : 0u)); }
    static __device__ __forceinline__ unsigned enc(float h) { return __float_as_uint(h) + 0x8000u; }
    static __device__ __forceinline__ void dec8(const u32x4 hb, const unsigned lq, float (&f)[8]) {
        f[0] = dec_lo(hb.x, lq & 0xfu); f[1] = dec_hi(hb.x, (lq >> 4) & 0xfu); f[2] = dec_lo(hb.y, (lq >> 8) & 0xfu); f[3] = dec_hi(hb.y, (lq >> 12) & 0xfu);
        f[4] = dec_lo(hb.z, (lq >> 16) & 0xfu); f[5] = dec_hi(hb.z, (lq >> 20) & 0xfu); f[6] = dec_lo(hb.w, (lq >> 24) & 0xfu); f[7] = dec_hi(hb.w, lq >> 28);
    }
    static __device__ __forceinline__ unsigned nib8(const unsigned (&e)[8]) {
        return ((e[0] >> 12) & 0xfu) | ((e[1] >> 8) & 0xf0u) | ((e[2] >> 4) & 0xf00u) | (e[3] & 0xf000u) | ((e[4] << 4) & 0xf0000u) | ((e[5] << 8) & 0xf00000u) | ((e[6] << 12) & 0xf000000u) | ((e[7] << 16) & 0xf0000000u);
    }
    __device__ __forceinline__ void operator()(const f32x4 (&acc)[2][2][4][2], const Unit& u, int wr, int wc, int fr, int fq) const {
        const int row0 = u.pm * BM + wr * 64 + fr, col0 = u.pn * BM + wc * 32 + 8 * fq;
#pragma unroll
        for (int ai = 0; ai < 2; ++ai)
#pragma unroll
            for (int m = 0; m < 4; ++m) { const int row = row0 + ai * HALF + m * 16; bf16_t* bp = HB + (size_t)row * 1024 + col0; unsigned* lp = LO + (size_t)row * 128 + (col0 >> 3); float ss = 0.f;
#pragma unroll
                for (int bj = 0; bj < 2; ++bj) { const u32x4 old = *(const gu32x4*)(bp + bj * HALF);
#if RESID_LO
                    const unsigned lq = lp[bj * (HALF / 8)];
#else
                    const unsigned lq = 0u;
#endif
                    float h[8]; dec8(old, lq, h);
#pragma unroll
                    for (int j = 0; j < 4; ++j) { h[j] += acc[ai][bj][m][0][j] * scale; h[4 + j] += acc[ai][bj][m][1][j] * scale; }
#pragma unroll
                    for (int j = 0; j < 8; ++j) ss += h[j] * h[j];
#if RESID_LO
                    unsigned e[8];
#pragma unroll
                    for (int j = 0; j < 8; ++j) e[j] = enc(h[j]);
                    u32x4 w; w.x = (e[0] >> 16) | (e[1] & 0xffff0000u); w.y = (e[2] >> 16) | (e[3] & 0xffff0000u); w.z = (e[4] >> 16) | (e[5] & 0xffff0000u); w.w = (e[6] >> 16) | (e[7] & 0xffff0000u);
                    *(u32x4*)(bp + bj * HALF) = w;
                    lp[bj * (HALF / 8)] = nib8(e);
#else
                    u32x4 w; w.x = cvt_pk_bf16(h[0], h[1]); w.y = cvt_pk_bf16(h[2], h[3]); w.z = cvt_pk_bf16(h[4], h[5]); w.w = cvt_pk_bf16(h[6], h[7]);
                    *(gu32x4*)(bp + bj * HALF) = w;
#endif
                }
                ss += __shfl_xor(ss, 16); ss += __shfl_xor(ss, 32);
                if (fq == 0) ((gfloat*)rowss_next)[(size_t)row * 16 + u.pn * 4 + wc] = ss; }
    }
};
struct EpiProj {
    static constexpr bool PERM = true, AFTER_DRAIN = false;
    bf16_t* P; float* DT; RstdTab rt;
    __device__ __forceinline__ void operator()(const f32x4 (&acc)[2][2][4][2], const Unit& u, int wr, int wc, int fr, int fq) const {
        const int row0 = u.pm * BM + wr * 64 + fr, col0 = u.pn * BM + wc * 32 + 8 * fq;
#pragma unroll
        for (int ai = 0; ai < 2; ++ai)
#pragma unroll
            for (int m = 0; m < 4; ++m) { const int row = row0 + ai * HALF + m * 16; const float rs = rt.get(u.pm, row);
                if (u.pn < 18) {
#pragma unroll
                    for (int bj = 0; bj < 2; ++bj) { const f32x4 v0 = acc[ai][bj][m][0] * rs, v1 = acc[ai][bj][m][1] * rs;
                        u32x4 w; w.x = cvt_pk_bf16(v0[0], v0[1]); w.y = cvt_pk_bf16(v0[2], v0[3]); w.z = cvt_pk_bf16(v1[0], v1[1]); w.w = cvt_pk_bf16(v1[2], v1[3]);
                        *(gu32x4*)(P + (size_t)row * 4608 + col0 + bj * HALF) = w; }
                } else if (wc == 0 && fq < 2) {
                    *(gf32x4*)(DT + (size_t)row * 16 + 8 * fq) = acc[ai][0][m][0] * rs; *(gf32x4*)(DT + (size_t)row * 16 + 8 * fq + 4) = acc[ai][0][m][1] * rs; }
            }
    }
};
struct EpiQkv {
    static constexpr bool PERM = true, AFTER_DRAIN = false;
    bf16_t* QKV; RstdTab rt; const float* rope; float qscale;
    __device__ __forceinline__ void operator()(const f32x4 (&acc)[2][2][4][2], const Unit& u, int wr, int wc, int fr, int fq) const {
        const int sect = u.pn >> 2; bf16_t* base = QKV + (size_t)sect * ((size_t)32768 * 1024);
        const int row0 = u.pm * BM + wr * 64 + fr, col0 = (u.pn & 3) * BM + wc * 32 + 8 * fq;
        const float sc = sect == 0 ? qscale : 1.0f; const bool rot = (sect < 2), mine = ((wc & 1) == 0) && (fq < 2);
#pragma unroll
        for (int ai = 0; ai < 2; ++ai)
#pragma unroll
            for (int m = 0; m < 4; ++m) { const int row = row0 + ai * HALF + m * 16; const float rs = rt.get(u.pm, row);
                f32x4 c0 = {1.f, 1.f, 1.f, 1.f}, c1 = c0, s0 = {0.f, 0.f, 0.f, 0.f}, s1 = s0;
                if (rot && mine) { const float* rp = rope + (size_t)(row & 2047) * 16; c0 = *(const gf32x4*)rp; c1 = *(const gf32x4*)(rp + 4); s0 = *(const gf32x4*)(rp + 8); s1 = *(const gf32x4*)(rp + 12);
                    if (fq == 0) { s0 = -s0; s1 = -s1; } }
#pragma unroll
                for (int bj = 0; bj < 2; ++bj) { f32x4 v0 = acc[ai][bj][m][0] * rs, v1 = acc[ai][bj][m][1] * rs;
                    if (rot) { f32x4 p0, p1;
#pragma unroll
                        for (int j = 0; j < 4; ++j) { p0[j] = __shfl_xor(v0[j], 16); p1[j] = __shfl_xor(v1[j], 16); }
                        v0 = v0 * c0 + p0 * s0; v1 = v1 * c1 + p1 * s1; }
                    v0 = v0 * sc; v1 = v1 * sc;
                    u32x4 w; w.x = cvt_pk_bf16(v0[0], v0[1]); w.y = cvt_pk_bf16(v0[2], v0[3]); w.z = cvt_pk_bf16(v1[0], v1[1]); w.w = cvt_pk_bf16(v1[2], v1[3]);
                    *(gu32x4*)(base + (size_t)row * 1024 + col0 + bj * HALF) = w; }
            }
    }
};
}
#include <hip/hip_bf16.h>
#include <cmath>
namespace attn_body {
using bf16=__hip_bfloat16;
using bf16x8=__attribute__((ext_vector_type(8)))short;
using s16x4=__attribute__((ext_vector_type(4)))short;
using f32x16=__attribute__((ext_vector_type(16)))float;
using u32x4=__attribute__((ext_vector_type(4)))unsigned;
constexpr int BATCH=16,SEQ=2048,D=64,DM=1024,OP=2048;
constexpr int NW=8,QBLK=32,QB=QBLK*NW,KVBLK=64,NQB=SEQ/QB;
constexpr int ATTN_PITCH=DM, ATTN_UNIT_ROWS=QB;
__device__ __forceinline__ int crow(int r,int hi){return (r&3)+8*(r>>2)+4*hi;}
#define SBAR() __builtin_amdgcn_sched_barrier(0)
__device__ __forceinline__ void cmask(f32x16&p0,f32x16&p1,int jb,int qrel,int hi){
  const float NEG=-INFINITY; int kb=64*jb+4*hi;
  #pragma unroll
  for(int r=0;r<16;++r){int kv=kb+(r&3)+8*(r>>2); if(kv>qrel)p0[r]=NEG; if(kv+32>qrel)p1[r]=NEG;}
}

constexpr int NSLOT=3, SLOTB=8192;
constexpr int LDS_K=0, LDS_V=NSLOT*SLOTB, LDS_WS=2*NSLOT*SLOTB, LDS_OST=LDS_WS+NW*64*4, LDS_BYTES=LDS_OST+NW*4096;
constexpr float C2=0.125f*1.4426950408889634f;
__device__ __forceinline__ void glds16(const void*gsrc,unsigned lds_dst){unsigned keep;
  asm volatile("s_mov_b32 %0, m0\n\ts_mov_b32 m0, %2\n\ts_nop 0\n\tglobal_load_lds_dwordx4 %1, off\n\ts_mov_b32 m0, %0":"=&s"(keep):"v"(gsrc),"s"(lds_dst):"memory");}
__device__ __forceinline__ float max3f(float a,float b,float c){float r;asm("v_max3_f32 %0, %1, %2, %3":"=v"(r):"v"(a),"v"(b),"v"(c));return r;}
__device__ __forceinline__ float max2f(float a,float b){float r;asm("v_max_f32_e32 %0, %1, %2":"=v"(r):"v"(a),"v"(b));return r;}
__device__ __forceinline__ float fadd_s(float a,float b){float r;asm("v_add_f32_e32 %0, %1, %2":"=v"(r):"v"(a),"v"(b));return r;}
__device__ __forceinline__ float fsub_s(float a,float b){float r;asm("v_sub_f32_e32 %0, %1, %2":"=v"(r):"v"(a),"v"(b));return r;}
typedef float f32x2_t __attribute__((ext_vector_type(2))); typedef __bf16 bf16x2_t __attribute__((ext_vector_type(2)));
__device__ __forceinline__ unsigned cvtpk_s(float lo,float hi){f32x2_t v={lo,hi};bf16x2_t b=__builtin_convertvector(v,bf16x2_t);return __builtin_bit_cast(unsigned,b);}
#define WAIT_BAR(N) asm volatile("s_waitcnt vmcnt(" #N ") lgkmcnt(0)\n\ts_barrier":::"memory")

__device__ __forceinline__ void qkt(f32x16&p0,f32x16&p1,const char*Kslot,const bf16x8*qr,const f32x16&negm,int r32,int hi){
  const char*kb=Kslot+hi*1024+r32*16;
  #pragma unroll
  for(int d0=0;d0<4;++d0){
    const bf16x8 b0=*reinterpret_cast<const bf16x8*>(kb+d0*2048);
    const bf16x8 b1=*reinterpret_cast<const bf16x8*>(kb+d0*2048+512);
    if(d0==0){p0=__builtin_amdgcn_mfma_f32_32x32x16_bf16(b0,qr[0],negm,0,0,0);p1=__builtin_amdgcn_mfma_f32_32x32x16_bf16(b1,qr[0],negm,0,0,0);}
    else{p0=__builtin_amdgcn_mfma_f32_32x32x16_bf16(b0,qr[d0],p0,0,0,0);p1=__builtin_amdgcn_mfma_f32_32x32x16_bf16(b1,qr[d0],p1,0,0,0);}}
}
typedef __attribute__((address_space(3))) const char* lds_cptr;
typedef short v4i16_t __attribute__((ext_vector_type(4)));
__device__ __forceinline__ void kload8(bf16x8*kf,lds_cptr kp){
  kf[0]=*(const __attribute__((address_space(3))) bf16x8*)(kp);      kf[1]=*(const __attribute__((address_space(3))) bf16x8*)(kp+512);
  kf[2]=*(const __attribute__((address_space(3))) bf16x8*)(kp+2048); kf[3]=*(const __attribute__((address_space(3))) bf16x8*)(kp+2560);
  kf[4]=*(const __attribute__((address_space(3))) bf16x8*)(kp+4096); kf[5]=*(const __attribute__((address_space(3))) bf16x8*)(kp+4608);
  kf[6]=*(const __attribute__((address_space(3))) bf16x8*)(kp+6144); kf[7]=*(const __attribute__((address_space(3))) bf16x8*)(kp+6656);
}
__device__ __forceinline__ void kload2(bf16x8*kf,lds_cptr kp,int j){ kf[2*j]=*(const __attribute__((address_space(3))) bf16x8*)(kp+j*2048); kf[2*j+1]=*(const __attribute__((address_space(3))) bf16x8*)(kp+j*2048+512); }
__device__ __forceinline__ s16x4 vtr(lds_cptr p){ return __builtin_bit_cast(s16x4,__builtin_amdgcn_ds_read_tr16_b64_v4i16((__attribute__((address_space(3))) v4i16_t*)p)); }
__device__ __forceinline__ float rowmax(const f32x16&p0,const f32x16&p1){
  float a=max3f(p0[0],p0[1],p1[0]),b=max3f(p0[2],p0[3],p1[1]);a=max3f(a,p1[2],p1[3]);
  #pragma unroll
  for(int r=4;r<16;r+=4){a=max3f(a,p0[r],p0[r+1]);b=max3f(b,p0[r+2],p0[r+3]);a=max3f(a,p1[r],p1[r+1]);b=max3f(b,p1[r+2],p1[r+3]);}
  const float m=max2f(a,b);
  auto rr=__builtin_amdgcn_permlane32_swap(__float_as_uint(m),__float_as_uint(m),false,false);
  return max2f(__uint_as_float(rr[0]),__uint_as_float(rr[1]));
}
__device__ __forceinline__ void pv(f32x16*o,int vb,bf16x8 pa0,bf16x8 pa1,bf16x8 pa2,bf16x8 pa3){
  #pragma unroll
  for(int d0=0;d0<2;++d0){s16x4 lo[4],hi[4];
    #pragma unroll
    for(int ks=0;ks<4;++ks){
      asm volatile("ds_read_b64_tr_b16 %0,%1 offset:%c2":"=&v"(lo[ks]):"v"(vb),"i"(d0*4096+ks*1024):"memory");
      asm volatile("ds_read_b64_tr_b16 %0,%1 offset:%c2":"=&v"(hi[ks]):"v"(vb),"i"(d0*4096+ks*1024+512):"memory");}
    asm volatile("s_waitcnt lgkmcnt(0)":::"memory");SBAR();
    #define PK(k) (bf16x8){lo[k][0],lo[k][1],lo[k][2],lo[k][3],hi[k][0],hi[k][1],hi[k][2],hi[k][3]}
    o[d0]=__builtin_amdgcn_mfma_f32_32x32x16_bf16(pa0,PK(0),o[d0],0,0,0);
    o[d0]=__builtin_amdgcn_mfma_f32_32x32x16_bf16(pa1,PK(1),o[d0],0,0,0);
    o[d0]=__builtin_amdgcn_mfma_f32_32x32x16_bf16(pa2,PK(2),o[d0],0,0,0);
    o[d0]=__builtin_amdgcn_mfma_f32_32x32x16_bf16(pa3,PK(3),o[d0],0,0,0);
    #undef PK
  }
}

#ifndef ATTN_STORE16
#define ATTN_STORE16(p,v) (*(u32x4*)(p)=(v))
#endif
template<int THRL> __device__ __forceinline__ void attn_unit(int b,int qcol,int vcol,int ocol,int qb,const bf16*Q,const bf16*__restrict__ K,const bf16*__restrict__ V,bf16*O,char*shm){
  int tid_=threadIdx.x; asm volatile("":"+v"(tid_)); const int tid=tid_,lane=tid&63,r32=lane&31,hi=lane>>5; const int wid=__builtin_amdgcn_readfirstlane(tid>>6);
  const long rowbase=(long)b*SEQ; const int q0=qb*QB;
  const bf16*Qw=Q+(rowbase+q0+wid*QBLK)*DM+qcol;
  const bf16*Kh=K+rowbase*DM+qcol,*Vh=V+rowbase*DM+vcol;
  const unsigned lds0=(unsigned)(uintptr_t)shm;
  float*wsf=(float*)(shm+LDS_WS)+wid*64;
  const bf16*ksrc=Kh+(long)lane*DM+wid*8;
  const bf16*vsrc=Vh+(long)(16*(wid&3)+(lane>>2))*DM+(wid>>2)*32+(lane&3)*8;
  const unsigned kdst=lds0+LDS_K+wid*1024, vdst=lds0+LDS_V+wid*1024;
  #define DMA_K(t,slot) glds16(ksrc+(long)(t)*KVBLK*DM,(unsigned)__builtin_amdgcn_readfirstlane(kdst+(slot)))
  #define DMA_V(t,slot) glds16(vsrc+(long)(t)*KVBLK*DM,(unsigned)__builtin_amdgcn_readfirstlane(vdst+(slot)))
  const int vb0=(int)(lds0+LDS_V)+((lane>>4)&1)*32+(lane&3)*8+(4*hi+((lane&15)>>2))*64;
  const char*Kbase=shm+LDS_K; bf16x8 kf[8];
  const lds_cptr shm3=(lds_cptr)shm; const lds_cptr kp0=shm3+LDS_K+hi*1024+r32*16; const lds_cptr vp0=shm3+LDS_V+((lane>>4)&1)*32+(lane&3)*8+(4*hi+((lane&15)>>2))*64;
  const int NT=(q0+QB)/KVBLK;
  DMA_K(0,0);DMA_V(0,0);DMA_K(1,SLOTB);
  bf16x8 qr[4];
  #pragma unroll
  for(int d0=0;d0<4;++d0)qr[d0]=*reinterpret_cast<const bf16x8*>(&Qw[(long)r32*DM+d0*16+hi*8]);
  float mhat=0.f,l_reg=0.f;f32x16 o[2];o[0]=f32x16{};o[1]=f32x16{};f32x16 negm=f32x16{};asm volatile("":"+v"(negm));
  const int qrel=wid*QBLK+r32;
  #define CMASK(P0,P1,t) do{int jb_=(t)-(NT-4); if(jb_>=0)cmask(P0,P1,jb_,qrel,hi);}while(0)
  bool resc=false;
  #define START(P0,P1) do{ const float rm=rowmax(P0,P1); resc=false; \
    { const float dl=rm; mhat=fadd_s(mhat,dl); \
      _Pragma("unroll") for(int r=0;r<16;++r){P0[r]=fsub_s(P0[r],dl);P1[r]=fsub_s(P1[r],dl);} \
      _Pragma("unroll") for(int r=0;r<16;++r)negm[r]=-mhat; asm volatile("":"+v"(negm)); } \
    _Pragma("unroll") for(int r=0;r<16;++r)P0[r]=__builtin_amdgcn_exp2f(P0[r]); }while(0)
  #define RESC() do{ if(resc){ asm volatile("s_waitcnt lgkmcnt(0)":::"memory"); \
      _Pragma("unroll") for(int d_=0;d_<2;++d_) _Pragma("unroll") for(int r=0;r<16;++r)o[d_][r]*=wsf[crow(r,hi)]; } }while(0)
  f32x16 pA0,pA1,pB0,pB1;
  int sl_prev=0,sl_cur=0,sl_next=SLOTB;
  #define ROT() do{sl_prev=sl_cur;sl_cur=sl_next;sl_next=(sl_next==(NSLOT-1)*SLOTB)?0:sl_next+SLOTB;}while(0)
  DMA_K(2,2*SLOTB);
  WAIT_BAR(3);
  qkt(pA0,pA1,Kbase,qr,negm,r32,hi);asm volatile("s_nop 15\n\ts_nop 7":"+v"(pA0),"+v"(pA1));CMASK(pA0,pA1,0);
  START(pA0,pA1);
  _Pragma("unroll") for(int r=0;r<16;++r)pA1[r]=__builtin_amdgcn_exp2f(pA1[r]);
  WAIT_BAR(0);
  DMA_K(3,0);DMA_V(1,SLOTB);
  ROT();
  kload8(kf,kp0+sl_cur);
  WAIT_BAR(2);
  s16x4 vlo[8],vhi[8]; u32x4 pw0,pw1,pw2,pw3;
  #define PKW(P,B) cvtpk_s(P[B],P[B+1])
  #define PAF(k) __builtin_bit_cast(bf16x8,pw##k)
  #define VFR(i) (bf16x8){vlo[i][0],vlo[i][1],vlo[i][2],vlo[i][3],vhi[i][0],vhi[i][1],vhi[i][2],vhi[i][3]}
  #define PIN(x) asm volatile("":"+v"(x))
  #define MX3(a,b,c) __builtin_fmaxf(__builtin_fmaxf((a),(b)),(c))
  #define GAPA(MF,A0,A1,A2,A3,W0,W1,PW) do{ MF; sacc+=A0; sacc+=A1; sacc+=A2; sacc+=A3; PIN(sacc); W0; W1; PIN(PW); SBAR(); }while(0)
  #define EX(v) __builtin_amdgcn_exp2f(v)
  #define GAPB(MF,X,B) do{ MF; X[B]=EX(X[B]); X[B+1]=EX(X[B+1]); X[B+2]=EX(X[B+2]); X[B+3]=EX(X[B+3]); PIN(X); SBAR(); }while(0)
  #define VRD(i) do{ vlo[i]=vtr(vp_+(((i)>>2)*4096+((i)&3)*1024)); vhi[i]=vtr(vp_+(((i)>>2)*4096+((i)&3)*1024+512)); }while(0)
  #define KRD(G,j) do{ if(G){ kload2(kf,kp0+sl_next,j); SBAR(); } }while(0)
  #define STEP(C0,C1,P0,P1,t,GK,GV,GL) do{ SBAR(); \
    const lds_cptr vp_=vp0+sl_prev; \
    VRD(0); SBAR(); float sacc=(P0[0]+P0[1]); \
    GAPA(C0=__builtin_amdgcn_mfma_f32_32x32x16_bf16(kf[0],qr[0],negm,0,0,0), P0[2],P0[3],P0[4],P0[5],     pw0[0]=PKW(P0,0), pw0[1]=PKW(P0,2), pw0); \
    VRD(4); SBAR(); GAPA(C1=__builtin_amdgcn_mfma_f32_32x32x16_bf16(kf[1],qr[0],negm,0,0,0), P0[6],P0[7],P0[8],P0[9],     pw0[2]=PKW(P0,4), pw0[3]=PKW(P0,6), pw0); \
    VRD(1); SBAR(); GAPA(C0=__builtin_amdgcn_mfma_f32_32x32x16_bf16(kf[2],qr[1],C0,0,0,0),   P0[10],P0[11],P0[12],P0[13], pw1[0]=PKW(P0,8), pw1[1]=PKW(P0,10), pw1); \
    VRD(5); SBAR(); GAPA(C1=__builtin_amdgcn_mfma_f32_32x32x16_bf16(kf[3],qr[1],C1,0,0,0),   P0[14],P0[15],P1[0],P1[1],   pw1[2]=PKW(P0,12),pw1[3]=PKW(P0,14), pw1); \
    VRD(2); SBAR(); GAPA(C0=__builtin_amdgcn_mfma_f32_32x32x16_bf16(kf[4],qr[2],C0,0,0,0),   P1[2],P1[3],P1[4],P1[5],     pw2[0]=PKW(P1,0), pw2[1]=PKW(P1,2), pw2); \
    VRD(6); SBAR(); GAPA(C1=__builtin_amdgcn_mfma_f32_32x32x16_bf16(kf[5],qr[2],C1,0,0,0),   P1[6],P1[7],P1[8],P1[9],     pw2[2]=PKW(P1,4), pw2[3]=PKW(P1,6), pw2); \
    VRD(3); SBAR(); GAPA(C0=__builtin_amdgcn_mfma_f32_32x32x16_bf16(kf[6],qr[3],C0,0,0,0),   P1[10],P1[11],P1[12],P1[13], pw3[0]=PKW(P1,8), pw3[1]=PKW(P1,10), pw3); \
    VRD(7); SBAR(); GAPA(C1=__builtin_amdgcn_mfma_f32_32x32x16_bf16(kf[7],qr[3],C1,0,0,0),   P1[14],P1[15],0.f,0.f,       pw3[2]=PKW(P1,12),pw3[3]=PKW(P1,14), pw3); \
    l_reg+=sacc; \
    if(GK){DMA_K((t)+3,sl_cur);} if(GV){DMA_V((t)+1,sl_next);} \
    CMASK(C0,C1,t); \
    { float a=MX3(C0[0],C0[1],C1[0]),b=MX3(C0[2],C0[3],C1[1]); a=MX3(a,C1[2],C1[3]); \
      _Pragma("unroll") for(int r=4;r<16;r+=4){a=MX3(a,C0[r],C0[r+1]);b=MX3(b,C0[r+2],C0[r+3]);a=MX3(a,C1[r],C1[r+1]);b=MX3(b,C1[r+2],C1[r+3]);} \
      float rm=__builtin_fmaxf(a,b); { auto rr=__builtin_amdgcn_permlane32_swap(__float_as_uint(rm),__float_as_uint(rm),false,false); rm=__builtin_fmaxf(__uint_as_float(rr[0]),__uint_as_float(rr[1])); } \
      resc=false; \
      if(__builtin_expect(__any(rm>(float)THRL),0)){ const float dl=__builtin_fmaxf(rm,0.f); mhat+=dl; \
        _Pragma("unroll") for(int r=0;r<16;++r){C0[r]-=dl;C1[r]-=dl;} \
        _Pragma("unroll") for(int r=0;r<16;++r)negm[r]=-mhat; asm volatile("":"+v"(negm)); \
        const float f=__builtin_amdgcn_exp2f(-dl); l_reg*=f; if(hi==0)wsf[r32]=f; resc=true; } } \
    SBAR(); \
    GAPB(o[0]=__builtin_amdgcn_mfma_f32_32x32x16_bf16(PAF(0),VFR(0),o[0],0,0,0), C0,0); \
    GAPB(o[1]=__builtin_amdgcn_mfma_f32_32x32x16_bf16(PAF(0),VFR(4),o[1],0,0,0), C0,4); \
    KRD(GL,0); GAPB(o[0]=__builtin_amdgcn_mfma_f32_32x32x16_bf16(PAF(1),VFR(1),o[0],0,0,0), C0,8); \
    KRD(GL,1); GAPB(o[1]=__builtin_amdgcn_mfma_f32_32x32x16_bf16(PAF(1),VFR(5),o[1],0,0,0), C0,12); \
    KRD(GL,2); GAPB(o[0]=__builtin_amdgcn_mfma_f32_32x32x16_bf16(PAF(2),VFR(2),o[0],0,0,0), C1,0); \
    KRD(GL,3); GAPB(o[1]=__builtin_amdgcn_mfma_f32_32x32x16_bf16(PAF(2),VFR(6),o[1],0,0,0), C1,4); \
    GAPB(o[0]=__builtin_amdgcn_mfma_f32_32x32x16_bf16(PAF(3),VFR(3),o[0],0,0,0), C1,8); \
    GAPB(o[1]=__builtin_amdgcn_mfma_f32_32x32x16_bf16(PAF(3),VFR(7),o[1],0,0,0), C1,12); \
    }while(0)
  int t=1;
  #undef CMASK
  #define CMASK(P0,P1,t) do{}while(0)
  for(;t+5<NT;t+=2){
    STEP(pB0,pB1,pA0,pA1,t,true,true,true);     WAIT_BAR(2); RESC(); ROT();
    STEP(pA0,pA1,pB0,pB1,t+1,true,true,true);   WAIT_BAR(2); RESC(); ROT();
  }
  #undef CMASK
  #define CMASK(P0,P1,t) do{int jb_=(t)-(NT-4); if(jb_>=0)cmask(P0,P1,jb_,qrel,hi);}while(0)
  #define ENDW(tt) do{ if((tt)+3<NT){WAIT_BAR(2);} else if((tt)+2<NT){WAIT_BAR(1);} else {WAIT_BAR(0);} }while(0)
  for(;t+1<NT;t+=2){
    STEP(pB0,pB1,pA0,pA1,t,(t+3<NT),(t+1<NT),(t+1<NT));       ENDW(t);   RESC(); ROT();
    STEP(pA0,pA1,pB0,pB1,t+1,(t+4<NT),(t+2<NT),(t+2<NT));     ENDW(t+1); RESC(); ROT();
  }
  STEP(pB0,pB1,pA0,pA1,NT-1,false,false,false); RESC();
  { float sacc=pB0[0]+pB0[1]; _Pragma("unroll") for(int r=2;r<16;++r)sacc+=pB0[r]; _Pragma("unroll") for(int r=0;r<16;++r)sacc+=pB1[r]; l_reg+=sacc;
    pw0=(u32x4){PKW(pB0,0),PKW(pB0,2),PKW(pB0,4),PKW(pB0,6)};pw1=(u32x4){PKW(pB0,8),PKW(pB0,10),PKW(pB0,12),PKW(pB0,14)};pw2=(u32x4){PKW(pB1,0),PKW(pB1,2),PKW(pB1,4),PKW(pB1,6)};pw3=(u32x4){PKW(pB1,8),PKW(pB1,10),PKW(pB1,12),PKW(pB1,14)};
    SBAR(); pv(o,vb0+sl_cur,PAF(0),PAF(1),PAF(2),PAF(3)); }
  #undef PKW
  #undef PAF
  #undef VFR
  #undef PIN
  #undef MX3
  #undef GAPA
  #undef GAPB
  #undef EX
  #undef VRD
  #undef KRD
  #undef STEP
  #undef ENDW
  {auto rr=__builtin_amdgcn_permlane32_swap(__float_as_uint(l_reg),__float_as_uint(l_reg),false,false);l_reg=__uint_as_float(rr[0])+__uint_as_float(rr[1]);}
  if(hi==0)wsf[32+r32]=l_reg;asm volatile("s_waitcnt lgkmcnt(0)":::"memory");
  float rli[16];
  #pragma unroll
  for(int r=0;r<16;++r)rli[r]=__builtin_amdgcn_rcpf(wsf[32+crow(r,hi)]);
  bf16*Ow=O+(rowbase+q0+wid*QBLK)*OP+ocol;
  { bf16*stg=(bf16*)(shm+LDS_OST)+wid*2048;
    #pragma unroll
    for(int r=0;r<16;++r){const int orow=crow(r,hi);
      #pragma unroll
      for(int d0=0;d0<2;++d0)stg[orow*64+d0*32+r32]=__float2bfloat16(o[d0][r]*rli[r]);}
    asm volatile("s_waitcnt lgkmcnt(0)":::"memory");
    #pragma unroll
    for(int i=0;i<4;++i){const int row=i*8+(lane>>3),ch=lane&7; const u32x4 v=*(const u32x4*)(stg+row*64+ch*8); ATTN_STORE16(Ow+(long)row*OP+ch*8,v);} }
  asm volatile("s_waitcnt lgkmcnt(0)\n\ts_barrier":::"memory");
  #undef DMA_K
  #undef DMA_V
  #undef CMASK
  #undef START
  #undef RESC
  #undef ROT
}
constexpr int ATTN_LDS_BYTES=LDS_BYTES;
struct AttnTensors { const bf16* Q; const bf16* K; const bf16* V; bf16* O; };
struct AttnUnit { int b, qcol, vcol, ocol, qb; };
template<int THRL=8> __device__ __forceinline__ void attn_phase(char*lds,const AttnTensors&T,int vcu,int G){
  for(int su=vcu;su<256;su+=G){ const int b=su>>4,h=(su>>1)&7,c=su&1;
    for(int i=0;i<16;++i){ const int half=i>>3,qb=7-(i&7);
      attn_unit<THRL>(b,(h*2+c)*64,h*128+half*64,c*1024+h*128+half*64,qb,T.Q,T.K,T.V,T.O,lds); } }
}
#undef SBAR
#undef WAIT_BAR
}
constexpr int NWAVES = 8;
constexpr int BATCH = 16, SEQ = 2048, DM_ = 1024, M = BATCH * SEQ, DFF = 2816, DEPTH = 4;
constexpr int PL = 4608;
constexpr int OFF_Z = 0, OFF_GATE = 1024, OFF_XA = 2048, OFF_B = 3072, OFF_C = 3328, OFF_XB = 3584;
constexpr float EPS = 1e-6f;
constexpr size_t MiB = 1u << 20;
constexpr size_t WS_ROWSS = 1 * MiB;
constexpr size_t WS_GSS = 5 * MiB;
constexpr size_t WS_ROPE = 7 * MiB;
constexpr size_t WS_DT = 7 * MiB + 512 * 1024;
constexpr size_t WS_WB = 10 * MiB;
constexpr size_t WB_GU1 = 0, WB_D1 = 11 * MiB, WB_GU2 = WB_D1 + 5 * MiB + 512 * 1024, WB_D2 = WB_GU2 + 11 * MiB, WB_MI = WB_D2 + 5 * MiB + 512 * 1024, WB_MO = WB_MI + 9 * MiB + 512 * 1024;
static_assert(WB_MO + 4 * MiB <= 48 * MiB, "weights");
constexpr size_t WS_HB = 58 * MiB;
constexpr size_t WS_BIG = 122 * MiB;
constexpr size_t WS_LO = 442 * MiB;
constexpr size_t WS_END = 474 * MiB;
constexpr int LDS_BYTES = 163840;

#define GAS __attribute__((address_space(1)))
#define LAS __attribute__((address_space(3)))
typedef unsigned short bf16;
typedef unsigned v4u __attribute__((ext_vector_type(4)));
typedef unsigned v2u __attribute__((ext_vector_type(2)));
typedef float f32x4 __attribute__((ext_vector_type(4)));
typedef short bf16x8 __attribute__((ext_vector_type(8)));
#define LDS_WAIT() asm volatile("s_waitcnt lgkmcnt(0)" ::: "memory")
__device__ __forceinline__ unsigned pk2(float lo, float hi) { return pg8::cvt_pk_bf16(lo, hi); }
__device__ __forceinline__ float bflo(unsigned w) { return __uint_as_float(w << 16); }
__device__ __forceinline__ float bfhi(unsigned w) { return __uint_as_float(w & 0xffff0000u); }
__device__ __forceinline__ float bf1(bf16 v) { return __uint_as_float((unsigned)v << 16); }
__device__ __forceinline__ float wave_sum(float v) {
#pragma unroll
    for (int o = 1; o < 64; o <<= 1) v += __shfl_xor(v, o);
    return v;
}
__device__ __forceinline__ float silu_f(float x) { return x * __builtin_amdgcn_rcpf(1.0f + __expf(-x)); }
__device__ __forceinline__ float sigmoid_f(float x) { return __builtin_amdgcn_rcpf(1.0f + __expf(-x)); }

struct Args { const float* in[33]; float* out; unsigned char* ws; };
struct FromArgs { const Args& a; __device__ __forceinline__ const float* operator()(int i) const { return a.in[i]; } };
struct FromTab { const float* const* t; __device__ __forceinline__ const float* operator()(int i) const { return t[i]; } };
constexpr size_t WS_TAB = 512 * 1024;

__device__ __forceinline__ void cvt_item(const float* W, int K, int Nsrc, int c0, int ncols, bf16* WT, int drow0, int mode, const float* kscale, LAS float* scr, int item, int lane) {
    const int nblk = (ncols + 63) / 64, kb = item / nblk, nb = item % nblk, k0 = 64 * kb, n0 = 64 * nb;
    const int l16 = lane & 15, kr = lane >> 4; const bool cok = (n0 + 4 * l16) < ncols;
    const float* src = W + (size_t)(k0 + kr) * Nsrc + c0 + n0 + 4 * l16;
    f32x4 v[16];
#pragma unroll
    for (int i = 0; i < 16; ++i) v[i] = cok ? __builtin_nontemporal_load((const f32x4*)(src + (size_t)(4 * i) * Nsrc)) : (f32x4){0.f, 0.f, 0.f, 0.f};
    const int c = lane & 7;
    f32x4 ks0 = {1.f, 1.f, 1.f, 1.f}, ks1 = ks0;
    if (kscale) { ks0 = *(const f32x4*)(kscale + k0 + 8 * c); ks1 = *(const f32x4*)(kscale + k0 + 8 * c + 4); }
#pragma unroll
    for (int i = 0; i < 16; ++i) { LAS float* d = scr + (4 * i + kr) * 65 + 4 * l16; d[0] = v[i][0]; d[1] = v[i][1]; d[2] = v[i][2]; d[3] = v[i][3]; }
    LDS_WAIT(); asm volatile("" ::: "memory");
    const int dbase = (mode == 0) ? (drow0 + n0) : ((n0 >> 7) * 256 + (n0 & 127) + (mode == 2 ? 128 : 0));
#pragma unroll
    for (int jj = 0; jj < 8; ++jj) { const int n = (lane >> 3) + 8 * jj; const LAS float* sp = scr + (8 * c) * 65 + n;
        v4u o; o.x = pk2(sp[0 * 65] * ks0[0], sp[1 * 65] * ks0[1]); o.y = pk2(sp[2 * 65] * ks0[2], sp[3 * 65] * ks0[3]); o.z = pk2(sp[4 * 65] * ks1[0], sp[5 * 65] * ks1[1]); o.w = pk2(sp[6 * 65] * ks1[2], sp[7 * 65] * ks1[3]);
        if (n0 + n < ncols) *(v4u*)(WT + (size_t)(dbase + n) * K + k0 + 8 * c) = o; }
    LDS_WAIT(); asm volatile("" ::: "memory");
}
#define CVT_SEC(W, K, Nsrc, c0, ncols, WT, drow0, mode, ksc) { const int cnt_ = ((K) / 64) * (((ncols) + 63) / 64); if (r < cnt_) { cvt_item(W, K, Nsrc, c0, ncols, WT, drow0, mode, ksc, scr, r, lane); continue; } r -= cnt_; }
template <class PS> __device__ __forceinline__ void convert_layer(const PS& P, unsigned char* wsb, int l, LAS unsigned char* lds, int gw, int NGW, int wave, int lane) {
    LAS float* scr = (LAS float*)(lds + wave * 16896);
    unsigned char* wb = wsb + WS_WB; const int j = l >> 1;
    const size_t FW = (size_t)1024 * 2816;
    const float* g1 = P(2) + l * FW; const float* u1 = P(3) + l * FW; const float* d1 = P(4) + l * FW;
    const float* g2 = P(7) + l * FW; const float* u2 = P(8) + l * FW; const float* d2 = P(9) + l * FW;
    const float* n1 = P(1) + l * 1024; const float* nm = P(5) + l * 1024; const float* n2 = P(6) + l * 1024;
    const float* win = P(10) + (size_t)j * 1024 * 4624; const float* wout = P(24) + (size_t)j * 2048 * 1024;
    const float* wqkv = P(25) + (size_t)j * 1024 * 3072; const float* wo = P(31) + (size_t)j * 1024 * 1024;
    bf16* GU1 = (bf16*)(wb + WB_GU1); bf16* D1 = (bf16*)(wb + WB_D1); bf16* GU2 = (bf16*)(wb + WB_GU2); bf16* D2 = (bf16*)(wb + WB_D2); bf16* MI = (bf16*)(wb + WB_MI); bf16* MO = (bf16*)(wb + WB_MO);
    const bool even = (l & 1) == 0;
    for (int it = gw; ; it += NGW) {
        int r = it;
        CVT_SEC(g1, 1024, 2816, 0, 2816, GU1, 0, 1, n1)
        CVT_SEC(u1, 1024, 2816, 0, 2816, GU1, 0, 2, n1)
        CVT_SEC(d1, 2816, 1024, 0, 1024, D1, 0, 0, nullptr)
        CVT_SEC(g2, 1024, 2816, 0, 2816, GU2, 0, 1, n2)
        CVT_SEC(u2, 1024, 2816, 0, 2816, GU2, 0, 2, n2)
        CVT_SEC(d2, 2816, 1024, 0, 1024, D2, 0, 0, nullptr)
        if (even) {
            CVT_SEC(win, 1024, 4624, 0, 1024, MI, 0, 0, nm)
            CVT_SEC(win, 1024, 4624, 1024, 1536, MI, 2048, 0, nm)
            CVT_SEC(win, 1024, 4624, 2560, 16, MI, 4608, 0, nm)
            CVT_SEC(win, 1024, 4624, 2576, 1024, MI, 1024, 0, nm)
            CVT_SEC(win, 1024, 4624, 3600, 1024, MI, 3584, 0, nm)
            CVT_SEC(wout, 2048, 1024, 0, 1024, MO, 0, 0, nullptr)
        } else {
            CVT_SEC(wqkv, 1024, 3072, 0, 3072, MI, 0, 0, nm)
            CVT_SEC(wo, 1024, 1024, 0, 1024, MO, 0, 0, nullptr)
        }
        break;
    }
}
__device__ __forceinline__ void prologue(const Args& a, LAS unsigned char* lds, int gw, int NGW, int wave, int lane, int gtid, int NGT) {
    float* rowss = (float*)(a.ws + WS_ROWSS); bf16* HB = (bf16*)(a.ws + WS_HB);
    for (int m = gw; m < M; m += NGW) {
        const f32x4* xr = (const f32x4*)(a.in[0] + (size_t)m * 1024) + lane; v2u* hb = (v2u*)(HB + (size_t)m * 1024) + lane;
        float s = 0.f;
#pragma unroll
        for (int j = 0; j < 4; ++j) { const f32x4 v = __builtin_nontemporal_load(xr + 64 * j); s += (v.x * v.x + v.y * v.y) + (v.z * v.z + v.w * v.w);
#if RESID_LO
            const unsigned e0 = pg8::EpiResid::enc(v.x), e1 = pg8::EpiResid::enc(v.y), e2 = pg8::EpiResid::enc(v.z), e3 = pg8::EpiResid::enc(v.w);
            v2u w; w.x = (e0 >> 16) | (e1 & 0xffff0000u); w.y = (e2 >> 16) | (e3 & 0xffff0000u); hb[64 * j] = w;
            const unsigned n4 = ((e0 >> 12) & 0xfu) | ((e1 >> 8) & 0xf0u) | ((e2 >> 4) & 0xf00u) | (e3 & 0xf000u);
            const unsigned nn = __shfl_xor(n4, 1);
            if ((lane & 1) == 0) ((unsigned*)(a.ws + WS_LO))[(size_t)m * 128 + ((lane + 64 * j) >> 1)] = n4 | (nn << 16);
#else
            v2u w; w.x = pk2(v.x, v.y); w.y = pk2(v.z, v.w); hb[64 * j] = w;
#endif
        }
        s = wave_sum(s); if (lane < 16) rowss[(size_t)m * 16 + lane] = (lane == 0) ? s : 0.f;
    }
    { float* rope = (float*)(a.ws + WS_ROPE);
      for (int i = gtid; i < 2048 * 8; i += NGT) { const int t = i >> 3, k = i & 7; const float inv = exp2f(-(float)k * (18.931568569324174f / 8.0f)); const float ang = (float)t * inv;
          float rev = ang * 0.15915494309189535f; rev -= floorf(rev); rope[t * 16 + k] = __builtin_amdgcn_cosf(rev); rope[t * 16 + 8 + k] = __builtin_amdgcn_sinf(rev); } }
    if (threadIdx.x == 0) { const float** tab = (const float**)(a.ws + WS_TAB);
#pragma unroll
        for (int i = 0; i < 33; ++i) tab[i] = a.in[i];
        tab[33] = a.out; }
    convert_layer(FromArgs{a}, a.ws, 0, lds, gw, NGW, wave, lane);
}

#define WG_BAR() do { asm volatile("s_waitcnt lgkmcnt(0)" ::: "memory"); __builtin_amdgcn_s_barrier(); asm volatile("" ::: "memory"); } while (0)
#define MFMA16(a, b, c) __builtin_amdgcn_mfma_f32_16x16x32_bf16(a, b, c, 0, 0, 0)
#define LDF(off) (*(const LAS bf16x8*)(lds + (off)))
constexpr int P2 = 272;
constexpr int L_C = 0, L_B = 34816, L_BWT = 69632, L_XT = 104448, L_S = 121856, L_CSALL = 139264  , L_DTALL = 147456  ;
__device__ __forceinline__ void unpack8(const v4u r, float (&f)[8]) { f[0] = bflo(r.x); f[1] = bfhi(r.x); f[2] = bflo(r.y); f[3] = bfhi(r.y); f[4] = bflo(r.z); f[5] = bfhi(r.z); f[6] = bflo(r.w); f[7] = bfhi(r.w); }

constexpr size_t BC2_OFF = (size_t)M * PL;
__device__ __forceinline__ void bc_preconv_pass(bf16* BIG, const float* cw, const float* cb, int gtid, int NGT) {
    for (int it = gtid; it < 64 * 4096; it += NGT) { const int cg = it & 63, strip = it >> 6; const int ch = 1024 + cg * 8, r0 = strip * 8, tb = r0 & (SEQ - 1);
        float w[4][8], bias[8];
#pragma unroll
        for (int k = 0; k < 4; ++k) { const f32x4 wa = *(const f32x4*)(cw + k * 1536 + ch), wb = *(const f32x4*)(cw + k * 1536 + ch + 4);
            w[k][0] = wa.x; w[k][1] = wa.y; w[k][2] = wa.z; w[k][3] = wa.w; w[k][4] = wb.x; w[k][5] = wb.y; w[k][6] = wb.z; w[k][7] = wb.w; }
        { const f32x4 ba = *(const f32x4*)(cb + ch), bb = *(const f32x4*)(cb + ch + 4); bias[0] = ba.x; bias[1] = ba.y; bias[2] = ba.z; bias[3] = ba.w; bias[4] = bb.x; bias[5] = bb.y; bias[6] = bb.z; bias[7] = bb.w; }
        v4u raw[11];
#pragma unroll
        for (int s = 0; s < 11; ++s) { const bool ok = (tb + s - 3 >= 0); const v4u t_ = __builtin_nontemporal_load((const GAS v4u*)(BIG + (size_t)(ok ? r0 + s - 3 : r0) * PL + OFF_B + cg * 8)); const unsigned mk = ok ? 0xffffffffu : 0u; raw[s] = (v4u){t_.x & mk, t_.y & mk, t_.z & mk, t_.w & mk}; }
#pragma unroll
        for (int s = 0; s < 8; ++s) { float val[8];
#pragma unroll
            for (int c = 0; c < 8; ++c) val[c] = bias[c];
#pragma unroll
            for (int k = 0; k < 4; ++k) { float f[8]; unpack8(raw[s + k], f);
#pragma unroll
                for (int c = 0; c < 8; ++c) val[c] += w[k][c] * f[c]; }
#pragma unroll
            for (int c = 0; c < 8; ++c) val[c] = silu_f(val[c]);
            v4u o; o.x = pk2(val[0], val[1]); o.y = pk2(val[2], val[3]); o.z = pk2(val[4], val[5]); o.w = pk2(val[6], val[7]);
            *(GAS v4u*)(BIG + BC2_OFF + (size_t)(r0 + s) * 512 + cg * 8) = o; }
    }
}
__device__ __forceinline__ void ssd_unit(LAS unsigned char* lds, int b, int h, int j, unsigned char* ws, const bool DRY) {
    int tid_ = threadIdx.x; asm volatile("" : "+v"(tid_));
    const int tid = tid_, wid = __builtin_amdgcn_readfirstlane(tid >> 6), lane = tid & 63, fr = lane & 15, fq = lane >> 4;
    const int g = h >> 3;
    { unsigned zz = 0u; asm volatile("" : "+v"(zz)); for (int i = tid; i < 17408 / 16; i += 512) *(LAS v4u*)(lds + L_S + i * 16) = (v4u){zz, zz, zz, zz}; }
    f32x4 S[4];
#pragma unroll
    for (int i = 0; i < 4; ++i) S[i] = (f32x4){0.f, 0.f, 0.f, 0.f};
    const int p0 = (wid & 3) * 16, n0 = (wid >> 2) * 64;
    const int xcg8 = tid & 7, xts = tid >> 3;
    float dt_bias, a_h, d_h; { const float* const* tab0 = (const float* const*)(ws + WS_TAB); dt_bias = tab0[13][j * 16 + h]; a_h = -__expf(tab0[14][j * 16 + h]); d_h = tab0[15][j * 16 + h]; }
    float xw[4][8], xbias[8];
    { const float* const* tab0 = (const float* const*)(ws + WS_TAB); const float* cw = tab0[11] + (size_t)j * 4 * 1536; const float* cb = tab0[12] + (size_t)j * 1536; const int ch = h * 64 + xcg8 * 8;
#pragma unroll
      for (int k = 0; k < 4; ++k) { const f32x4 wa = *(const f32x4*)(cw + k * 1536 + ch), wb = *(const f32x4*)(cw + k * 1536 + ch + 4);
          xw[k][0] = wa.x; xw[k][1] = wa.y; xw[k][2] = wa.z; xw[k][3] = wa.w; xw[k][4] = wb.x; xw[k][5] = wb.y; xw[k][6] = wb.z; xw[k][7] = wb.w; }
      const f32x4 ba = *(const f32x4*)(cb + ch), bb = *(const f32x4*)(cb + ch + 4); xbias[0] = ba.x; xbias[1] = ba.y; xbias[2] = ba.z; xbias[3] = ba.w; xbias[4] = bb.x; xbias[5] = bb.y; xbias[6] = bb.z; xbias[7] = bb.w; }
    {
        const GAS float* dtp = (const GAS float*)(ws + WS_DT) + ((size_t)b * SEQ + 4 * tid) * 16 + h;
        float d[4], p[4];
#pragma unroll
        for (int i = 0; i < 4; ++i) { const float x = dtp[i * 16] + dt_bias; d[i] = x > 20.f ? x : log1pf(__expf(x)); }
        p[0] = d[0] * a_h; p[1] = p[0] + d[1] * a_h; p[2] = p[1] + d[2] * a_h; p[3] = p[2] + d[3] * a_h;
        float sc = p[3];
#pragma unroll
        for (int o = 1; o < 32; o <<= 1) { const float v = __shfl_up(sc, o); if ((lane & 31) >= o) sc += v; }
        const float ex = sc - p[3];
        *(LAS f32x4*)(lds + L_CSALL + tid * 16) = (f32x4){ex + p[0], ex + p[1], ex + p[2], ex + p[3]}; *(LAS f32x4*)(lds + L_DTALL + tid * 16) = (f32x4){d[0], d[1], d[2], d[3]};
    }
    WG_BAR();
    for (int chunk = 0; chunk < 16; ++chunk) {
        const int t0 = chunk * 128; const size_t row0 = (size_t)b * SEQ + t0;
        unsigned char* wsl = ws; asm volatile("" : "+s"(wsl));
        bf16* proj = (bf16*)(wsl + WS_BIG); const float* const* tab = (const float* const*)(wsl + WS_TAB);
        const LAS float* csA = (const LAS float*)(lds + L_CSALL) + t0; const LAS float* dtA = (const LAS float*)(lds + L_DTALL) + t0;
        {
            int tl = tid; asm volatile("" : "+v"(tl)); const int cgp = tl & 31, ts = tl >> 5; const bool isB = cgp < 16;
            const bf16* src = proj + BC2_OFF + (row0 + 8 * ts) * 512 + (isB ? 0 : 256) + g * 128 + (cgp & 15) * 8;
            v4u raw[8];
#pragma unroll
            for (int s = 0; s < 8; ++s) raw[s] = *(const GAS v4u*)(src + (size_t)s * 512);
#pragma unroll
            for (int s = 0; s < 8; ++s) *(LAS v4u*)(lds + (isB ? L_B : L_C) + (8 * ts + s) * P2 + (cgp & 15) * 16) = raw[s];
            if (isB) {
                float val[8][8], wj[8];
#pragma unroll
                for (int s = 0; s < 8; ++s) { unpack8(raw[s], val[s]); wj[s] = dtA[8 * ts + s] * __expf(csA[127] - csA[8 * ts + s]); }
#pragma unroll
                for (int c = 0; c < 8; ++c) { v4u o; o.x = pk2(val[0][c] * wj[0], val[1][c] * wj[1]); o.y = pk2(val[2][c] * wj[2], val[3][c] * wj[3]); o.z = pk2(val[4][c] * wj[4], val[5][c] * wj[5]); o.w = pk2(val[6][c] * wj[6], val[7][c] * wj[7]);
                    *(LAS v4u*)(lds + L_BWT + ((cgp & 15) * 8 + c) * P2 + (8 * ts) * 2) = o; }
            }
        }
        {
            const int cg8 = xcg8, ts = xts, col = OFF_XA + h * 64 + cg8 * 8;
            v4u raw[5];
#pragma unroll
            for (int s = 0; s < 5; ++s) { const int t = t0 + 2 * ts + s - 3; const v4u t_ = *(const GAS v4u*)(proj + ((size_t)b * SEQ + (t >= 0 ? t : 0)) * PL + col); const unsigned mk = (t >= 0) ? 0xffffffffu : 0u; raw[s] = (v4u){t_.x & mk, t_.y & mk, t_.z & mk, t_.w & mk}; }
            float val[2][8];
#pragma unroll
            for (int s = 0; s < 2; ++s) {
#pragma unroll
                for (int c = 0; c < 8; ++c) val[s][c] = xbias[c];
#pragma unroll
                for (int k = 0; k < 4; ++k) { float f[8]; unpack8(raw[s + k], f);
#pragma unroll
                    for (int c = 0; c < 8; ++c) val[s][c] += xw[k][c] * f[c]; }
#pragma unroll
                for (int c = 0; c < 8; ++c) val[s][c] = silu_f(val[s][c]);
            }
#pragma unroll
            for (int c = 0; c < 8; ++c) *(LAS unsigned*)(lds + L_XT + (cg8 * 8 + c) * P2 + (2 * ts) * 2) = pk2(val[0][c], val[1][c]);
        }
        WG_BAR();
        const int irow = 16 * wid + fr;
        v2u zr[4];
#pragma unroll
        for (int pt = 0; pt < 4; ++pt) zr[pt] = *(const GAS v2u*)(proj + (row0 + irow) * PL + OFF_Z + h * 64 + 16 * pt + 4 * fq);
        f32x4 cbv[8], yo[4];
#pragma unroll
        for (int i = 0; i < 8; ++i) cbv[i] = (f32x4){0.f, 0.f, 0.f, 0.f};
#pragma unroll
        for (int i = 0; i < 4; ++i) yo[i] = (f32x4){0.f, 0.f, 0.f, 0.f};
        { const float cd = __expf(csA[127]);
#pragma unroll
          for (int i = 0; i < 4; ++i) S[i] = S[i] * cd; }
#pragma unroll
        for (int kk = 0; kk < 4; ++kk) {
            const bf16x8 cf = LDF(L_C + irow * P2 + kk * 64 + fq * 16);
#pragma unroll
            for (int jt = 0; jt < 8; ++jt) if (jt <= wid) cbv[jt] = MFMA16(LDF(L_B + (16 * jt + fr) * P2 + kk * 64 + fq * 16), cf, cbv[jt]);
#pragma unroll
            for (int pt = 0; pt < 4; ++pt) yo[pt] = MFMA16(LDF(L_S + (16 * pt + fr) * P2 + kk * 64 + fq * 16), cf, yo[pt]);
            const bf16x8 xf = LDF(L_XT + (p0 + fr) * P2 + kk * 64 + fq * 16);
#pragma unroll
            for (int nt = 0; nt < 4; ++nt) S[nt] = MFMA16(LDF(L_BWT + (n0 + 16 * nt + fr) * P2 + kk * 64 + fq * 16), xf, S[nt]);
        }
        WG_BAR();
        const float csi = csA[irow];
#pragma unroll
        for (int jt = 0; jt < 8; ++jt) { const int j0 = 16 * jt + 4 * fq; v2u o = {0u, 0u};
            if (jt <= wid) { const f32x4 csj = *(const LAS f32x4*)(csA + j0), dtj = *(const LAS f32x4*)(dtA + j0); float gv[4];
#pragma unroll
                for (int r = 0; r < 4; ++r) gv[r] = (j0 + r <= irow) ? cbv[jt][r] * __expf(csi - csj[r]) * dtj[r] : 0.f;
                o.x = pk2(gv[0], gv[1]); o.y = pk2(gv[2], gv[3]); }
            *(LAS v2u*)(lds + L_B + irow * P2 + j0 * 2) = o; }
#pragma unroll
        for (int nt = 0; nt < 4; ++nt) { v2u o; o.x = pk2(S[nt][0], S[nt][1]); o.y = pk2(S[nt][2], S[nt][3]); *(LAS v2u*)(lds + L_S + (p0 + fr) * P2 + (n0 + 16 * nt + 4 * fq) * 2) = o; }
        WG_BAR();
        { const float ei = __expf(csi); f32x4 y[4]; float* gss = (float*)(wsl + WS_GSS);
#pragma unroll
          for (int pt = 0; pt < 4; ++pt) y[pt] = yo[pt] * ei;
#pragma unroll
          for (int kk = 0; kk < 4; ++kk) { const bf16x8 gf = LDF(L_B + irow * P2 + kk * 64 + fq * 16);
#pragma unroll
              for (int pt = 0; pt < 4; ++pt) y[pt] = MFMA16(LDF(L_XT + (16 * pt + fr) * P2 + kk * 64 + fq * 16), gf, y[pt]); }
          float ss = 0.f;
#pragma unroll
          for (int pt = 0; pt < 4; ++pt) { float o[4]; const float zf[4] = {bflo(zr[pt].x), bfhi(zr[pt].x), bflo(zr[pt].y), bfhi(zr[pt].y)};
#pragma unroll
              for (int r = 0; r < 4; ++r) { const int p = 16 * pt + 4 * fq + r; const float xv = bf1(*(const LAS bf16*)(lds + L_XT + p * P2 + irow * 2));
                  const float yv = (y[pt][r] + d_h * xv) * silu_f(zf[r]); o[r] = yv; ss += yv * yv; }
              v2u w; w.x = pk2(o[0], o[1]); w.y = pk2(o[2], o[3]); if (!DRY) *(GAS v2u*)(proj + (row0 + irow) * PL + OFF_Z + h * 64 + 16 * pt + 4 * fq) = w; }
          ss += __shfl_xor(ss, 16); ss += __shfl_xor(ss, 32);
          if (fq == 0 && !DRY) ((GAS float*)gss)[(row0 + irow) * 16 + h] = ss; }
        WG_BAR();
    }
}
constexpr int P1 = 144;
constexpr int L_WRA = 0, L_WIX = 9216, L_XBM = 18432, L_AS = 36864, L_US = 71680, L_SEGA = 106496, L_SEGH = 108544, L_CARRY = 110592;
__device__ __forceinline__ void lru_unit(LAS unsigned char* lds, int b, int blk, int j, unsigned char* ws, const bool DRY) {
    int tid_ = threadIdx.x; asm volatile("" : "+v"(tid_));
    const int tid = tid_, wid = __builtin_amdgcn_readfirstlane(tid >> 6), lane = tid & 63, fr = lane & 15, fq = lane >> 4;
    const int cbase = blk * 64;
    const float* const* tab = (const float* const*)(ws + WS_TAB);
    const float* cw = tab[17] + (size_t)j * 4 * 1024; const float* cb = tab[18] + (size_t)j * 1024; const float* wra = tab[19] + ((size_t)j * 16 + blk) * 4096; const float* wix = tab[21] + ((size_t)j * 16 + blk) * 4096;
    const float* bra = tab[20] + (size_t)j * 1024; const float* bix = tab[22] + (size_t)j * 1024; const float* lam = tab[23] + (size_t)j * 1024;
    for (int q = 0; q < 8; ++q) { const int e = tid + 512 * q, i = e >> 6, j = e & 63;
        *(LAS bf16*)(lds + L_WRA + j * P1 + i * 2) = (bf16)(pk2(wra[e], 0.f) & 0xffffu); *(LAS bf16*)(lds + L_WIX + j * P1 + i * 2) = (bf16)(pk2(wix[e], 0.f) & 0xffffu); }
    if (tid < 128) ((LAS float*)(lds + L_CARRY))[tid] = 0.f;
    f32x4 braV[4], bixV[4], spV[4];
#pragma unroll
    for (int jt = 0; jt < 4; ++jt) { const int j0 = cbase + 16 * jt + 4 * fq; braV[jt] = *(const f32x4*)(bra + j0); bixV[jt] = *(const f32x4*)(bix + j0); const f32x4 lv = *(const f32x4*)(lam + j0);
#pragma unroll
        for (int r = 0; r < 4; ++r) { const float x = -lv[r]; spV[jt][r] = -8.0f * (x > 20.f ? x : log1pf(__expf(x))); } }
    const int cg8 = tid & 7, ts = tid >> 3, cch = cbase + cg8 * 8;
    float w[4][8], bias[8];
#pragma unroll
    for (int k = 0; k < 4; ++k) { const f32x4 wa = *(const f32x4*)(cw + k * 1024 + cch), wb = *(const f32x4*)(cw + k * 1024 + cch + 4);
        w[k][0] = wa.x; w[k][1] = wa.y; w[k][2] = wa.z; w[k][3] = wa.w; w[k][4] = wb.x; w[k][5] = wb.y; w[k][6] = wb.z; w[k][7] = wb.w; }
    { const f32x4 ba = *(const f32x4*)(cb + cch), bb = *(const f32x4*)(cb + cch + 4); bias[0] = ba.x; bias[1] = ba.y; bias[2] = ba.z; bias[3] = ba.w; bias[4] = bb.x; bias[5] = bb.y; bias[6] = bb.z; bias[7] = bb.w; }
    WG_BAR();
    for (int tile = 0; tile < 16; ++tile) {
        const int t0 = tile * 128; const size_t row0 = (size_t)b * SEQ + t0;
        unsigned char* wsl = ws; asm volatile("" : "+s"(wsl)); bf16* proj = (bf16*)(wsl + WS_BIG);
        {
            v4u raw[5];
#pragma unroll
            for (int s = 0; s < 5; ++s) { const int t = t0 + 2 * ts + s - 3; const v4u t_ = *(const GAS v4u*)(proj + ((size_t)b * SEQ + (t >= 0 ? t : 0)) * PL + OFF_XB + cch); const unsigned mk = (t >= 0) ? 0xffffffffu : 0u; raw[s] = (v4u){t_.x & mk, t_.y & mk, t_.z & mk, t_.w & mk}; }
#pragma unroll
            for (int s = 0; s < 2; ++s) { float val[8];
#pragma unroll
                for (int c = 0; c < 8; ++c) val[c] = bias[c];
#pragma unroll
                for (int k = 0; k < 4; ++k) { float f[8]; unpack8(raw[s + k], f);
#pragma unroll
                    for (int c = 0; c < 8; ++c) val[c] += w[k][c] * f[c]; }
                v4u o; o.x = pk2(val[0], val[1]); o.y = pk2(val[2], val[3]); o.z = pk2(val[4], val[5]); o.w = pk2(val[6], val[7]);
                *(LAS v4u*)(lds + L_XBM + (2 * ts + s) * P1 + cg8 * 16) = o; }
        }
        WG_BAR();
        {
            const int trow = 16 * wid + fr; f32x4 R[4], I[4];
#pragma unroll
            for (int i = 0; i < 4; ++i) { R[i] = (f32x4){0.f, 0.f, 0.f, 0.f}; I[i] = R[i]; }
#pragma unroll
            for (int kk = 0; kk < 2; ++kk) { const bf16x8 xf = LDF(L_XBM + trow * P1 + kk * 64 + fq * 16);
#pragma unroll
                for (int jt = 0; jt < 4; ++jt) { R[jt] = MFMA16(LDF(L_WRA + (16 * jt + fr) * P1 + kk * 64 + fq * 16), xf, R[jt]); I[jt] = MFMA16(LDF(L_WIX + (16 * jt + fr) * P1 + kk * 64 + fq * 16), xf, I[jt]); } }
#pragma unroll
            for (int jt = 0; jt < 4; ++jt) { const v2u xw = *(const LAS v2u*)(lds + L_XBM + trow * P1 + (16 * jt + 4 * fq) * 2); const float xb[4] = {bflo(xw.x), bfhi(xw.x), bflo(xw.y), bfhi(xw.y)}; f32x4 av, uv;
#pragma unroll
                for (int r = 0; r < 4; ++r) { const float rg = sigmoid_f(R[jt][r] + braV[jt][r]), ig = sigmoid_f(I[jt][r] + bixV[jt][r]); const float la = rg * spV[jt][r];
                    av[r] = __expf(la); uv[r] = __builtin_amdgcn_sqrtf(fmaxf(1.0f - __expf(2.0f * la), 0.f)) * ig * xb[r]; }
                *(LAS f32x4*)(lds + L_AS + trow * P2 + (16 * jt + 4 * fq) * 4) = av; *(LAS f32x4*)(lds + L_US + trow * P2 + (16 * jt + 4 * fq) * 4) = uv; }
        }
        WG_BAR();
        {
            const int c = lane; bf16 gv[16];
#pragma unroll
            for (int s = 0; s < 16; ++s) gv[s] = ((const GAS bf16*)proj)[(row0 + 16 * wid + s) * PL + OFF_GATE + cbase + c];
            float hl = 0.f, ap = 1.f;
#pragma unroll
            for (int s = 0; s < 16; ++s) { LAS float* pa = (LAS float*)(lds + L_AS + (16 * wid + s) * P2) + c; LAS float* pu = (LAS float*)(lds + L_US + (16 * wid + s) * P2) + c;
                const float av = *pa, uv = *pu; hl = av * hl + uv; ap *= av; *pu = hl; *pa = ap; }
            ((LAS float*)(lds + L_SEGA))[wid * 64 + c] = ap; ((LAS float*)(lds + L_SEGH))[wid * 64 + c] = hl;
            WG_BAR();
            float hin = ((LAS float*)(lds + L_CARRY))[(tile & 1) * 64 + c];
            for (int q = 0; q < wid; ++q) hin = ((LAS float*)(lds + L_SEGA))[q * 64 + c] * hin + ((LAS float*)(lds + L_SEGH))[q * 64 + c];
            if (wid == 7) ((LAS float*)(lds + L_CARRY))[((tile + 1) & 1) * 64 + c] = ap * hin + hl;
#pragma unroll
            for (int s = 0; s < 16; ++s) { const float hv = ((LAS float*)(lds + L_US + (16 * wid + s) * P2))[c] + ((LAS float*)(lds + L_AS + (16 * wid + s) * P2))[c] * hin;
                const float x = bf1(gv[s]); const float ge = x * sigmoid_f(1.5957691216057308f * (x + 0.044715f * x * x * x));
                if (!DRY) ((GAS bf16*)proj)[(row0 + 16 * wid + s) * PL + OFF_GATE + cbase + c] = (bf16)(pk2(ge * hv, 0.f) & 0xffffu); }
        }
        WG_BAR();
    }
}
__device__ __forceinline__ void ssd_norm_pass(bf16* proj, const float* gss, const float* nw, int gw, int NGW, int lane) {
    const f32x4 w0a = *(const f32x4*)(nw + lane * 8), w0b = *(const f32x4*)(nw + lane * 8 + 4), w1a = *(const f32x4*)(nw + 512 + lane * 8), w1b = *(const f32x4*)(nw + 512 + lane * 8 + 4);
    for (int m0 = gw; m0 < M; m0 += 4 * NGW) {
        f32x4 ga[4], gb[4], gc[4], gd[4]; v4u a[4], c[4];
#pragma unroll
        for (int q = 0; q < 4; ++q) { const int m = m0 + q * NGW; if (m < M) { const f32x4* gp = (const f32x4*)(gss + (size_t)m * 16); ga[q] = gp[0]; gb[q] = gp[1]; gc[q] = gp[2]; gd[q] = gp[3];
            const bf16* rp = proj + (size_t)m * PL; a[q] = *(const v4u*)(rp + lane * 8); c[q] = *(const v4u*)(rp + 512 + lane * 8); } }
#pragma unroll
        for (int q = 0; q < 4; ++q) { const int m = m0 + q * NGW; if (m < M) { bf16* rp = proj + (size_t)m * PL;
            const float r0 = __builtin_amdgcn_rsqf((((ga[q][0] + ga[q][1]) + (ga[q][2] + ga[q][3])) + ((gb[q][0] + gb[q][1]) + (gb[q][2] + gb[q][3]))) * (1.0f / 512.0f) + EPS), r1 = __builtin_amdgcn_rsqf((((gc[q][0] + gc[q][1]) + (gc[q][2] + gc[q][3])) + ((gd[q][0] + gd[q][1]) + (gd[q][2] + gd[q][3]))) * (1.0f / 512.0f) + EPS);
            float f[8]; v4u o;
            unpack8(a[q], f); o.x = pk2(f[0] * r0 * w0a.x, f[1] * r0 * w0a.y); o.y = pk2(f[2] * r0 * w0a.z, f[3] * r0 * w0a.w); o.z = pk2(f[4] * r0 * w0b.x, f[5] * r0 * w0b.y); o.w = pk2(f[6] * r0 * w0b.z, f[7] * r0 * w0b.w); *(v4u*)(rp + lane * 8) = o;
            unpack8(c[q], f); o.x = pk2(f[0] * r1 * w1a.x, f[1] * r1 * w1a.y); o.y = pk2(f[2] * r1 * w1a.z, f[3] * r1 * w1a.w); o.z = pk2(f[4] * r1 * w1b.x, f[5] * r1 * w1b.y); o.w = pk2(f[6] * r1 * w1b.z, f[7] * r1 * w1b.w); *(v4u*)(rp + 512 + lane * 8) = o; } }
    }
}
__device__ __forceinline__ void diff_combine_pass(bf16* O, const float* lq1, const float* lk1, const float* lq2, const float* lk2, const float* subln, float lambda_init, int gw, int NGW, int lane) {
    const float lamv = __expf(wave_sum(lq1[lane] * lk1[lane])) - __expf(wave_sum(lq2[lane] * lk2[lane])) + lambda_init;
    const int e0 = (lane & 15) * 8; const f32x4 wa = *(const f32x4*)(subln + e0), wb = *(const f32x4*)(subln + e0 + 4); const float os = 1.0f - lambda_init;
    for (int m0 = gw; m0 < M; m0 += 4 * NGW) {
        v4u a[4][2], c[4][2];
#pragma unroll
        for (int q = 0; q < 4; ++q) { const int m = m0 + q * NGW; if (m < M) { const bf16* rp = O + (size_t)m * 2048;
#pragma unroll
            for (int hf = 0; hf < 2; ++hf) { a[q][hf] = *(const v4u*)(rp + hf * 512 + lane * 8); c[q][hf] = *(const v4u*)(rp + 1024 + hf * 512 + lane * 8); } } }
#pragma unroll
        for (int q = 0; q < 4; ++q) { const int m = m0 + q * NGW; if (m < M) { bf16* rp = O + (size_t)m * 2048;
#pragma unroll
            for (int hf = 0; hf < 2; ++hf) { const int col = hf * 512 + lane * 8; float f1[8], f2[8], o[8]; unpack8(a[q][hf], f1); unpack8(c[q][hf], f2); float ss = 0.f;
#pragma unroll
                for (int i = 0; i < 8; ++i) { o[i] = f1[i] - lamv * f2[i]; ss += o[i] * o[i]; }
                ss += __shfl_xor(ss, 1); ss += __shfl_xor(ss, 2); ss += __shfl_xor(ss, 4); ss += __shfl_xor(ss, 8);
                const float rs = os * __builtin_amdgcn_rsqf(ss * (1.0f / 128.0f) + EPS);
                v4u w; w.x = pk2(o[0] * rs * wa.x, o[1] * rs * wa.y); w.y = pk2(o[2] * rs * wa.z, o[3] * rs * wa.w); w.z = pk2(o[4] * rs * wb.x, o[5] * rs * wb.y); w.w = pk2(o[6] * rs * wb.z, o[7] * rs * wb.w);
                *(v4u*)(rp + col) = w; } } }
    }
}
__device__ __forceinline__ void final_norm_pass(float* out, const bf16* HB, const unsigned* LO, const float* rowss, const float* nw, int gw, int NGW, int lane) {
    const f32x4 wa = *(const f32x4*)(nw + lane * 8), wb = *(const f32x4*)(nw + lane * 8 + 4), wc = *(const f32x4*)(nw + 512 + lane * 8), wd = *(const f32x4*)(nw + 512 + lane * 8 + 4);
    for (int m0 = gw; m0 < M; m0 += 4 * NGW) {
        v4u a[4], c[4]; unsigned la[4], lc[4]; float rs[4];
#pragma unroll
        for (int q = 0; q < 4; ++q) { const int m = m0 + q * NGW; if (m < M) { const bf16* hp = HB + (size_t)m * 1024; a[q] = *(const v4u*)(hp + lane * 8); c[q] = *(const v4u*)(hp + 512 + lane * 8);
#if RESID_LO
            const unsigned* lp = LO + (size_t)m * 128; la[q] = lp[lane]; lc[q] = lp[64 + lane];
#else
            la[q] = 0u; lc[q] = 0u;
#endif
            rs[q] = pg8::rstd_of(rowss, m); } }
#pragma unroll
        for (int q = 0; q < 4; ++q) { const int m = m0 + q * NGW; if (m < M) { float* op = out + (size_t)m * 1024; float f[8]; const float r = rs[q];
            pg8::EpiResid::dec8(a[q], la[q], f); __builtin_nontemporal_store((f32x4){f[0] * r * wa.x, f[1] * r * wa.y, f[2] * r * wa.z, f[3] * r * wa.w}, (f32x4*)(op + lane * 8)); __builtin_nontemporal_store((f32x4){f[4] * r * wb.x, f[5] * r * wb.y, f[6] * r * wb.z, f[7] * r * wb.w}, (f32x4*)(op + lane * 8 + 4));
            pg8::EpiResid::dec8(c[q], lc[q], f); __builtin_nontemporal_store((f32x4){f[0] * r * wc.x, f[1] * r * wc.y, f[2] * r * wc.z, f[3] * r * wc.w}, (f32x4*)(op + 512 + lane * 8)); __builtin_nontemporal_store((f32x4){f[4] * r * wd.x, f[5] * r * wd.y, f[6] * r * wd.z, f[7] * r * wd.w}, (f32x4*)(op + 512 + lane * 8 + 4)); } }
    }
}
typedef GAS unsigned gu32;
constexpr size_t WS_CTL = 0, CTL_ZERO_BYTES = 64 * 1024;
constexpr int XB_MISC_OFF = LDS_BYTES - 64;
#define XB_TMO      128
#define XB_XCNT(j)  (256  + 64 * (j))
#define XB_XSUB(j)  (1280 + 64 * (j))
#define XB_XGEN(j)  (2304 + 64 * (j))
#define XB_TOP      3328
#define XB_TOPGEN   3392
#define XCD_BAR_WORDS 3456
#define XB_SPIN_CAP (1u << 18)

__device__ __forceinline__ unsigned xb_ld(unsigned* p)              { return __hip_atomic_load(p, __ATOMIC_RELAXED, __HIP_MEMORY_SCOPE_AGENT); }
__device__ __forceinline__ unsigned xb_add(unsigned* p, unsigned v) { return __hip_atomic_fetch_add(p, v, __ATOMIC_RELAXED, __HIP_MEMORY_SCOPE_AGENT); }
__device__ __forceinline__ unsigned xb_xcc_id() { return (unsigned)__builtin_amdgcn_s_getreg((3 << 11) | 20) & 0xFu; }
#define XB_SPIN(cond, bar) do { unsigned _sp = 0; while (cond) { __builtin_amdgcn_s_sleep(1); \
    if ((++_sp & 255u) == 0u) { if (xb_ld(&(bar)[XB_TMO])) break; if (_sp > XB_SPIN_CAP) { atomicAdd(&(bar)[XB_TMO], 1u); break; } } } } while (0)

struct XcdBarrier {
    unsigned* bar; unsigned x;
    volatile LAS unsigned* st;
};

__device__ __forceinline__ XcdBarrier xcd_barrier_post(unsigned* bar, volatile LAS unsigned* st) {
    XcdBarrier b; b.bar = bar; b.x = xb_xcc_id(); b.st = st;
    if (threadIdx.x == 0) (void)xb_add(&bar[XB_XCNT(b.x)], 1u);
    return b;
}
__device__ __forceinline__ void xcd_barrier_complete(unsigned* bar, unsigned x, unsigned& nloc, unsigned& nx) {
    const unsigned G = gridDim.x * gridDim.y * gridDim.z;
    unsigned sum, cnt, mine, sp = 0u;
    for (;;) {
        sum = 0u; cnt = 0u; mine = 0u;
#pragma unroll
        for (unsigned j = 0; j < 16; ++j) { const unsigned c = xb_ld(&bar[XB_XCNT(j)]); sum += c; cnt += (c > 0u) ? 1u : 0u; mine = (j == x) ? c : mine; }
        if (sum == G) break;
        __builtin_amdgcn_s_sleep(1);
        if ((++sp & 255u) == 0u) { if (xb_ld(&bar[XB_TMO])) break; if (sp > XB_SPIN_CAP) { atomicAdd(&bar[XB_TMO], 1u); break; } }
    }
    nloc = mine > 0u ? mine : 1u; nx = cnt > 0u ? cnt : 1u;
}

__device__ __forceinline__ void xcd_barrier(const XcdBarrier& b) {
    asm volatile("s_waitcnt vmcnt(0)" ::: "memory");
    __syncthreads();
    if (threadIdx.x == 0) {
        unsigned* bar = b.bar;
        __builtin_amdgcn_s_waitcnt(0);
        unsigned nloc = b.st[0], nx = b.st[1];
        if (nloc == 0u) { xcd_barrier_complete(bar, b.x, nloc, nx); b.st[0] = nloc; b.st[1] = nx; }
        const unsigned old = xb_add(&bar[XB_XSUB(b.x)], 1u);
        const unsigned gen = old / nloc;
        if (old + 1u == (gen + 1u) * nloc) {
            __builtin_amdgcn_fence(__ATOMIC_RELEASE, "agent");
            asm volatile("s_waitcnt vmcnt(0)" ::: "memory");
            const unsigned og = xb_add(&bar[XB_TOP], 1u);
            const unsigned tg = og / nx;
            if (og + 1u == (tg + 1u) * nx) xb_add(&bar[XB_TOPGEN], 1u);
            else XB_SPIN(xb_ld(&bar[XB_TOPGEN]) == tg, bar);
            __builtin_amdgcn_fence(__ATOMIC_ACQUIRE, "agent");
            xb_add(&bar[XB_XGEN(b.x)], 1u);
            asm volatile("s_waitcnt vmcnt(0)" ::: "memory");
        } else {
            XB_SPIN(xb_ld(&bar[XB_XGEN(b.x)]) == gen, bar);
            __builtin_amdgcn_fence(__ATOMIC_ACQUIRE, "agent");
            asm volatile("s_waitcnt vmcnt(0)" ::: "memory");
        }
    }
    __syncthreads();
}
__global__ void __launch_bounds__(NWAVES * 64, 2) mega_fwd(Args a) {
    extern __shared__ __attribute__((aligned(16))) unsigned char lds_raw[];
    LAS unsigned char* lds = (LAS unsigned char*)lds_raw;
    cg::grid_group grid = cg::this_grid();
    if (threadIdx.x < 16) ((LAS unsigned*)(lds + XB_MISC_OFF))[threadIdx.x] = 0u;
    __syncthreads();
    { XcdBarrier b0 = xcd_barrier_post((unsigned*)(a.ws + WS_CTL), (volatile LAS unsigned*)(lds + XB_MISC_OFF)); (void)b0; }
#define GSYNC() do { XcdBarrier xb_; xb_.bar = (unsigned*)(a.ws + WS_CTL); xb_.x = xb_xcc_id(); xb_.st = (volatile LAS unsigned*)(lds + XB_MISC_OFF); xcd_barrier(xb_); } while (0)
#define PHASE_ENV() \
    int tidL = threadIdx.x; asm volatile("" : "+v"(tidL)); const int tid = tidL, lane = tid & 63, wave = __builtin_amdgcn_readfirstlane(tid >> 6); \
    int G = gridDim.x, bx = blockIdx.x; asm volatile("" : "+s"(G), "+s"(bx)); const int vcu = (G % 8 == 0) ? (bx % 8) * (G / 8) + bx / 8 : bx; \
    const int gw = vcu * NWAVES + wave, NGW = G * NWAVES, gtid = bx * (NWAVES * 64) + tid, NGT = G * NWAVES * 64; \
    unsigned char* ws = a.ws; asm volatile("" : "+s"(ws)); \
    float* rowss = (float*)(ws + WS_ROWSS); float* gssb = (float*)(ws + WS_GSS); const float* rope = (const float*)(ws + WS_ROPE); float* dtb = (float*)(ws + WS_DT); \
    bf16* HB = (bf16*)(ws + WS_HB); bf16* BIG = (bf16*)(ws + WS_BIG); \
    bf16* GU1 = (bf16*)(ws + WS_WB + WB_GU1); bf16* D1 = (bf16*)(ws + WS_WB + WB_D1); bf16* GU2 = (bf16*)(ws + WS_WB + WB_GU2); bf16* D2 = (bf16*)(ws + WS_WB + WB_D2); \
    bf16* MI = (bf16*)(ws + WS_WB + WB_MI); bf16* MO = (bf16*)(ws + WS_WB + WB_MO); \
    (void)gw; (void)NGW; (void)gtid; (void)NGT; (void)rowss; (void)gssb; (void)rope; (void)dtb; (void)HB; (void)BIG; (void)GU1; (void)D1; (void)GU2; (void)D2; (void)MI; (void)MO; (void)lane; (void)vcu;
    grid.sync();
    { PHASE_ENV()
    prologue(a, lds, gw, NGW, wave, lane, gtid, NGT); }
    GSYNC();
    for (int lo = 0; lo < DEPTH; ++lo) {
#ifdef DUP_MIX
      for (int opx = (lo == 0) ? 1 : 0; opx < 10; ++opx) { const int op = opx < 5 ? opx : opx - 1; bool dry = (opx == 4);
        if (dry && (lo & 1)) continue;
#else
      for (int op = (lo == 0) ? 1 : 0; op < 10; ++op) { const bool dry = false;
#endif
        int l = lo; asm volatile("" : "+s"(l));
        const int j = l >> 1; const bool even = (l & 1) == 0;
        switch (op) {
        case 0: { PHASE_ENV() const float* const* tab = (const float* const*)(ws + WS_TAB);
            convert_layer(FromTab{tab}, ws, l, lds, gw, NGW, wave, lane); } break;
        case 1: case 8: { PHASE_ENV() const int hf = (op == 8);
            pg8::Gemm g{HB, hf ? GU2 : GU1, M, 2 * DFF, 1024, 1024}; pg8::StaticOrder S; S.init(M, 2 * DFF, G, bx);
            pg8::EpiSwiglu E{BIG, pg8::build_rstd(lds + 131072, rowss + (size_t)((3 * l + 2 * hf) & 1) * M * 16, S)};
#ifdef DUP_GU
            for (int rp = 0; rp < 2; ++rp)
#endif
            pg8::gemm_phase<pg8::EpiSwiglu, pg8::StaticOrder, true, true, 1024, 1024>(lds, g, S, E); } break;
        case 2: case 9: { PHASE_ENV() const float* const* tab = (const float* const*)(ws + WS_TAB);
            pg8::Gemm g{BIG, (op == 2) ? D1 : D2, M, 1024, DFF, DFF}; pg8::StaticOrder S; S.init(M, 1024, G, bx);
            pg8::EpiResid E{HB, (unsigned*)(ws + WS_LO), rowss + (size_t)(((op == 2) ? 3 * l + 1 : 3 * l + 3) & 1) * M * 16, 0.5f};
#ifdef DUP_RESID
            for (int rp = 0; rp < 2; ++rp) { E.scale = rp ? 0.5f : 0.f;
#endif
            pg8::gemm_phase<pg8::EpiResid, pg8::StaticOrder, true, true, DFF, DFF>(lds, g, S, E);
#ifdef DUP_RESID
            }
#endif
            } break;
        case 3: { PHASE_ENV()
            if (even) { pg8::Gemm g{HB, MI, M, 4864, 1024, 1024}; pg8::StaticOrder S; S.init(M, 4864, G, bx);
                pg8::EpiProj E{BIG, dtb, pg8::build_rstd(lds + 131072, rowss + (size_t)((3 * l + 1) & 1) * M * 16, S)};
                pg8::gemm_phase<pg8::EpiProj, pg8::StaticOrder, true, true, 1024, 1024>(lds, g, S, E); }
            else { pg8::Gemm g{HB, MI, M, 3072, 1024, 1024}; pg8::StaticOrder S; S.init(M, 3072, G, bx);
                pg8::EpiQkv E{BIG, pg8::build_rstd(lds + 131072, rowss + (size_t)((3 * l + 1) & 1) * M * 16, S), rope, attn_body::C2};
                pg8::gemm_phase<pg8::EpiQkv, pg8::StaticOrder, true, true, 1024, 1024>(lds, g, S, E); } } break;
        case 4: { if (!even) continue;
            PHASE_ENV() const float* const* tab = (const float* const*)(ws + WS_TAB);
            bc_preconv_pass(BIG, tab[11] + (size_t)j * 4 * 1536, tab[12] + (size_t)j * 1536, gtid, NGT); } break;
        case 5: {
            if (even) { int G = gridDim.x, bx = blockIdx.x; asm volatile("" : "+s"(G), "+s"(bx)); const int vcu = (G % 8 == 0) ? (bx % 8) * (G / 8) + bx / 8 : bx;
                for (int u = vcu; u < 256; u += G) { const int b = u >> 4, h = u & 15; unsigned char* wsu = a.ws; asm volatile("" : "+s"(wsu));
#if defined(DUP_SSD) || defined(DUP_LRU)
                    for (int rp = 0; rp < 2; ++rp) { int dr = (rp == 0); asm volatile("" : "+s"(dr));
#ifndef DUP_LRU
                    ssd_unit(lds, b, h, j, wsu, dr != 0);
#else
                    if (!dr) ssd_unit(lds, b, h, j, wsu, false);
#endif
#ifndef DUP_SSD
                    lru_unit(lds, b, h, j, wsu, dr != 0);
#else
                    if (!dr) lru_unit(lds, b, h, j, wsu, false);
#endif
                    }
#else
                    ssd_unit(lds, b, h, j, wsu, dry);
                    lru_unit(lds, b, h, j, wsu, dry);
#endif
                } }
            else {
#ifndef NO_ATTN
                int G = gridDim.x, bx = blockIdx.x; asm volatile("" : "+s"(G), "+s"(bx)); const int vcu = (G % 8 == 0) ? (bx % 8) * (G / 8) + bx / 8 : bx;
                unsigned char* wsu = a.ws; asm volatile("" : "+s"(wsu)); bf16* BIG = (bf16*)(wsu + WS_BIG);
                const attn_body::AttnTensors AT{(const attn_body::bf16*)BIG, (const attn_body::bf16*)(BIG + (size_t)M * 1024), (const attn_body::bf16*)(BIG + (size_t)2 * M * 1024), (attn_body::bf16*)(BIG + (size_t)3 * M * 1024)};
                attn_body::attn_phase<8>((char*)lds_raw, AT, vcu, G);
#ifdef DUP_ATTN
                attn_body::attn_phase<8>((char*)lds_raw, AT, vcu, G);
#endif
#endif
            } } break;
        case 6: { PHASE_ENV() const float* const* tab = (const float* const*)(ws + WS_TAB);
            if (even) ssd_norm_pass(BIG, gssb, tab[16] + (size_t)j * 1024, gw, NGW, lane);
            else diff_combine_pass(BIG + (size_t)3 * M * 1024, tab[26] + j * 64, tab[27] + j * 64, tab[28] + j * 64, tab[29] + j * 64, tab[30] + j * 128, 0.8f - 0.6f * expf(-0.3f * (float)l), gw, NGW, lane); } break;
        default: { PHASE_ENV() const float* const* tab = (const float* const*)(ws + WS_TAB);
            pg8::StaticOrder S; S.init(M, 1024, G, bx);
            pg8::EpiResid E{HB, (unsigned*)(ws + WS_LO), rowss + (size_t)((3 * l + 2) & 1) * M * 16, 1.0f};
            if (even) { pg8::Gemm g{BIG, MO, M, 1024, 2048, PL}; pg8::gemm_phase<pg8::EpiResid, pg8::StaticOrder, true, true, 2048, PL>(lds, g, S, E); }
            else { pg8::Gemm g{BIG + (size_t)3 * M * 1024, MO, M, 1024, 1024, 2048}; pg8::gemm_phase<pg8::EpiResid, pg8::StaticOrder, true, true, 1024, 2048>(lds, g, S, E); } } break;
        }
        GSYNC();
#ifdef DUP_SYNC
        GSYNC(); GSYNC();
#endif
      }
    }
    { PHASE_ENV()
    const float* const* tab = (const float* const*)(ws + WS_TAB);
    final_norm_pass((float*)tab[33], HB, (const unsigned*)(ws + WS_LO), rowss, tab[32], gw, NGW, lane); }
}

extern "C" void kernel_launch(void* const* d_in, const int* in_sizes, int n_in, void* d_out, int out_size, void* d_ws, size_t ws_size, hipStream_t stream) {
    static int grid = 0;
    if (grid == 0) {
        if (n_in != 33 || out_size != M * 1024 || ws_size < WS_END) { fprintf(stderr, "kernel_launch: unexpected problem (n_in %d, out %d, ws %zu)\n", n_in, out_size, ws_size); grid = -1; return; }
        int dev = 0, cus = 0, per_cu = 0;
        if (hipGetDevice(&dev) != hipSuccess || hipDeviceGetAttribute(&cus, hipDeviceAttributeMultiprocessorCount, dev) != hipSuccess) { grid = -1; return; }
        if (hipFuncSetAttribute((const void*)mega_fwd, hipFuncAttributeMaxDynamicSharedMemorySize, LDS_BYTES) != hipSuccess) { fprintf(stderr, "kernel_launch: hipFuncSetAttribute failed\n"); grid = -1; return; }
        if (hipOccupancyMaxActiveBlocksPerMultiprocessor(&per_cu, (const void*)mega_fwd, NWAVES * 64, LDS_BYTES) != hipSuccess || per_cu < 1) { fprintf(stderr, "kernel_launch: occupancy query says %d\n", per_cu); per_cu = 1; }
        (void)hipGetLastError();
        grid = cus;
    }
    if (grid < 0) return;
    Args a{};
    for (int i = 0; i < 33; ++i) a.in[i] = (const float*)d_in[i];
    a.out = (float*)d_out; a.ws = (unsigned char*)d_ws;
    if (hipMemsetAsync((char*)d_ws + WS_CTL, 0, CTL_ZERO_BYTES, stream) != hipSuccess) { fprintf(stderr, "kernel_launch: memset failed\n"); return; }
    void* args[] = {&a};
    hipError_t e = hipLaunchCooperativeKernel((const void*)mega_fwd, dim3(grid), dim3(NWAVES * 64), args, LDS_BYTES, stream);
    if (e != hipSuccess) fprintf(stderr, "kernel_launch: cooperative launch failed: %s (grid %d)\n", hipGetErrorString(e), grid);
}
```

```cpp
#define RESID_LO 0
#include <hip/hip_runtime.h>
#include <hip/hip_cooperative_groups.h>
#include <hip/hip_bf16.h>
#include <cstdio>
#include <cstdint>
#include <cmath>
namespace cg = cooperative_groups;
namespace pg8 {
#define PG8_LAS __attribute__((address_space(3)))
typedef unsigned short bf16_t;
typedef short bf16x8 __attribute__((ext_vector_type(8)));
typedef float f32x4 __attribute__((ext_vector_type(4)));
typedef unsigned u32x4 __attribute__((ext_vector_type(4)));
constexpr int BM = 256, BK = 64, HALF = 128, HTB = HALF * BK * 2  , STAGE_BYTES = 8 * HTB, NXCD = 8, WGM = 8;

__host__ __device__ __forceinline__ int lds_byte(int r, int c) { const int st = (r >> 4) * 2 + (c >> 5), rr = r & 15, cc = c & 31, ob = rr * 64 + cc * 2; return st * 1024 + (ob ^ (((ob >> 9) & 1) << 5)); }
__host__ __device__ __forceinline__ void stage_rc(int b, int& R, int& C) { const int st = b / 1024, sb = b % 1024, swz = sb ^ (((sb >> 9) & 1) << 5); R = (st >> 1) * 16 + swz / 64; C = (st & 1) * 32 + (swz % 64) / 2; }
__host__ __device__ __forceinline__ int perm32(int rho) { const int n = rho >> 4, i = rho & 15; return 8 * (i >> 2) + 4 * n + (i & 3); }

struct Unit { int pm, pn; };
struct Gemm { const bf16_t* A; const bf16_t* Bt; int M, N, K, lda; };

struct StaticOrder {
    int nM, nN, nwg, G, c;
    __host__ __device__ void init(int M, int N, int G_, int c_) { nM = M / BM; nN = N / BM; nwg = nM * nN; G = G_; c = c_; }
    __host__ __device__ bool next(int i, Unit& u) const {
        const long L = (long)i * G + c; if (L >= nwg) return false;
        int wgid = (int)L; { const int q = nwg / NXCD, r = nwg % NXCD, xcd = wgid % NXCD, off = wgid / NXCD; wgid = (xcd < r ? xcd * (q + 1) : r * (q + 1) + (xcd - r) * q) + off; }
        const int nig = WGM * nN, gid = wgid / nig, fm = gid * WGM, gsz = (nM - fm) < WGM ? (nM - fm) : WGM;
        u.pm = fm + ((wgid % nig) % gsz); u.pn = (wgid % nig) / gsz; return true;
    }
    __device__ __forceinline__ void a_ready(const Unit&) const {}
    __device__ __forceinline__ void done(const Unit&) const {}
};

__device__ __forceinline__ unsigned cvt_pk_bf16(float lo, float hi) { unsigned r; asm volatile("v_cvt_pk_bf16_f32 %0, %1, %2" : "=v"(r) : "v"(lo), "v"(hi)); return r; }
typedef float f32x2 __attribute__((ext_vector_type(2)));
template <class Epi, class Sched, bool ALIGN_EPI = false, bool SP2 = false, int KC = 0, int LDAC = 0>
__device__ __forceinline__ void gemm_phase(PG8_LAS unsigned char* lds, const Gemm g, const Sched& S, const Epi& E) {
    int tid_ = threadIdx.x; asm volatile("" : "+v"(tid_));
    const int tid = tid_, wid = __builtin_amdgcn_readfirstlane(tid >> 6), lane = tid & 63, wr = wid >> 2, wc = wid & 3, fr = lane & 15, fq = lane >> 4;
    const int K = KC ? KC : g.K, nt = K / BK, LDA = LDAC ? LDAC : g.lda;
    unsigned voffA[2], voffB[2];
#pragma unroll
    for (int i = 0; i < 2; ++i) { int R, C; stage_rc(tid * 16 + i * 8192, R, C); const int Rb = Epi::PERM ? ((R & ~31) + perm32(R & 31)) : R;
        voffA[i] = (unsigned)(R * LDA + C) * 2u; voffB[i] = (unsigned)(Rb * K + C) * 2u; }
    const size_t kstep = (size_t)(BK * 2);
    const size_t hstep = (size_t)HALF * K * 2;
    const size_t tstep = 2 * hstep; const size_t hstepA = (size_t)HALF * LDA * 2, tstepA = 2 * hstepA;
    const unsigned ldsw = (unsigned)wid * 1024u;
    const int aoff = lds_byte(wr * 64 + fr, fq * 8), boff = lds_byte(wc * 32 + fr, fq * 8);
#define PG8_SA(b, h) (((b) * 2 + (h)) * HTB)
#define PG8_SB(b, h) ((4 + (b) * 2 + (h)) * HTB)
#define PG8_STAGE(bufoff, gbase, voff) do { _Pragma("unroll") for (int _i = 0; _i < 2; ++_i) \
        __builtin_amdgcn_global_load_lds((const unsigned*)((const char*)(gbase) + (voff)[_i]), (PG8_LAS unsigned*)(lds + (bufoff) + ldsw + _i * 8192), 16, 0, 0); } while (0)
#define PG8_LDA(dst, b, h) do { _Pragma("unroll") for (int m = 0; m < 4; ++m) _Pragma("unroll") for (int k = 0; k < 2; ++k) dst[m][k] = *(const PG8_LAS bf16x8*)(lds + PG8_SA(b, h) + aoff + m * 2048 + k * 1024); } while (0)
#define PG8_LDB(dst, b, h) do { _Pragma("unroll") for (int n = 0; n < 2; ++n) _Pragma("unroll") for (int k = 0; k < 2; ++k) dst[n][k] = *(const PG8_LAS bf16x8*)(lds + PG8_SB(b, h) + boff + n * 2048 + k * 1024); } while (0)
#define PG8_MMA(ai, bj, At, Bt) do { __builtin_amdgcn_s_setprio(1); _Pragma("unroll") for (int m = 0; m < 4; ++m) _Pragma("unroll") for (int n = 0; n < 2; ++n) _Pragma("unroll") for (int k = 0; k < 2; ++k) \
        acc[ai][bj][m][n] = __builtin_amdgcn_mfma_f32_16x16x32_bf16(Bt[n][k], At[m][k], acc[ai][bj][m][n], 0, 0, 0); __builtin_amdgcn_s_setprio(0); } while (0)
#define PG8_WAIT_V(n) asm volatile("s_waitcnt vmcnt(" #n ")" ::: "memory")
#define PG8_WAIT_L(n) asm volatile("s_waitcnt lgkmcnt(" #n ")" ::: "memory")
#define PG8_BAR __builtin_amdgcn_s_barrier()
#define PG8_SCHED __builtin_amdgcn_sched_barrier(0)
    Unit cur, nxt; int ui = 0;
    if (!S.next(0, cur)) return;
    f32x4 acc[2][2][4][2];
#pragma unroll
    for (int a = 0; a < 2; ++a)
#pragma unroll
        for (int b = 0; b < 2; ++b)
#pragma unroll
            for (int m = 0; m < 4; ++m)
#pragma unroll
                for (int n = 0; n < 2; ++n) acc[a][b][m][n] = (f32x4){0.f, 0.f, 0.f, 0.f};
    bf16x8 At[4][2], B0[2][2], B1[2][2];
    const char* cA = (const char*)g.A + (size_t)cur.pm * tstepA; const char* cB = (const char*)g.Bt + (size_t)cur.pn * tstep;
    S.a_ready(cur);
    if constexpr (SP2) {
        PG8_STAGE(PG8_SB(0, 0), cB, voffB); PG8_STAGE(PG8_SB(0, 1), cB + hstep, voffB); PG8_STAGE(PG8_SA(0, 0), cA, voffA); PG8_STAGE(PG8_SA(0, 1), cA + hstepA, voffA);
        if (wr == 1) PG8_BAR;
        PG8_WAIT_V(2); PG8_BAR;
        PG8_STAGE(PG8_SB(1, 0), cB + kstep, voffB); PG8_STAGE(PG8_SA(1, 0), cA + kstep, voffA); PG8_STAGE(PG8_SB(1, 1), cB + hstep + kstep, voffB);
        PG8_WAIT_V(6); PG8_BAR;
    } else {
        PG8_STAGE(PG8_SB(0, 0), cB, voffB); PG8_STAGE(PG8_SA(0, 0), cA, voffA); PG8_STAGE(PG8_SB(0, 1), cB + hstep, voffB); PG8_STAGE(PG8_SA(0, 1), cA + hstepA, voffA);
        if (wr == 1) PG8_BAR;
        PG8_WAIT_V(4); PG8_BAR;
        PG8_STAGE(PG8_SB(1, 0), cB + kstep, voffB); PG8_STAGE(PG8_SA(1, 0), cA + kstep, voffA); PG8_STAGE(PG8_SB(1, 1), cB + hstep + kstep, voffB);
        PG8_WAIT_V(6); PG8_BAR;
    }
    for (;;) {
        const bool has_next = S.next(ui + 1, nxt);
        const char* nA = has_next ? (const char*)g.A + (size_t)nxt.pm * tstepA : cA; const char* nB = has_next ? (const char*)g.Bt + (size_t)nxt.pn * tstep : cB;
        for (int t = 0; t < nt; t += 2) {
            const bool last = (t == nt - 2);
            const char* a1 = cA + (size_t)(t + 1) * kstep;
            const char* a2 = last ? nA : cA + (size_t)(t + 2) * kstep; const char* b2 = last ? nB : cB + (size_t)(t + 2) * kstep;
            const char* a3 = a2 + kstep; const char* b3 = b2 + kstep;
            if (last && has_next) S.a_ready(nxt);
            if constexpr (SP2) {
            PG8_LDB(B0, 0, 0); PG8_LDB(B1, 0, 1); PG8_SCHED; PG8_LDA(At, 0, 0); PG8_STAGE(PG8_SA(1, 1), a1 + hstepA, voffA);
            PG8_WAIT_V(8); PG8_WAIT_L(0); PG8_BAR; PG8_MMA(0, 0, At, B0); PG8_MMA(0, 1, At, B1); PG8_BAR; PG8_SCHED;
            PG8_LDA(At, 0, 1); PG8_STAGE(PG8_SB(0, 0), b2, voffB); PG8_STAGE(PG8_SB(0, 1), b2 + hstep, voffB); PG8_STAGE(PG8_SA(0, 0), a2, voffA);
            PG8_WAIT_V(8); PG8_WAIT_L(0); PG8_BAR; PG8_MMA(1, 0, At, B0); PG8_MMA(1, 1, At, B1); PG8_BAR; PG8_SCHED;
            PG8_LDB(B0, 1, 0); PG8_LDB(B1, 1, 1); PG8_SCHED; PG8_LDA(At, 1, 0); PG8_STAGE(PG8_SA(0, 1), a2 + hstepA, voffA);
            PG8_WAIT_V(8); PG8_WAIT_L(0); PG8_BAR; PG8_MMA(0, 0, At, B0); PG8_MMA(0, 1, At, B1); PG8_BAR; PG8_SCHED;
            PG8_LDA(At, 1, 1); PG8_STAGE(PG8_SB(1, 0), b3, voffB); PG8_STAGE(PG8_SB(1, 1), b3 + hstep, voffB); PG8_STAGE(PG8_SA(1, 0), a3, voffA);
            PG8_WAIT_V(8); PG8_WAIT_L(0); PG8_BAR; PG8_MMA(1, 0, At, B0); PG8_MMA(1, 1, At, B1); PG8_BAR; PG8_SCHED;
            } else {
            PG8_LDB(B0, 0, 0); PG8_SCHED; PG8_LDA(At, 0, 0); PG8_STAGE(PG8_SA(1, 1), a1 + hstepA, voffA);
            PG8_WAIT_L(8); PG8_BAR; PG8_WAIT_L(0); PG8_MMA(0, 0, At, B0); PG8_BAR; PG8_SCHED;
            PG8_LDB(B1, 0, 1); PG8_STAGE(PG8_SB(0, 0), b2, voffB);
            PG8_BAR; PG8_WAIT_L(0); PG8_MMA(0, 1, At, B1); PG8_BAR;
            PG8_LDA(At, 0, 1); PG8_STAGE(PG8_SA(0, 0), a2, voffA);
            PG8_BAR; PG8_WAIT_L(0); PG8_MMA(1, 0, At, B0); PG8_BAR; PG8_SCHED;
            PG8_STAGE(PG8_SB(0, 1), b2 + hstep, voffB);
            PG8_WAIT_V(6); PG8_BAR; PG8_MMA(1, 1, At, B1); PG8_BAR;
            PG8_LDB(B0, 1, 0); PG8_SCHED; PG8_LDA(At, 1, 0); PG8_STAGE(PG8_SA(0, 1), a2 + hstepA, voffA);
            PG8_WAIT_L(8); PG8_BAR; PG8_WAIT_L(0); PG8_MMA(0, 0, At, B0); PG8_BAR; PG8_SCHED;
            PG8_LDB(B1, 1, 1); PG8_STAGE(PG8_SB(1, 0), b3, voffB);
            PG8_BAR; PG8_WAIT_L(0); PG8_MMA(0, 1, At, B1); PG8_BAR;
            PG8_LDA(At, 1, 1); PG8_STAGE(PG8_SA(1, 0), a3, voffA);
            PG8_BAR; PG8_WAIT_L(0); PG8_MMA(1, 0, At, B0); PG8_BAR; PG8_SCHED;
            PG8_STAGE(PG8_SB(1, 1), b3 + hstep, voffB);
            PG8_WAIT_V(6); PG8_BAR; PG8_MMA(1, 1, At, B1); PG8_BAR;
            }
        }
        if constexpr (ALIGN_EPI) { if (wr == 0) PG8_BAR; }
        if constexpr (!Epi::AFTER_DRAIN) { E(acc, cur, wr, wc, fr, fq); S.done(cur); }
        if (!has_next) break;
#pragma unroll
        for (int a = 0; a < 2; ++a)
#pragma unroll
            for (int b = 0; b < 2; ++b)
#pragma unroll
                for (int m = 0; m < 4; ++m)
#pragma unroll
                    for (int n = 0; n < 2; ++n) acc[a][b][m][n] = (f32x4){0.f, 0.f, 0.f, 0.f};
        cur = nxt; cA = nA; cB = nB; ++ui;
        if constexpr (ALIGN_EPI) { if (wr == 1) PG8_BAR; }
    }
    PG8_WAIT_V(0);
    if constexpr (!ALIGN_EPI) { if (wr == 0) PG8_BAR; }
    PG8_BAR;
    if constexpr (Epi::AFTER_DRAIN) { E.fused(acc, cur, wr, wc, fr, fq, lds, wid, lane); S.done(cur); }
#undef PG8_SA
#undef PG8_SB
#undef PG8_STAGE
#undef PG8_LDA
#undef PG8_LDB
#undef PG8_MMA
#undef PG8_WAIT_V
#undef PG8_WAIT_L
#undef PG8_BAR
#undef PG8_SCHED
}
}
namespace pg8 {
constexpr float NORM_EPS = 1e-6f;
#define PG8_GAS __attribute__((address_space(1)))
typedef PG8_GAS f32x4 gf32x4; typedef PG8_GAS u32x4 gu32x4; typedef PG8_GAS float gfloat;
__device__ __forceinline__ float rstd_of(const float* rowss, int row) { const gf32x4* p = (const gf32x4*)(rowss + (size_t)row * 16); const f32x4 a = p[0], b = p[1], c = p[2], d = p[3];
    const float s = (((a[0] + a[1]) + (a[2] + a[3])) + ((b[0] + b[1]) + (b[2] + b[3]))) + (((c[0] + c[1]) + (c[2] + c[3])) + ((d[0] + d[1]) + (d[2] + d[3]))); return __builtin_amdgcn_rsqf(s * (1.0f / 1024.0f) + NORM_EPS); }
struct RstdTab {
    int p0, p1, p2, p3; const PG8_LAS float* tab; const float* rowss;
    __device__ __forceinline__ float get(int pm, int row) const {
        if (pm == p0) return tab[(row & 255)]; if (pm == p1) return tab[256 + (row & 255)]; if (pm == p2) return tab[512 + (row & 255)]; if (pm == p3) return tab[768 + (row & 255)];
        return rstd_of(rowss, row); }
};
template <class Sched> __device__ __forceinline__ RstdTab build_rstd(PG8_LAS unsigned char* lds_free, const float* rowss, const Sched& S) {
    RstdTab t; t.p0 = t.p1 = t.p2 = t.p3 = -1; t.tab = (const PG8_LAS float*)lds_free; t.rowss = rowss;
    Unit u;
    for (int i = 0; S.next(i, u); ++i) { const int pm = u.pm;
        if (pm != t.p0 && pm != t.p1 && pm != t.p2 && pm != t.p3) { if (t.p0 < 0) t.p0 = pm; else if (t.p1 < 0) t.p1 = pm; else if (t.p2 < 0) t.p2 = pm; else if (t.p3 < 0) t.p3 = pm; } }
    int tid_ = threadIdx.x; asm volatile("" : "+v"(tid_));
    for (int e = tid_; e < 1024; e += 512) { const int k = e >> 8, r = e & 255; const int pm = (k == 0) ? t.p0 : (k == 1) ? t.p1 : (k == 2) ? t.p2 : t.p3;
        if (pm >= 0) ((PG8_LAS float*)lds_free)[e] = rstd_of(rowss, pm * 256 + r); }
    asm volatile("s_waitcnt vmcnt(0) lgkmcnt(0)" ::: "memory"); __builtin_amdgcn_s_barrier(); asm volatile("" ::: "memory");
    return t;
}
__device__ __forceinline__ float silu_f(float x) { return x * __builtin_amdgcn_rcpf(1.0f + __expf(-x)); }
struct EpiSwiglu {
    static constexpr bool PERM = true, AFTER_DRAIN = false;
    bf16_t* O; RstdTab rt;
    __device__ __forceinline__ void operator()(const f32x4 (&acc)[2][2][4][2], const Unit& u, int wr, int wc, int fr, int fq) const {
        const int row0 = u.pm * BM + wr * 64 + fr, col0 = u.pn * 128 + wc * 32 + 8 * fq;
#pragma unroll
        for (int ai = 0; ai < 2; ++ai)
#pragma unroll
            for (int m = 0; m < 4; ++m) { const int row = row0 + ai * HALF + m * 16; const float rs = rt.get(u.pm, row);
                float o[8];
#pragma unroll
                for (int n = 0; n < 2; ++n)
#pragma unroll
                    for (int j = 0; j < 4; ++j) { const float g = acc[ai][0][m][n][j] * rs, up = acc[ai][1][m][n][j] * rs; o[n * 4 + j] = silu_f(g) * up; }
                u32x4 w; w.x = cvt_pk_bf16(o[0], o[1]); w.y = cvt_pk_bf16(o[2], o[3]); w.z = cvt_pk_bf16(o[4], o[5]); w.w = cvt_pk_bf16(o[6], o[7]);
                *(gu32x4*)(O + (size_t)row * 2816 + col0) = w; }
    }
};
#ifndef RESID_LO
#define RESID_LO 1
#endif
struct EpiResid {
    static constexpr bool PERM = true, AFTER_DRAIN = false;
    bf16_t* HB; unsigned* LO; float* rowss_next; float scale;
    static __device__ __forceinline__ float dec_lo(unsigned hw, unsigned nib) { return __uint_as_float(((hw << 16) | (nib << 12)) - (RESID_LO ? 0x7800u : 0u)); }
    static __device__ __forceinline__ float dec_hi(unsigned hw, unsigned nib) { return __uint_as_float(((hw & 0xffff0000u) | (nib << 12)) - (RESID_LO ? 0x7800u : 0u)); }
    static __device__ __forceinline__ unsigned enc(float h) { return __float_as_uint(h) + 0x8000u; }
    static __device__ __forceinline__ void dec8(const u32x4 hb, const unsigned lq, float (&f)[8]) {
        f[0] = dec_lo(hb.x, lq & 0xfu); f[1] = dec_hi(hb.x, (lq >> 4) & 0xfu); f[2] = dec_lo(hb.y, (lq >> 8) & 0xfu); f[3] = dec_hi(hb.y, (lq >> 12) & 0xfu);
        f[4] = dec_lo(hb.z, (lq >> 16) & 0xfu); f[5] = dec_hi(hb.z, (lq >> 20) & 0xfu); f[6] = dec_lo(hb.w, (lq >> 24) & 0xfu); f[7] = dec_hi(hb.w, lq >> 28);
    }
    static __device__ __forceinline__ unsigned nib8(const unsigned (&e)[8]) {
        return ((e[0] >> 12) & 0xfu) | ((e[1] >> 8) & 0xf0u) | ((e[2] >> 4) & 0xf00u) | (e[3] & 0xf000u) | ((e[4] << 4) & 0xf0000u) | ((e[5] << 8) & 0xf00000u) | ((e[6] << 12) & 0xf000000u) | ((e[7] << 16) & 0xf0000000u);
    }
    __device__ __forceinline__ void operator()(const f32x4 (&acc)[2][2][4][2], const Unit& u, int wr, int wc, int fr, int fq) const {
        const int row0 = u.pm * BM + wr * 64 + fr, col0 = u.pn * BM + wc * 32 + 8 * fq;
#pragma unroll
        for (int ai = 0; ai < 2; ++ai)
#pragma unroll
            for (int m = 0; m < 4; ++m) { const int row = row0 + ai * HALF + m * 16; bf16_t* bp = HB + (size_t)row * 1024 + col0; unsigned* lp = LO + (size_t)row * 128 + (col0 >> 3); float ss = 0.f;
#pragma unroll
                for (int bj = 0; bj < 2; ++bj) { const u32x4 old = *(const gu32x4*)(bp + bj * HALF);
#if RESID_LO
                    const unsigned lq = lp[bj * (HALF / 8)];
#else
                    const unsigned lq = 0u;
#endif
                    float h[8]; dec8(old, lq, h);
#pragma unroll
                    for (int j = 0; j < 4; ++j) { h[j] += acc[ai][bj][m][0][j] * scale; h[4 + j] += acc[ai][bj][m][1][j] * scale; }
#pragma unroll
                    for (int j = 0; j < 8; ++j) ss += h[j] * h[j];
#if RESID_LO
                    unsigned e[8];
#pragma unroll
                    for (int j = 0; j < 8; ++j) e[j] = enc(h[j]);
                    u32x4 w; w.x = (e[0] >> 16) | (e[1] & 0xffff0000u); w.y = (e[2] >> 16) | (e[3] & 0xffff0000u); w.z = (e[4] >> 16) | (e[5] & 0xffff0000u); w.w = (e[6] >> 16) | (e[7] & 0xffff0000u);
                    *(u32x4*)(bp + bj * HALF) = w;
                    lp[bj * (HALF / 8)] = nib8(e);
#else
                    u32x4 w; w.x = cvt_pk_bf16(h[0], h[1]); w.y = cvt_pk_bf16(h[2], h[3]); w.z = cvt_pk_bf16(h[4], h[5]); w.w = cvt_pk_bf16(h[6], h[7]);
                    *(gu32x4*)(bp + bj * HALF) = w;
#endif
                }
                ss += __shfl_xor(ss, 16); ss += __shfl_xor(ss, 32);
                if (fq == 0) ((gfloat*)rowss_next)[(size_t)row * 16 + u.pn * 4 + wc] = ss; }
    }
};
struct EpiProj {
    static constexpr bool PERM = true, AFTER_DRAIN = false;
    bf16_t* P; float* DT; RstdTab rt;
    __device__ __forceinline__ void operator()(const f32x4 (&acc)[2][2][4][2], const Unit& u, int wr, int wc, int fr, int fq) const {
        const int row0 = u.pm * BM + wr * 64 + fr, col0 = u.pn * BM + wc * 32 + 8 * fq;
#pragma unroll
        for (int ai = 0; ai < 2; ++ai)
#pragma unroll
            for (int m = 0; m < 4; ++m) { const int row = row0 + ai * HALF + m * 16; const float rs = rt.get(u.pm, row);
                if (u.pn < 18) {
#pragma unroll
                    for (int bj = 0; bj < 2; ++bj) { const f32x4 v0 = acc[ai][bj][m][0] * rs, v1 = acc[ai][bj][m][1] * rs;
                        u32x4 w; w.x = cvt_pk_bf16(v0[0], v0[1]); w.y = cvt_pk_bf16(v0[2], v0[3]); w.z = cvt_pk_bf16(v1[0], v1[1]); w.w = cvt_pk_bf16(v1[2], v1[3]);
                        *(gu32x4*)(P + (size_t)row * 4608 + col0 + bj * HALF) = w; }
                } else if (wc == 0 && fq < 2) {
                    *(gf32x4*)(DT + (size_t)row * 16 + 8 * fq) = acc[ai][0][m][0] * rs; *(gf32x4*)(DT + (size_t)row * 16 + 8 * fq + 4) = acc[ai][0][m][1] * rs; }
            }
    }
};
struct EpiQkv {
    static constexpr bool PERM = true, AFTER_DRAIN = false;
    bf16_t* QKV; RstdTab rt; const float* rope; float qscale;
    __device__ __forceinline__ void operator()(const f32x4 (&acc)[2][2][4][2], const Unit& u, int wr, int wc, int fr, int fq) const {
        const int sect = u.pn >> 2; bf16_t* base = QKV + (size_t)sect * ((size_t)32768 * 1024);
        const int row0 = u.pm * BM + wr * 64 + fr, col0 = (u.pn & 3) * BM + wc * 32 + 8 * fq;
        const float sc = sect == 0 ? qscale : 1.0f; const bool rot = (sect < 2), mine = ((wc & 1) == 0) && (fq < 2);
#pragma unroll
        for (int ai = 0; ai < 2; ++ai)
#pragma unroll
            for (int m = 0; m < 4; ++m) { const int row = row0 + ai * HALF + m * 16; const float rs = rt.get(u.pm, row);
                f32x4 c0 = {1.f, 1.f, 1.f, 1.f}, c1 = c0, s0 = {0.f, 0.f, 0.f, 0.f}, s1 = s0;
                if (rot && mine) { const float* rp = rope + (size_t)(row & 2047) * 16; c0 = *(const gf32x4*)rp; c1 = *(const gf32x4*)(rp + 4); s0 = *(const gf32x4*)(rp + 8); s1 = *(const gf32x4*)(rp + 12);
                    if (fq == 0) { s0 = -s0; s1 = -s1; } }
#pragma unroll
                for (int bj = 0; bj < 2; ++bj) { f32x4 v0 = acc[ai][bj][m][0] * rs, v1 = acc[ai][bj][m][1] * rs;
                    if (rot) { f32x4 p0, p1;
#pragma unroll
                        for (int j = 0; j < 4; ++j) { p0[j] = __shfl_xor(v0[j], 16); p1[j] = __shfl_xor(v1[j], 16); }
                        v0 = v0 * c0 + p0 * s0; v1 = v1 * c1 + p1 * s1; }
                    v0 = v0 * sc; v1 = v1 * sc;
                    u32x4 w; w.x = cvt_pk_bf16(v0[0], v0[1]); w.y = cvt_pk_bf16(v0[2], v0[3]); w.z = cvt_pk_bf16(v1[0], v1[1]); w.w = cvt_pk_bf16(v1[2], v1[3]);
                    *(gu32x4*)(base + (size_t)row * 1024 + col0 + bj * HALF) = w; }
            }
    }
};
}
#include <hip/hip_bf16.h>
#include <cmath>
namespace attn_body {
using bf16=__hip_bfloat16;
using bf16x8=__attribute__((ext_vector_type(8)))short;
using s16x4=__attribute__((ext_vector_type(4)))short;
using f32x16=__attribute__((ext_vector_type(16)))float;
using u32x4=__attribute__((ext_vector_type(4)))unsigned;
constexpr int BATCH=16,SEQ=2048,D=64,DM=1024,OP=2048;
constexpr int NW=8,QBLK=32,QB=QBLK*NW,KVBLK=64,NQB=SEQ/QB;
constexpr int ATTN_PITCH=DM, ATTN_UNIT_ROWS=QB;
__device__ __forceinline__ int crow(int r,int hi){return (r&3)+8*(r>>2)+4*hi;}
#define SBAR() __builtin_amdgcn_sched_barrier(0)
__device__ __forceinline__ void cmask(f32x16&p0,f32x16&p1,int jb,int qrel,int hi){
  const float NEG=-INFINITY; int kb=64*jb+4*hi;
  #pragma unroll
  for(int r=0;r<16;++r){int kv=kb+(r&3)+8*(r>>2); if(kv>qrel)p0[r]=NEG; if(kv+32>qrel)p1[r]=NEG;}
}

constexpr int NSLOT=3, SLOTB=8192;
constexpr int LDS_K=0, LDS_V=NSLOT*SLOTB, LDS_WS=2*NSLOT*SLOTB, LDS_OST=LDS_WS+NW*64*4, LDS_BYTES=LDS_OST+NW*4096;
constexpr float C2=0.125f*1.4426950408889634f;
__device__ __forceinline__ void glds16(const void*gsrc,unsigned lds_dst){unsigned keep;
  asm volatile("s_mov_b32 %0, m0\n\ts_mov_b32 m0, %2\n\ts_nop 0\n\tglobal_load_lds_dwordx4 %1, off\n\ts_mov_b32 m0, %0":"=&s"(keep):"v"(gsrc),"s"(lds_dst):"memory");}
__device__ __forceinline__ float max3f(float a,float b,float c){float r;asm("v_max3_f32 %0, %1, %2, %3":"=v"(r):"v"(a),"v"(b),"v"(c));return r;}
__device__ __forceinline__ float max2f(float a,float b){float r;asm("v_max_f32_e32 %0, %1, %2":"=v"(r):"v"(a),"v"(b));return r;}
__device__ __forceinline__ float fadd_s(float a,float b){float r;asm("v_add_f32_e32 %0, %1, %2":"=v"(r):"v"(a),"v"(b));return r;}
__device__ __forceinline__ float fsub_s(float a,float b){float r;asm("v_sub_f32_e32 %0, %1, %2":"=v"(r):"v"(a),"v"(b));return r;}
typedef float f32x2_t __attribute__((ext_vector_type(2))); typedef __bf16 bf16x2_t __attribute__((ext_vector_type(2)));
__device__ __forceinline__ unsigned cvtpk_s(float lo,float hi){f32x2_t v={lo,hi};bf16x2_t b=__builtin_convertvector(v,bf16x2_t);return __builtin_bit_cast(unsigned,b);}
#define WAIT_BAR(N) asm volatile("s_waitcnt vmcnt(" #N ") lgkmcnt(0)\n\ts_barrier":::"memory")

__device__ __forceinline__ void qkt(f32x16&p0,f32x16&p1,const char*Kslot,const bf16x8*qr,const f32x16&negm,int r32,int hi){
  const char*kb=Kslot+hi*1024+r32*16;
  #pragma unroll
  for(int d0=0;d0<4;++d0){
    const bf16x8 b0=*reinterpret_cast<const bf16x8*>(kb+d0*2048);
    const bf16x8 b1=*reinterpret_cast<const bf16x8*>(kb+d0*2048+512);
    if(d0==0){p0=__builtin_amdgcn_mfma_f32_32x32x16_bf16(b0,qr[0],negm,0,0,0);p1=__builtin_amdgcn_mfma_f32_32x32x16_bf16(b1,qr[0],negm,0,0,0);}
    else{p0=__builtin_amdgcn_mfma_f32_32x32x16_bf16(b0,qr[d0],p0,0,0,0);p1=__builtin_amdgcn_mfma_f32_32x32x16_bf16(b1,qr[d0],p1,0,0,0);}}
}
typedef __attribute__((address_space(3))) const char* lds_cptr;
typedef short v4i16_t __attribute__((ext_vector_type(4)));
__device__ __forceinline__ void kload8(bf16x8*kf,lds_cptr kp){
  kf[0]=*(const __attribute__((address_space(3))) bf16x8*)(kp);      kf[1]=*(const __attribute__((address_space(3))) bf16x8*)(kp+512);
  kf[2]=*(const __attribute__((address_space(3))) bf16x8*)(kp+2048); kf[3]=*(const __attribute__((address_space(3))) bf16x8*)(kp+2560);
  kf[4]=*(const __attribute__((address_space(3))) bf16x8*)(kp+4096); kf[5]=*(const __attribute__((address_space(3))) bf16x8*)(kp+4608);
  kf[6]=*(const __attribute__((address_space(3))) bf16x8*)(kp+6144); kf[7]=*(const __attribute__((address_space(3))) bf16x8*)(kp+6656);
}
__device__ __forceinline__ void kload2(bf16x8*kf,lds_cptr kp,int j){ kf[2*j]=*(const __attribute__((address_space(3))) bf16x8*)(kp+j*2048); kf[2*j+1]=*(const __attribute__((address_space(3))) bf16x8*)(kp+j*2048+512); }
__device__ __forceinline__ s16x4 vtr(lds_cptr p){ return __builtin_bit_cast(s16x4,__builtin_amdgcn_ds_read_tr16_b64_v4i16((__attribute__((address_space(3))) v4i16_t*)p)); }
__device__ __forceinline__ float rowmax(const f32x16&p0,const f32x16&p1){
  float a=max3f(p0[0],p0[1],p1[0]),b=max3f(p0[2],p0[3],p1[1]);a=max3f(a,p1[2],p1[3]);
  #pragma unroll
  for(int r=4;r<16;r+=4){a=max3f(a,p0[r],p0[r+1]);b=max3f(b,p0[r+2],p0[r+3]);a=max3f(a,p1[r],p1[r+1]);b=max3f(b,p1[r+2],p1[r+3]);}
  const float m=max2f(a,b);
  auto rr=__builtin_amdgcn_permlane32_swap(__float_as_uint(m),__float_as_uint(m),false,false);
  return max2f(__uint_as_float(rr[0]),__uint_as_float(rr[1]));
}
__device__ __forceinline__ void pv(f32x16*o,int vb,bf16x8 pa0,bf16x8 pa1,bf16x8 pa2,bf16x8 pa3){
  #pragma unroll
  for(int d0=0;d0<2;++d0){s16x4 lo[4],hi[4];
    #pragma unroll
    for(int ks=0;ks<4;++ks){
      asm volatile("ds_read_b64_tr_b16 %0,%1 offset:%c2":"=&v"(lo[ks]):"v"(vb),"i"(d0*4096+ks*1024):"memory");
      asm volatile("ds_read_b64_tr_b16 %0,%1 offset:%c2":"=&v"(hi[ks]):"v"(vb),"i"(d0*4096+ks*1024+512):"memory");}
    asm volatile("s_waitcnt lgkmcnt(0)":::"memory");SBAR();
    #define PK(k) (bf16x8){lo[k][0],lo[k][1],lo[k][2],lo[k][3],hi[k][0],hi[k][1],hi[k][2],hi[k][3]}
    o[d0]=__builtin_amdgcn_mfma_f32_32x32x16_bf16(pa0,PK(0),o[d0],0,0,0);
    o[d0]=__builtin_amdgcn_mfma_f32_32x32x16_bf16(pa1,PK(1),o[d0],0,0,0);
    o[d0]=__builtin_amdgcn_mfma_f32_32x32x16_bf16(pa2,PK(2),o[d0],0,0,0);
    o[d0]=__builtin_amdgcn_mfma_f32_32x32x16_bf16(pa3,PK(3),o[d0],0,0,0);
    #undef PK
  }
}

#ifndef ATTN_STORE16
#define ATTN_STORE16(p,v) (*(u32x4*)(p)=(v))
#endif
template<int THRL> __device__ __forceinline__ void attn_unit(int b,int qcol,int vcol,int ocol,int qb,const bf16*Q,const bf16*__restrict__ K,const bf16*__restrict__ V,bf16*O,char*shm){
  int tid_=threadIdx.x; asm volatile("":"+v"(tid_)); const int tid=tid_,lane=tid&63,r32=lane&31,hi=lane>>5; const int wid=__builtin_amdgcn_readfirstlane(tid>>6);
  const long rowbase=(long)b*SEQ; const int q0=qb*QB;
  const bf16*Qw=Q+(rowbase+q0+wid*QBLK)*DM+qcol;
  const bf16*Kh=K+rowbase*DM+qcol,*Vh=V+rowbase*DM+vcol;
  const unsigned lds0=(unsigned)(uintptr_t)shm;
  float*wsf=(float*)(shm+LDS_WS)+wid*64;
  const bf16*ksrc=Kh+(long)lane*DM+wid*8;
  const bf16*vsrc=Vh+(long)(16*(wid&3)+(lane>>2))*DM+(wid>>2)*32+(lane&3)*8;
  const unsigned kdst=lds0+LDS_K+wid*1024, vdst=lds0+LDS_V+wid*1024;
  #define DMA_K(t,slot) glds16(ksrc+(long)(t)*KVBLK*DM,(unsigned)__builtin_amdgcn_readfirstlane(kdst+(slot)))
  #define DMA_V(t,slot) glds16(vsrc+(long)(t)*KVBLK*DM,(unsigned)__builtin_amdgcn_readfirstlane(vdst+(slot)))
  const int vb0=(int)(lds0+LDS_V)+((lane>>4)&1)*32+(lane&3)*8+(4*hi+((lane&15)>>2))*64;
  const char*Kbase=shm+LDS_K; bf16x8 kf[8];
  const lds_cptr shm3=(lds_cptr)shm; const lds_cptr kp0=shm3+LDS_K+hi*1024+r32*16; const lds_cptr vp0=shm3+LDS_V+((lane>>4)&1)*32+(lane&3)*8+(4*hi+((lane&15)>>2))*64;
  const int NT=(q0+QB)/KVBLK;
  DMA_K(0,0);DMA_V(0,0);DMA_K(1,SLOTB);
  bf16x8 qr[4];
  #pragma unroll
  for(int d0=0;d0<4;++d0)qr[d0]=*reinterpret_cast<const bf16x8*>(&Qw[(long)r32*DM+d0*16+hi*8]);
  float mhat=0.f,l_reg=0.f;f32x16 o[2];o[0]=f32x16{};o[1]=f32x16{};f32x16 negm=f32x16{};asm volatile("":"+v"(negm));
  const int qrel=wid*QBLK+r32;
  #define CMASK(P0,P1,t) do{int jb_=(t)-(NT-4); if(jb_>=0)cmask(P0,P1,jb_,qrel,hi);}while(0)
  bool resc=false;
  #define START(P0,P1) do{ const float rm=rowmax(P0,P1); resc=false; \
    { const float dl=rm; mhat=fadd_s(mhat,dl); \
      _Pragma("unroll") for(int r=0;r<16;++r){P0[r]=fsub_s(P0[r],dl);P1[r]=fsub_s(P1[r],dl);} \
      _Pragma("unroll") for(int r=0;r<16;++r)negm[r]=-mhat; asm volatile("":"+v"(negm)); } \
    _Pragma("unroll") for(int r=0;r<16;++r)P0[r]=__builtin_amdgcn_exp2f(P0[r]); }while(0)
  #define RESC() do{ if(resc){ asm volatile("s_waitcnt lgkmcnt(0)":::"memory"); \
      _Pragma("unroll") for(int d_=0;d_<2;++d_) _Pragma("unroll") for(int r=0;r<16;++r)o[d_][r]*=wsf[crow(r,hi)]; } }while(0)
  f32x16 pA0,pA1,pB0,pB1;
  int sl_prev=0,sl_cur=0,sl_next=SLOTB;
  #define ROT() do{sl_prev=sl_cur;sl_cur=sl_next;sl_next=(sl_next==(NSLOT-1)*SLOTB)?0:sl_next+SLOTB;}while(0)
  DMA_K(2,2*SLOTB);
  WAIT_BAR(3);
  qkt(pA0,pA1,Kbase,qr,negm,r32,hi);asm volatile("s_nop 15\n\ts_nop 7":"+v"(pA0),"+v"(pA1));CMASK(pA0,pA1,0);
  START(pA0,pA1);
  _Pragma("unroll") for(int r=0;r<16;++r)pA1[r]=__builtin_amdgcn_exp2f(pA1[r]);
  WAIT_BAR(0);
  DMA_K(3,0);DMA_V(1,SLOTB);
  ROT();
  kload8(kf,kp0+sl_cur);
  WAIT_BAR(2);
  s16x4 vlo[8],vhi[8]; u32x4 pw0,pw1,pw2,pw3;
  #define PKW(P,B) cvtpk_s(P[B],P[B+1])
  #define PAF(k) __builtin_bit_cast(bf16x8,pw##k)
  #define VFR(i) (bf16x8){vlo[i][0],vlo[i][1],vlo[i][2],vlo[i][3],vhi[i][0],vhi[i][1],vhi[i][2],vhi[i][3]}
  #define PIN(x) asm volatile("":"+v"(x))
  #define MX3(a,b,c) __builtin_fmaxf(__builtin_fmaxf((a),(b)),(c))
  #define GAPA(MF,A0,A1,A2,A3,W0,W1,PW) do{ MF; sacc+=A0; sacc+=A1; sacc+=A2; sacc+=A3; PIN(sacc); W0; W1; PIN(PW); SBAR(); }while(0)
  #define EX(v) __builtin_amdgcn_exp2f(v)
  #define GAPB(MF,X,B) do{ MF; X[B]=EX(X[B]); X[B+1]=EX(X[B+1]); X[B+2]=EX(X[B+2]); X[B+3]=EX(X[B+3]); PIN(X); SBAR(); }while(0)
  #define VRD(i) do{ vlo[i]=vtr(vp_+(((i)>>2)*4096+((i)&3)*1024)); vhi[i]=vtr(vp_+(((i)>>2)*4096+((i)&3)*1024+512)); }while(0)
  #define KRD(G,j) do{ if(G){ kload2(kf,kp0+sl_next,j); SBAR(); } }while(0)
  #define STEP(C0,C1,P0,P1,t,GK,GV,GL) do{ SBAR(); \
    const lds_cptr vp_=vp0+sl_prev; \
    VRD(0); SBAR(); float sacc=(P0[0]+P0[1]); \
    GAPA(C0=__builtin_amdgcn_mfma_f32_32x32x16_bf16(kf[0],qr[0],negm,0,0,0), P0[2],P0[3],P0[4],P0[5],     pw0[0]=PKW(P0,0), pw0[1]=PKW(P0,2), pw0); \
    VRD(4); SBAR(); GAPA(C1=__builtin_amdgcn_mfma_f32_32x32x16_bf16(kf[1],qr[0],negm,0,0,0), P0[6],P0[7],P0[8],P0[9],     pw0[2]=PKW(P0,4), pw0[3]=PKW(P0,6), pw0); \
    VRD(1); SBAR(); GAPA(C0=__builtin_amdgcn_mfma_f32_32x32x16_bf16(kf[2],qr[1],C0,0,0,0),   P0[10],P0[11],P0[12],P0[13], pw1[0]=PKW(P0,8), pw1[1]=PKW(P0,10), pw1); \
    VRD(5); SBAR(); GAPA(C1=__builtin_amdgcn_mfma_f32_32x32x16_bf16(kf[3],qr[1],C1,0,0,0),   P0[14],P0[15],P1[0],P1[1],   pw1[2]=PKW(P0,12),pw1[3]=PKW(P0,14), pw1); \
    VRD(2); SBAR(); GAPA(C0=__builtin_amdgcn_mfma_f32_32x32x16_bf16(kf[4],qr[2],C0,0,0,0),   P1[2],P1[3],P1[4],P1[5],     pw2[0]=PKW(P1,0), pw2[1]=PKW(P1,2), pw2); \
    VRD(6); SBAR(); GAPA(C1=__builtin_amdgcn_mfma_f32_32x32x16_bf16(kf[5],qr[2],C1,0,0,0),   P1[6],P1[7],P1[8],P1[9],     pw2[2]=PKW(P1,4), pw2[3]=PKW(P1,6), pw2); \
    VRD(3); SBAR(); GAPA(C0=__builtin_amdgcn_mfma_f32_32x32x16_bf16(kf[6],qr[3],C0,0,0,0),   P1[10],P1[11],P1[12],P1[13], pw3[0]=PKW(P1,8), pw3[1]=PKW(P1,10), pw3); \
    VRD(7); SBAR(); GAPA(C1=__builtin_amdgcn_mfma_f32_32x32x16_bf16(kf[7],qr[3],C1,0,0,0),   P1[14],P1[15],0.f,0.f,       pw3[2]=PKW(P1,12),pw3[3]=PKW(P1,14), pw3); \
    l_reg+=sacc; \
    if(GK){DMA_K((t)+3,sl_cur);} if(GV){DMA_V((t)+1,sl_next);} \
    CMASK(C0,C1,t); \
    { float a=MX3(C0[0],C0[1],C1[0]),b=MX3(C0[2],C0[3],C1[1]); a=MX3(a,C1[2],C1[3]); \
      _Pragma("unroll") for(int r=4;r<16;r+=4){a=MX3(a,C0[r],C0[r+1]);b=MX3(b,C0[r+2],C0[r+3]);a=MX3(a,C1[r],C1[r+1]);b=MX3(b,C1[r+2],C1[r+3]);} \
      float rm=__builtin_fmaxf(a,b); { auto rr=__builtin_amdgcn_permlane32_swap(__float_as_uint(rm),__float_as_uint(rm),false,false); rm=__builtin_fmaxf(__uint_as_float(rr[0]),__uint_as_float(rr[1])); } \
      resc=false; \
      if(__builtin_expect(__any(rm>(float)THRL),0)){ const float dl=__builtin_fmaxf(rm,0.f); mhat+=dl; \
        _Pragma("unroll") for(int r=0;r<16;++r){C0[r]-=dl;C1[r]-=dl;} \
        _Pragma("unroll") for(int r=0;r<16;++r)negm[r]=-mhat; asm volatile("":"+v"(negm)); \
        const float f=__builtin_amdgcn_exp2f(-dl); l_reg*=f; if(hi==0)wsf[r32]=f; resc=true; } } \
    SBAR(); \
    GAPB(o[0]=__builtin_amdgcn_mfma_f32_32x32x16_bf16(PAF(0),VFR(0),o[0],0,0,0), C0,0); \
    GAPB(o[1]=__builtin_amdgcn_mfma_f32_32x32x16_bf16(PAF(0),VFR(4),o[1],0,0,0), C0,4); \
    KRD(GL,0); GAPB(o[0]=__builtin_amdgcn_mfma_f32_32x32x16_bf16(PAF(1),VFR(1),o[0],0,0,0), C0,8); \
    KRD(GL,1); GAPB(o[1]=__builtin_amdgcn_mfma_f32_32x32x16_bf16(PAF(1),VFR(5),o[1],0,0,0), C0,12); \
    KRD(GL,2); GAPB(o[0]=__builtin_amdgcn_mfma_f32_32x32x16_bf16(PAF(2),VFR(2),o[0],0,0,0), C1,0); \
    KRD(GL,3); GAPB(o[1]=__builtin_amdgcn_mfma_f32_32x32x16_bf16(PAF(2),VFR(6),o[1],0,0,0), C1,4); \
    GAPB(o[0]=__builtin_amdgcn_mfma_f32_32x32x16_bf16(PAF(3),VFR(3),o[0],0,0,0), C1,8); \
    GAPB(o[1]=__builtin_amdgcn_mfma_f32_32x32x16_bf16(PAF(3),VFR(7),o[1],0,0,0), C1,12); \
    }while(0)
  int t=1;
  #undef CMASK
  #define CMASK(P0,P1,t) do{}while(0)
  for(;t+5<NT;t+=2){
    STEP(pB0,pB1,pA0,pA1,t,true,true,true);     WAIT_BAR(2); RESC(); ROT();
    STEP(pA0,pA1,pB0,pB1,t+1,true,true,true);   WAIT_BAR(2); RESC(); ROT();
  }
  #undef CMASK
  #define CMASK(P0,P1,t) do{int jb_=(t)-(NT-4); if(jb_>=0)cmask(P0,P1,jb_,qrel,hi);}while(0)
  #define ENDW(tt) do{ if((tt)+3<NT){WAIT_BAR(2);} else if((tt)+2<NT){WAIT_BAR(1);} else {WAIT_BAR(0);} }while(0)
  for(;t+1<NT;t+=2){
    STEP(pB0,pB1,pA0,pA1,t,(t+3<NT),(t+1<NT),(t+1<NT));       ENDW(t);   RESC(); ROT();
    STEP(pA0,pA1,pB0,pB1,t+1,(t+4<NT),(t+2<NT),(t+2<NT));     ENDW(t+1); RESC(); ROT();
  }
  STEP(pB0,pB1,pA0,pA1,NT-1,false,false,false); RESC();
  { float sacc=pB0[0]+pB0[1]; _Pragma("unroll") for(int r=2;r<16;++r)sacc+=pB0[r]; _Pragma("unroll") for(int r=0;r<16;++r)sacc+=pB1[r]; l_reg+=sacc;
    pw0=(u32x4){PKW(pB0,0),PKW(pB0,2),PKW(pB0,4),PKW(pB0,6)};pw1=(u32x4){PKW(pB0,8),PKW(pB0,10),PKW(pB0,12),PKW(pB0,14)};pw2=(u32x4){PKW(pB1,0),PKW(pB1,2),PKW(pB1,4),PKW(pB1,6)};pw3=(u32x4){PKW(pB1,8),PKW(pB1,10),PKW(pB1,12),PKW(pB1,14)};
    SBAR(); pv(o,vb0+sl_cur,PAF(0),PAF(1),PAF(2),PAF(3)); }
  #undef PKW
  #undef PAF
  #undef VFR
  #undef PIN
  #undef MX3
  #undef GAPA
  #undef GAPB
  #undef EX
  #undef VRD
  #undef KRD
  #undef STEP
  #undef ENDW
  {auto rr=__builtin_amdgcn_permlane32_swap(__float_as_uint(l_reg),__float_as_uint(l_reg),false,false);l_reg=__uint_as_float(rr[0])+__uint_as_float(rr[1]);}
  if(hi==0)wsf[32+r32]=l_reg;asm volatile("s_waitcnt lgkmcnt(0)":::"memory");
  float rli[16];
  #pragma unroll
  for(int r=0;r<16;++r)rli[r]=__builtin_amdgcn_rcpf(wsf[32+crow(r,hi)]);
  bf16*Ow=O+(rowbase+q0+wid*QBLK)*OP+ocol;
  { bf16*stg=(bf16*)(shm+LDS_OST)+wid*2048;
    #pragma unroll
    for(int r=0;r<16;++r){const int orow=crow(r,hi);
      #pragma unroll
      for(int d0=0;d0<2;++d0)stg[orow*64+d0*32+r32]=__float2bfloat16(o[d0][r]*rli[r]);}
    asm volatile("s_waitcnt lgkmcnt(0)":::"memory");
    #pragma unroll
    for(int i=0;i<4;++i){const int row=i*8+(lane>>3),ch=lane&7; const u32x4 v=*(const u32x4*)(stg+row*64+ch*8); ATTN_STORE16(Ow+(long)row*OP+ch*8,v);} }
  asm volatile("s_waitcnt lgkmcnt(0)\n\ts_barrier":::"memory");
  #undef DMA_K
  #undef DMA_V
  #undef CMASK
  #undef START
  #undef RESC
  #undef ROT
}
constexpr int ATTN_LDS_BYTES=LDS_BYTES;
struct AttnTensors { const bf16* Q; const bf16* K; const bf16* V; bf16* O; };
struct AttnUnit { int b, qcol, vcol, ocol, qb; };
template<int THRL=8> __device__ __forceinline__ void attn_phase(char*lds,const AttnTensors&T,int vcu,int G){
  for(int su=vcu;su<256;su+=G){ const int b=su>>4,h=(su>>1)&7,c=su&1;
    for(int i=0;i<16;++i){ const int half=i>>3,qb=7-(i&7);
      attn_unit<THRL>(b,(h*2+c)*64,h*128+half*64,c*1024+h*128+half*64,qb,T.Q,T.K,T.V,T.O,lds); } }
}
#undef SBAR
#undef WAIT_BAR
}
constexpr int NWAVES = 8;
constexpr int BATCH = 16, SEQ = 2048, DM_ = 1024, M = BATCH * SEQ, DFF = 2816, DEPTH = 4;
constexpr int PL = 4608;
constexpr int OFF_Z = 0, OFF_GATE = 1024, OFF_XA = 2048, OFF_B = 3072, OFF_C = 3328, OFF_XB = 3584;
constexpr float EPS = 1e-6f;
constexpr size_t MiB = 1u << 20;
constexpr size_t WS_ROWSS = 1 * MiB;
constexpr size_t WS_GSS = 5 * MiB;
constexpr size_t WS_ROPE = 7 * MiB;
constexpr size_t WS_DT = 7 * MiB + 512 * 1024;
constexpr size_t WS_WB = 10 * MiB;
constexpr size_t WB_GU1 = 0, WB_D1 = 11 * MiB, WB_GU2 = WB_D1 + 5 * MiB + 512 * 1024, WB_D2 = WB_GU2 + 11 * MiB, WB_MI = WB_D2 + 5 * MiB + 512 * 1024, WB_MO = WB_MI + 9 * MiB + 512 * 1024;
static_assert(WB_MO + 4 * MiB <= 48 * MiB, "weights");
constexpr size_t WS_HB = 58 * MiB;
constexpr size_t WS_BIG = 122 * MiB;
constexpr size_t WS_LO = 442 * MiB;
constexpr size_t WS_END = 474 * MiB;
constexpr int LDS_BYTES = 163840;

#define GAS __attribute__((address_space(1)))
#define LAS __attribute__((address_space(3)))
typedef unsigned short bf16;
typedef unsigned v4u __attribute__((ext_vector_type(4)));
typedef unsigned v2u __attribute__((ext_vector_type(2)));
typedef float f32x4 __attribute__((ext_vector_type(4)));
typedef short bf16x8 __attribute__((ext_vector_type(8)));
#define LDS_WAIT() asm volatile("s_waitcnt lgkmcnt(0)" ::: "memory")
__device__ __forceinline__ unsigned pk2(float lo, float hi) { return pg8::cvt_pk_bf16(lo, hi); }
__device__ __forceinline__ float bflo(unsigned w) { return __uint_as_float(w << 16); }
__device__ __forceinline__ float bfhi(unsigned w) { return __uint_as_float(w & 0xffff0000u); }
__device__ __forceinline__ float bf1(bf16 v) { return __uint_as_float((unsigned)v << 16); }
__device__ __forceinline__ float wave_sum(float v) {
#pragma unroll
    for (int o = 1; o < 64; o <<= 1) v += __shfl_xor(v, o);
    return v;
}
__device__ __forceinline__ float silu_f(float x) { return x * __builtin_amdgcn_rcpf(1.0f + __expf(-x)); }
__device__ __forceinline__ float sigmoid_f(float x) { return __builtin_amdgcn_rcpf(1.0f + __expf(-x)); }

struct Args { const float* in[33]; float* out; unsigned char* ws; };
struct FromArgs { const Args& a; __device__ __forceinline__ const float* operator()(int i) const { return a.in[i]; } };
struct FromTab { const float* const* t; __device__ __forceinline__ const float* operator()(int i) const { return t[i]; } };
constexpr size_t WS_TAB = 512 * 1024;

__device__ __forceinline__ void cvt_item(const float* W, int K, int Nsrc, int c0, int ncols, bf16* WT, int drow0, int mode, const float* kscale, LAS float* scr, int item, int lane) {
    const int nblk = (ncols + 63) / 64, kb = item / nblk, nb = item % nblk, k0 = 64 * kb, n0 = 64 * nb;
    const int l16 = lane & 15, kr = lane >> 4; const bool cok = (n0 + 4 * l16) < ncols;
    const float* src = W + (size_t)(k0 + kr) * Nsrc + c0 + n0 + 4 * l16;
    f32x4 v[16];
#pragma unroll
    for (int i = 0; i < 16; ++i) v[i] = cok ? __builtin_nontemporal_load((const f32x4*)(src + (size_t)(4 * i) * Nsrc)) : (f32x4){0.f, 0.f, 0.f, 0.f};
    const int c = lane & 7;
    f32x4 ks0 = {1.f, 1.f, 1.f, 1.f}, ks1 = ks0;
    if (kscale) { ks0 = *(const f32x4*)(kscale + k0 + 8 * c); ks1 = *(const f32x4*)(kscale + k0 + 8 * c + 4); }
#pragma unroll
    for (int i = 0; i < 16; ++i) { LAS float* d = scr + (4 * i + kr) * 65 + 4 * l16; d[0] = v[i][0]; d[1] = v[i][1]; d[2] = v[i][2]; d[3] = v[i][3]; }
    LDS_WAIT(); asm volatile("" ::: "memory");
    const int dbase = (mode == 0) ? (drow0 + n0) : ((n0 >> 7) * 256 + (n0 & 127) + (mode == 2 ? 128 : 0));
#pragma unroll
    for (int jj = 0; jj < 8; ++jj) { const int n = (lane >> 3) + 8 * jj; const LAS float* sp = scr + (8 * c) * 65 + n;
        v4u o; o.x = pk2(sp[0 * 65] * ks0[0], sp[1 * 65] * ks0[1]); o.y = pk2(sp[2 * 65] * ks0[2], sp[3 * 65] * ks0[3]); o.z = pk2(sp[4 * 65] * ks1[0], sp[5 * 65] * ks1[1]); o.w = pk2(sp[6 * 65] * ks1[2], sp[7 * 65] * ks1[3]);
        if (n0 + n < ncols) *(v4u*)(WT + (size_t)(dbase + n) * K + k0 + 8 * c) = o; }
    LDS_WAIT(); asm volatile("" ::: "memory");
}
#define CVT_SEC(W, K, Nsrc, c0, ncols, WT, drow0, mode, ksc) { const int cnt_ = ((K) / 64) * (((ncols) + 63) / 64); if (r < cnt_) { cvt_item(W, K, Nsrc, c0, ncols, WT, drow0, mode, ksc, scr, r, lane); continue; } r -= cnt_; }
template <class PS> __device__ __forceinline__ void convert_layer(const PS& P, unsigned char* wsb, int l, LAS unsigned char* lds, int gw, int NGW, int wave, int lane) {
    LAS float* scr = (LAS float*)(lds + wave * 16896);
    unsigned char* wb = wsb + WS_WB; const int j = l >> 1;
    const size_t FW = (size_t)1024 * 2816;
    const float* g1 = P(2) + l * FW; const float* u1 = P(3) + l * FW; const float* d1 = P(4) + l * FW;
    const float* g2 = P(7) + l * FW; const float* u2 = P(8) + l * FW; const float* d2 = P(9) + l * FW;
    const float* n1 = P(1) + l * 1024; const float* nm = P(5) + l * 1024; const float* n2 = P(6) + l * 1024;
    const float* win = P(10) + (size_t)j * 1024 * 4624; const float* wout = P(24) + (size_t)j * 2048 * 1024;
    const float* wqkv = P(25) + (size_t)j * 1024 * 3072; const float* wo = P(31) + (size_t)j * 1024 * 1024;
    bf16* GU1 = (bf16*)(wb + WB_GU1); bf16* D1 = (bf16*)(wb + WB_D1); bf16* GU2 = (bf16*)(wb + WB_GU2); bf16* D2 = (bf16*)(wb + WB_D2); bf16* MI = (bf16*)(wb + WB_MI); bf16* MO = (bf16*)(wb + WB_MO);
    const bool even = (l & 1) == 0;
    for (int it = gw; ; it += NGW) {
        int r = it;
        CVT_SEC(g1, 1024, 2816, 0, 2816, GU1, 0, 1, n1)
        CVT_SEC(u1, 1024, 2816, 0, 2816, GU1, 0, 2, n1)
        CVT_SEC(d1, 2816, 1024, 0, 1024, D1, 0, 0, nullptr)
        CVT_SEC(g2, 1024, 2816, 0, 2816, GU2, 0, 1, n2)
        CVT_SEC(u2, 1024, 2816, 0, 2816, GU2, 0, 2, n2)
        CVT_SEC(d2, 2816, 1024, 0, 1024, D2, 0, 0, nullptr)
        if (even) {
            CVT_SEC(win, 1024, 4624, 0, 1024, MI, 0, 0, nm)
            CVT_SEC(win, 1024, 4624, 1024, 1536, MI, 2048, 0, nm)
            CVT_SEC(win, 1024, 4624, 2560, 16, MI, 4608, 0, nm)
            CVT_SEC(win, 1024, 4624, 2576, 1024, MI, 1024, 0, nm)
            CVT_SEC(win, 1024, 4624, 3600, 1024, MI, 3584, 0, nm)
            CVT_SEC(wout, 2048, 1024, 0, 1024, MO, 0, 0, nullptr)
        } else {
            CVT_SEC(wqkv, 1024, 3072, 0, 3072, MI, 0, 0, nm)
            CVT_SEC(wo, 1024, 1024, 0, 1024, MO, 0, 0, nullptr)
        }
        break;
    }
}
__device__ __forceinline__ void prologue(const Args& a, LAS unsigned char* lds, int gw, int NGW, int wave, int lane, int gtid, int NGT) {
    float* rowss = (float*)(a.ws + WS_ROWSS); bf16* HB = (bf16*)(a.ws + WS_HB);
    for (int m = gw; m < M; m += NGW) {
        const f32x4* xr = (const f32x4*)(a.in[0] + (size_t)m * 1024) + lane; v2u* hb = (v2u*)(HB + (size_t)m * 1024) + lane;
        float s = 0.f;
#pragma unroll
        for (int j = 0; j < 4; ++j) { const f32x4 v = __builtin_nontemporal_load(xr + 64 * j); s += (v.x * v.x + v.y * v.y) + (v.z * v.z + v.w * v.w);
#if RESID_LO
            const unsigned e0 = pg8::EpiResid::enc(v.x), e1 = pg8::EpiResid::enc(v.y), e2 = pg8::EpiResid::enc(v.z), e3 = pg8::EpiResid::enc(v.w);
            v2u w; w.x = (e0 >> 16) | (e1 & 0xffff0000u); w.y = (e2 >> 16) | (e3 & 0xffff0000u); hb[64 * j] = w;
            const unsigned n4 = ((e0 >> 12) & 0xfu) | ((e1 >> 8) & 0xf0u) | ((e2 >> 4) & 0xf00u) | (e3 & 0xf000u);
            const unsigned nn = __shfl_xor(n4, 1);
            if ((lane & 1) == 0) ((unsigned*)(a.ws + WS_LO))[(size_t)m * 128 + ((lane + 64 * j) >> 1)] = n4 | (nn << 16);
#else
            v2u w; w.x = pk2(v.x, v.y); w.y = pk2(v.z, v.w); hb[64 * j] = w;
#endif
        }
        s = wave_sum(s); if (lane < 16) rowss[(size_t)m * 16 + lane] = (lane == 0) ? s : 0.f;
    }
    { float* rope = (float*)(a.ws + WS_ROPE);
      for (int i = gtid; i < 2048 * 8; i += NGT) { const int t = i >> 3, k = i & 7; const float inv = exp2f(-(float)k * (18.931568569324174f / 8.0f)); const float ang = (float)t * inv;
          float rev = ang * 0.15915494309189535f; rev -= floorf(rev); rope[t * 16 + k] = __builtin_amdgcn_cosf(rev); rope[t * 16 + 8 + k] = __builtin_amdgcn_sinf(rev); } }
    if (threadIdx.x == 0) { const float** tab = (const float**)(a.ws + WS_TAB);
#pragma unroll
        for (int i = 0; i < 33; ++i) tab[i] = a.in[i];
        tab[33] = a.out; }
    convert_layer(FromArgs{a}, a.ws, 0, lds, gw, NGW, wave, lane);
}

#define WG_BAR() do { asm volatile("s_waitcnt lgkmcnt(0)" ::: "memory"); __builtin_amdgcn_s_barrier(); asm volatile("" ::: "memory"); } while (0)
#define MFMA16(a, b, c) __builtin_amdgcn_mfma_f32_16x16x32_bf16(a, b, c, 0, 0, 0)
#define LDF(off) (*(const LAS bf16x8*)(lds + (off)))
constexpr int P2 = 272;
constexpr int L_C = 0, L_B = 34816, L_BWT = 69632, L_XT = 104448, L_S = 121856, L_CSALL = 139264  , L_DTALL = 147456  ;
__device__ __forceinline__ void unpack8(const v4u r, float (&f)[8]) { f[0] = bflo(r.x); f[1] = bfhi(r.x); f[2] = bflo(r.y); f[3] = bfhi(r.y); f[4] = bflo(r.z); f[5] = bfhi(r.z); f[6] = bflo(r.w); f[7] = bfhi(r.w); }

constexpr size_t BC2_OFF = (size_t)M * PL;
__device__ __forceinline__ void bc_preconv_pass(bf16* BIG, const float* cw, const float* cb, int gtid, int NGT) {
    const int cg = gtid & 63, ch = 1024 + cg * 8;
    float w[4][8], bias[8];
#pragma unroll
    for (int k = 0; k < 4; ++k) { const f32x4 wa = *(const f32x4*)(cw + k * 1536 + ch), wb = *(const f32x4*)(cw + k * 1536 + ch + 4);
        w[k][0] = wa.x; w[k][1] = wa.y; w[k][2] = wa.z; w[k][3] = wa.w; w[k][4] = wb.x; w[k][5] = wb.y; w[k][6] = wb.z; w[k][7] = wb.w; }
    { const f32x4 ba = *(const f32x4*)(cb + ch), bb = *(const f32x4*)(cb + ch + 4); bias[0] = ba.x; bias[1] = ba.y; bias[2] = ba.z; bias[3] = ba.w; bias[4] = bb.x; bias[5] = bb.y; bias[6] = bb.z; bias[7] = bb.w; }
    if ((NGT & 63) != 0) return;
    for (int it = gtid; it < 64 * 4096; it += NGT) { const int strip = it >> 6; const int r0 = strip * 8, tb = r0 & (SEQ - 1);
        v4u raw[11];
#pragma unroll
        for (int s = 0; s < 11; ++s) { const bool ok = (tb + s - 3 >= 0); const v4u t_ = __builtin_nontemporal_load((const GAS v4u*)(BIG + (size_t)(ok ? r0 + s - 3 : r0) * PL + OFF_B + cg * 8)); const unsigned mk = ok ? 0xffffffffu : 0u; raw[s] = (v4u){t_.x & mk, t_.y & mk, t_.z & mk, t_.w & mk}; }
#pragma unroll
        for (int s = 0; s < 8; ++s) { float val[8];
#pragma unroll
            for (int c = 0; c < 8; ++c) val[c] = bias[c];
#pragma unroll
            for (int k = 0; k < 4; ++k) { float f[8]; unpack8(raw[s + k], f);
#pragma unroll
                for (int c = 0; c < 8; ++c) val[c] += w[k][c] * f[c]; }
#pragma unroll
            for (int c = 0; c < 8; ++c) val[c] = silu_f(val[c]);
            v4u o; o.x = pk2(val[0], val[1]); o.y = pk2(val[2], val[3]); o.z = pk2(val[4], val[5]); o.w = pk2(val[6], val[7]);
            *(GAS v4u*)(BIG + BC2_OFF + (size_t)(r0 + s) * 512 + cg * 8) = o; }
    }
}
__device__ __forceinline__ void ssd_unit(LAS unsigned char* lds, int b, int h, int j, unsigned char* ws, const bool DRY) {
    int tid_ = threadIdx.x; asm volatile("" : "+v"(tid_));
    const int tid = tid_, wid = __builtin_amdgcn_readfirstlane(tid >> 6), lane = tid & 63, fr = lane & 15, fq = lane >> 4;
    const int g = h >> 3;
    { unsigned zz = 0u; asm volatile("" : "+v"(zz)); for (int i = tid; i < 17408 / 16; i += 512) *(LAS v4u*)(lds + L_S + i * 16) = (v4u){zz, zz, zz, zz}; }
    f32x4 S[4];
#pragma unroll
    for (int i = 0; i < 4; ++i) S[i] = (f32x4){0.f, 0.f, 0.f, 0.f};
    const int p0 = (wid & 3) * 16, n0 = (wid >> 2) * 64;
    const int xcg8 = tid & 7, xts = tid >> 3;
    float dt_bias, a_h, d_h; { const float* const* tab0 = (const float* const*)(ws + WS_TAB); dt_bias = tab0[13][j * 16 + h]; a_h = -__expf(tab0[14][j * 16 + h]); d_h = tab0[15][j * 16 + h]; }
    float xw[4][8], xbias[8];
    { const float* const* tab0 = (const float* const*)(ws + WS_TAB); const float* cw = tab0[11] + (size_t)j * 4 * 1536; const float* cb = tab0[12] + (size_t)j * 1536; const int ch = h * 64 + xcg8 * 8;
#pragma unroll
      for (int k = 0; k < 4; ++k) { const f32x4 wa = *(const f32x4*)(cw + k * 1536 + ch), wb = *(const f32x4*)(cw + k * 1536 + ch + 4);
          xw[k][0] = wa.x; xw[k][1] = wa.y; xw[k][2] = wa.z; xw[k][3] = wa.w; xw[k][4] = wb.x; xw[k][5] = wb.y; xw[k][6] = wb.z; xw[k][7] = wb.w; }
      const f32x4 ba = *(const f32x4*)(cb + ch), bb = *(const f32x4*)(cb + ch + 4); xbias[0] = ba.x; xbias[1] = ba.y; xbias[2] = ba.z; xbias[3] = ba.w; xbias[4] = bb.x; xbias[5] = bb.y; xbias[6] = bb.z; xbias[7] = bb.w; }
    {
        const GAS float* dtp = (const GAS float*)(ws + WS_DT) + ((size_t)b * SEQ + 4 * tid) * 16 + h;
        float d[4], p[4];
#pragma unroll
        for (int i = 0; i < 4; ++i) { const float x = dtp[i * 16] + dt_bias; d[i] = x > 20.f ? x : log1pf(__expf(x)); }
        p[0] = d[0] * a_h; p[1] = p[0] + d[1] * a_h; p[2] = p[1] + d[2] * a_h; p[3] = p[2] + d[3] * a_h;
        float sc = p[3];
#pragma unroll
        for (int o = 1; o < 32; o <<= 1) { const float v = __shfl_up(sc, o); if ((lane & 31) >= o) sc += v; }
        const float ex = sc - p[3];
        *(LAS f32x4*)(lds + L_CSALL + tid * 16) = (f32x4){ex + p[0], ex + p[1], ex + p[2], ex + p[3]}; *(LAS f32x4*)(lds + L_DTALL + tid * 16) = (f32x4){d[0], d[1], d[2], d[3]};
    }
    WG_BAR();
    for (int chunk = 0; chunk < 16; ++chunk) {
        const int t0 = chunk * 128; const size_t row0 = (size_t)b * SEQ + t0;
        unsigned char* wsl = ws; asm volatile("" : "+s"(wsl));
        bf16* proj = (bf16*)(wsl + WS_BIG); const float* const* tab = (const float* const*)(wsl + WS_TAB);
        const LAS float* csA = (const LAS float*)(lds + L_CSALL) + t0; const LAS float* dtA = (const LAS float*)(lds + L_DTALL) + t0;
        {
            int tl = tid; asm volatile("" : "+v"(tl)); const int cgp = tl & 31, ts = tl >> 5; const bool isB = cgp < 16;
            const bf16* src = proj + BC2_OFF + (row0 + 8 * ts) * 512 + (isB ? 0 : 256) + g * 128 + (cgp & 15) * 8;
            v4u raw[8];
#pragma unroll
            for (int s = 0; s < 8; ++s) raw[s] = *(const GAS v4u*)(src + (size_t)s * 512);
#pragma unroll
            for (int s = 0; s < 8; ++s) *(LAS v4u*)(lds + (isB ? L_B : L_C) + (8 * ts + s) * P2 + (cgp & 15) * 16) = raw[s];
            if (isB) {
                float val[8][8], wj[8];
#pragma unroll
                for (int s = 0; s < 8; ++s) { unpack8(raw[s], val[s]); wj[s] = dtA[8 * ts + s] * __expf(csA[127] - csA[8 * ts + s]); }
#pragma unroll
                for (int c = 0; c < 8; ++c) { v4u o; o.x = pk2(val[0][c] * wj[0], val[1][c] * wj[1]); o.y = pk2(val[2][c] * wj[2], val[3][c] * wj[3]); o.z = pk2(val[4][c] * wj[4], val[5][c] * wj[5]); o.w = pk2(val[6][c] * wj[6], val[7][c] * wj[7]);
                    *(LAS v4u*)(lds + L_BWT + ((cgp & 15) * 8 + c) * P2 + (8 * ts) * 2) = o; }
            }
        }
        {
            const int cg8 = xcg8, ts = xts, col = OFF_XA + h * 64 + cg8 * 8;
            v4u raw[5];
#pragma unroll
            for (int s = 0; s < 5; ++s) { const int t = t0 + 2 * ts + s - 3; const v4u t_ = *(const GAS v4u*)(proj + ((size_t)b * SEQ + (t >= 0 ? t : 0)) * PL + col); const unsigned mk = (t >= 0) ? 0xffffffffu : 0u; raw[s] = (v4u){t_.x & mk, t_.y & mk, t_.z & mk, t_.w & mk}; }
            float val[2][8];
#pragma unroll
            for (int s = 0; s < 2; ++s) {
#pragma unroll
                for (int c = 0; c < 8; ++c) val[s][c] = xbias[c];
#pragma unroll
                for (int k = 0; k < 4; ++k) { float f[8]; unpack8(raw[s + k], f);
#pragma unroll
                    for (int c = 0; c < 8; ++c) val[s][c] += xw[k][c] * f[c]; }
#pragma unroll
                for (int c = 0; c < 8; ++c) val[s][c] = silu_f(val[s][c]);
            }
#pragma unroll
            for (int c = 0; c < 8; ++c) *(LAS unsigned*)(lds + L_XT + (cg8 * 8 + c) * P2 + (2 * ts) * 2) = pk2(val[0][c], val[1][c]);
        }
        WG_BAR();
        const int irow = 16 * wid + fr;
        v2u zr[4];
#pragma unroll
        for (int pt = 0; pt < 4; ++pt) zr[pt] = *(const GAS v2u*)(proj + (row0 + irow) * PL + OFF_Z + h * 64 + 16 * pt + 4 * fq);
        f32x4 cbv[8], yo[4];
#pragma unroll
        for (int i = 0; i < 8; ++i) cbv[i] = (f32x4){0.f, 0.f, 0.f, 0.f};
#pragma unroll
        for (int i = 0; i < 4; ++i) yo[i] = (f32x4){0.f, 0.f, 0.f, 0.f};
        { const float cd = __expf(csA[127]);
#pragma unroll
          for (int i = 0; i < 4; ++i) S[i] = S[i] * cd; }
#pragma unroll
        for (int kk = 0; kk < 4; ++kk) {
            const bf16x8 cf = LDF(L_C + irow * P2 + kk * 64 + fq * 16);
#pragma unroll
            for (int jt = 0; jt < 8; ++jt) cbv[jt] = MFMA16(LDF(L_B + (16 * jt + fr) * P2 + kk * 64 + fq * 16), cf, cbv[jt]);
#pragma unroll
            for (int pt = 0; pt < 4; ++pt) yo[pt] = MFMA16(LDF(L_S + (16 * pt + fr) * P2 + kk * 64 + fq * 16), cf, yo[pt]);
            const bf16x8 xf = LDF(L_XT + (p0 + fr) * P2 + kk * 64 + fq * 16);
#pragma unroll
            for (int nt = 0; nt < 4; ++nt) S[nt] = MFMA16(LDF(L_BWT + (n0 + 16 * nt + fr) * P2 + kk * 64 + fq * 16), xf, S[nt]);
        }
        WG_BAR();
        const float csi = csA[irow];
#pragma unroll
        for (int jt = 0; jt < 8; ++jt) { const int j0 = 16 * jt + 4 * fq; const f32x4 csj = *(const LAS f32x4*)(csA + j0), dtj = *(const LAS f32x4*)(dtA + j0); float gv[4];
#pragma unroll
            for (int r = 0; r < 4; ++r) gv[r] = (j0 + r <= irow) ? cbv[jt][r] * __expf(csi - csj[r]) * dtj[r] : 0.f;
            v2u o; o.x = pk2(gv[0], gv[1]); o.y = pk2(gv[2], gv[3]); *(LAS v2u*)(lds + L_B + irow * P2 + j0 * 2) = o; }
#pragma unroll
        for (int nt = 0; nt < 4; ++nt) { v2u o; o.x = pk2(S[nt][0], S[nt][1]); o.y = pk2(S[nt][2], S[nt][3]); *(LAS v2u*)(lds + L_S + (p0 + fr) * P2 + (n0 + 16 * nt + 4 * fq) * 2) = o; }
        WG_BAR();
        { const float ei = __expf(csi); f32x4 y[4]; float* gss = (float*)(wsl + WS_GSS);
#pragma unroll
          for (int pt = 0; pt < 4; ++pt) y[pt] = yo[pt] * ei;
#pragma unroll
          for (int kk = 0; kk < 4; ++kk) { const bf16x8 gf = LDF(L_B + irow * P2 + kk * 64 + fq * 16);
#pragma unroll
              for (int pt = 0; pt < 4; ++pt) y[pt] = MFMA16(LDF(L_XT + (16 * pt + fr) * P2 + kk * 64 + fq * 16), gf, y[pt]); }
          float ss = 0.f;
#pragma unroll
          for (int pt = 0; pt < 4; ++pt) { float o[4]; const float zf[4] = {bflo(zr[pt].x), bfhi(zr[pt].x), bflo(zr[pt].y), bfhi(zr[pt].y)};
#pragma unroll
              for (int r = 0; r < 4; ++r) { const int p = 16 * pt + 4 * fq + r; const float xv = bf1(*(const LAS bf16*)(lds + L_XT + p * P2 + irow * 2));
                  const float yv = (y[pt][r] + d_h * xv) * silu_f(zf[r]); o[r] = yv; ss += yv * yv; }
              v2u w; w.x = pk2(o[0], o[1]); w.y = pk2(o[2], o[3]); if (!DRY) *(GAS v2u*)(proj + (row0 + irow) * PL + OFF_Z + h * 64 + 16 * pt + 4 * fq) = w; }
          ss += __shfl_xor(ss, 16); ss += __shfl_xor(ss, 32);
          if (fq == 0 && !DRY) ((GAS float*)gss)[(row0 + irow) * 16 + h] = ss; }
        WG_BAR();
    }
}
constexpr int P1 = 144;
constexpr int L_WRA = 0, L_WIX = 9216, L_XBM = 18432, L_AS = 36864, L_US = 71680, L_SEGA = 106496, L_SEGH = 108544, L_CARRY = 110592;
__device__ __forceinline__ void lru_unit(LAS unsigned char* lds, int b, int blk, int j, unsigned char* ws, const bool DRY) {
    int tid_ = threadIdx.x; asm volatile("" : "+v"(tid_));
    const int tid = tid_, wid = __builtin_amdgcn_readfirstlane(tid >> 6), lane = tid & 63, fr = lane & 15, fq = lane >> 4;
    const int cbase = blk * 64;
    const float* const* tab = (const float* const*)(ws + WS_TAB);
    const float* cw = tab[17] + (size_t)j * 4 * 1024; const float* cb = tab[18] + (size_t)j * 1024; const float* wra = tab[19] + ((size_t)j * 16 + blk) * 4096; const float* wix = tab[21] + ((size_t)j * 16 + blk) * 4096;
    const float* bra = tab[20] + (size_t)j * 1024; const float* bix = tab[22] + (size_t)j * 1024; const float* lam = tab[23] + (size_t)j * 1024;
    for (int q = 0; q < 8; ++q) { const int e = tid + 512 * q, i = e >> 6, j = e & 63;
        *(LAS bf16*)(lds + L_WRA + j * P1 + i * 2) = (bf16)(pk2(wra[e], 0.f) & 0xffffu); *(LAS bf16*)(lds + L_WIX + j * P1 + i * 2) = (bf16)(pk2(wix[e], 0.f) & 0xffffu); }
    if (tid < 128) ((LAS float*)(lds + L_CARRY))[tid] = 0.f;
    f32x4 braV[4], bixV[4], spV[4];
#pragma unroll
    for (int jt = 0; jt < 4; ++jt) { const int j0 = cbase + 16 * jt + 4 * fq; braV[jt] = *(const f32x4*)(bra + j0); bixV[jt] = *(const f32x4*)(bix + j0); const f32x4 lv = *(const f32x4*)(lam + j0);
#pragma unroll
        for (int r = 0; r < 4; ++r) { const float x = -lv[r]; spV[jt][r] = -8.0f * (x > 20.f ? x : log1pf(__expf(x))); } }
    const int cg8 = tid & 7, ts = tid >> 3, cch = cbase + cg8 * 8;
    float w[4][8], bias[8];
#pragma unroll
    for (int k = 0; k < 4; ++k) { const f32x4 wa = *(const f32x4*)(cw + k * 1024 + cch), wb = *(const f32x4*)(cw + k * 1024 + cch + 4);
        w[k][0] = wa.x; w[k][1] = wa.y; w[k][2] = wa.z; w[k][3] = wa.w; w[k][4] = wb.x; w[k][5] = wb.y; w[k][6] = wb.z; w[k][7] = wb.w; }
    { const f32x4 ba = *(const f32x4*)(cb + cch), bb = *(const f32x4*)(cb + cch + 4); bias[0] = ba.x; bias[1] = ba.y; bias[2] = ba.z; bias[3] = ba.w; bias[4] = bb.x; bias[5] = bb.y; bias[6] = bb.z; bias[7] = bb.w; }
    WG_BAR();
    for (int tile = 0; tile < 16; ++tile) {
        const int t0 = tile * 128; const size_t row0 = (size_t)b * SEQ + t0;
        unsigned char* wsl = ws; asm volatile("" : "+s"(wsl)); bf16* proj = (bf16*)(wsl + WS_BIG);
        {
            v4u raw[5];
#pragma unroll
            for (int s = 0; s < 5; ++s) { const int t = t0 + 2 * ts + s - 3; const v4u t_ = *(const GAS v4u*)(proj + ((size_t)b * SEQ + (t >= 0 ? t : 0)) * PL + OFF_XB + cch); const unsigned mk = (t >= 0) ? 0xffffffffu : 0u; raw[s] = (v4u){t_.x & mk, t_.y & mk, t_.z & mk, t_.w & mk}; }
#pragma unroll
            for (int s = 0; s < 2; ++s) { float val[8];
#pragma unroll
                for (int c = 0; c < 8; ++c) val[c] = bias[c];
#pragma unroll
                for (int k = 0; k < 4; ++k) { float f[8]; unpack8(raw[s + k], f);
#pragma unroll
                    for (int c = 0; c < 8; ++c) val[c] += w[k][c] * f[c]; }
                v4u o; o.x = pk2(val[0], val[1]); o.y = pk2(val[2], val[3]); o.z = pk2(val[4], val[5]); o.w = pk2(val[6], val[7]);
                *(LAS v4u*)(lds + L_XBM + (2 * ts + s) * P1 + cg8 * 16) = o; }
        }
        WG_BAR();
        {
            const int trow = 16 * wid + fr; f32x4 R[4], I[4];
#pragma unroll
            for (int i = 0; i < 4; ++i) { R[i] = (f32x4){0.f, 0.f, 0.f, 0.f}; I[i] = R[i]; }
#pragma unroll
            for (int kk = 0; kk < 2; ++kk) { const bf16x8 xf = LDF(L_XBM + trow * P1 + kk * 64 + fq * 16);
#pragma unroll
                for (int jt = 0; jt < 4; ++jt) { R[jt] = MFMA16(LDF(L_WRA + (16 * jt + fr) * P1 + kk * 64 + fq * 16), xf, R[jt]); I[jt] = MFMA16(LDF(L_WIX + (16 * jt + fr) * P1 + kk * 64 + fq * 16), xf, I[jt]); } }
#pragma unroll
            for (int jt = 0; jt < 4; ++jt) { const v2u xw = *(const LAS v2u*)(lds + L_XBM + trow * P1 + (16 * jt + 4 * fq) * 2); const float xb[4] = {bflo(xw.x), bfhi(xw.x), bflo(xw.y), bfhi(xw.y)}; f32x4 av, uv;
#pragma unroll
                for (int r = 0; r < 4; ++r) { const float rg = sigmoid_f(R[jt][r] + braV[jt][r]), ig = sigmoid_f(I[jt][r] + bixV[jt][r]); const float la = rg * spV[jt][r];
                    av[r] = __expf(la); uv[r] = __builtin_amdgcn_sqrtf(fmaxf(1.0f - __expf(2.0f * la), 0.f)) * ig * xb[r]; }
                *(LAS f32x4*)(lds + L_AS + trow * P2 + (16 * jt + 4 * fq) * 4) = av; *(LAS f32x4*)(lds + L_US + trow * P2 + (16 * jt + 4 * fq) * 4) = uv; }
        }
        WG_BAR();
        {
            const int c = lane; bf16 gv[16];
#pragma unroll
            for (int s = 0; s < 16; ++s) gv[s] = ((const GAS bf16*)proj)[(row0 + 16 * wid + s) * PL + OFF_GATE + cbase + c];
            float hl = 0.f, ap = 1.f;
#pragma unroll
            for (int s = 0; s < 16; ++s) { LAS float* pa = (LAS float*)(lds + L_AS + (16 * wid + s) * P2) + c; LAS float* pu = (LAS float*)(lds + L_US + (16 * wid + s) * P2) + c;
                const float av = *pa, uv = *pu; hl = av * hl + uv; ap *= av; *pu = hl; *pa = ap; }
            ((LAS float*)(lds + L_SEGA))[wid * 64 + c] = ap; ((LAS float*)(lds + L_SEGH))[wid * 64 + c] = hl;
            WG_BAR();
            float hin = ((LAS float*)(lds + L_CARRY))[(tile & 1) * 64 + c];
            for (int q = 0; q < wid; ++q) hin = ((LAS float*)(lds + L_SEGA))[q * 64 + c] * hin + ((LAS float*)(lds + L_SEGH))[q * 64 + c];
            if (wid == 7) ((LAS float*)(lds + L_CARRY))[((tile + 1) & 1) * 64 + c] = ap * hin + hl;
#pragma unroll
            for (int s = 0; s < 16; ++s) { const float hv = ((LAS float*)(lds + L_US + (16 * wid + s) * P2))[c] + ((LAS float*)(lds + L_AS + (16 * wid + s) * P2))[c] * hin;
                const float x = bf1(gv[s]); const float ge = x * sigmoid_f(1.5957691216057308f * (x + 0.044715f * x * x * x));
                if (!DRY) ((GAS bf16*)proj)[(row0 + 16 * wid + s) * PL + OFF_GATE + cbase + c] = (bf16)(pk2(ge * hv, 0.f) & 0xffffu); }
        }
        WG_BAR();
    }
}
__device__ __forceinline__ void ssd_norm_pass(bf16* proj, const float* gss, const float* nw, int gw, int NGW, int lane) {
    const f32x4 w0a = *(const f32x4*)(nw + lane * 8), w0b = *(const f32x4*)(nw + lane * 8 + 4), w1a = *(const f32x4*)(nw + 512 + lane * 8), w1b = *(const f32x4*)(nw + 512 + lane * 8 + 4);
    for (int m0 = gw; m0 < M; m0 += 4 * NGW) {
        f32x4 ga[4], gb[4], gc[4], gd[4]; v4u a[4], c[4];
#pragma unroll
        for (int q = 0; q < 4; ++q) { const int m = m0 + q * NGW; if (m < M) { const f32x4* gp = (const f32x4*)(gss + (size_t)m * 16); ga[q] = gp[0]; gb[q] = gp[1]; gc[q] = gp[2]; gd[q] = gp[3];
            const bf16* rp = proj + (size_t)m * PL; a[q] = *(const v4u*)(rp + lane * 8); c[q] = *(const v4u*)(rp + 512 + lane * 8); } }
#pragma unroll
        for (int q = 0; q < 4; ++q) { const int m = m0 + q * NGW; if (m < M) { bf16* rp = proj + (size_t)m * PL;
            const float r0 = __builtin_amdgcn_rsqf((((ga[q][0] + ga[q][1]) + (ga[q][2] + ga[q][3])) + ((gb[q][0] + gb[q][1]) + (gb[q][2] + gb[q][3]))) * (1.0f / 512.0f) + EPS), r1 = __builtin_amdgcn_rsqf((((gc[q][0] + gc[q][1]) + (gc[q][2] + gc[q][3])) + ((gd[q][0] + gd[q][1]) + (gd[q][2] + gd[q][3]))) * (1.0f / 512.0f) + EPS);
            float f[8]; v4u o;
            unpack8(a[q], f); o.x = pk2(f[0] * r0 * w0a.x, f[1] * r0 * w0a.y); o.y = pk2(f[2] * r0 * w0a.z, f[3] * r0 * w0a.w); o.z = pk2(f[4] * r0 * w0b.x, f[5] * r0 * w0b.y); o.w = pk2(f[6] * r0 * w0b.z, f[7] * r0 * w0b.w); *(v4u*)(rp + lane * 8) = o;
            unpack8(c[q], f); o.x = pk2(f[0] * r1 * w1a.x, f[1] * r1 * w1a.y); o.y = pk2(f[2] * r1 * w1a.z, f[3] * r1 * w1a.w); o.z = pk2(f[4] * r1 * w1b.x, f[5] * r1 * w1b.y); o.w = pk2(f[6] * r1 * w1b.z, f[7] * r1 * w1b.w); *(v4u*)(rp + 512 + lane * 8) = o; } }
    }
}
__device__ __forceinline__ void diff_combine_pass(bf16* O, const float* lq1, const float* lk1, const float* lq2, const float* lk2, const float* subln, float lambda_init, int gw, int NGW, int lane) {
    const float lamv = __expf(wave_sum(lq1[lane] * lk1[lane])) - __expf(wave_sum(lq2[lane] * lk2[lane])) + lambda_init;
    const int e0 = (lane & 15) * 8; const f32x4 wa = *(const f32x4*)(subln + e0), wb = *(const f32x4*)(subln + e0 + 4); const float os = 1.0f - lambda_init;
    for (int m0 = gw; m0 < M; m0 += 4 * NGW) {
        v4u a[4][2], c[4][2];
#pragma unroll
        for (int q = 0; q < 4; ++q) { const int m = m0 + q * NGW; if (m < M) { const bf16* rp = O + (size_t)m * 2048;
#pragma unroll
            for (int hf = 0; hf < 2; ++hf) { a[q][hf] = *(const v4u*)(rp + hf * 512 + lane * 8); c[q][hf] = *(const v4u*)(rp + 1024 + hf * 512 + lane * 8); } } }
#pragma unroll
        for (int q = 0; q < 4; ++q) { const int m = m0 + q * NGW; if (m < M) { bf16* rp = O + (size_t)m * 2048;
#pragma unroll
            for (int hf = 0; hf < 2; ++hf) { const int col = hf * 512 + lane * 8; float f1[8], f2[8], o[8]; unpack8(a[q][hf], f1); unpack8(c[q][hf], f2); float ss = 0.f;
#pragma unroll
                for (int i = 0; i < 8; ++i) { o[i] = f1[i] - lamv * f2[i]; ss += o[i] * o[i]; }
                ss += __shfl_xor(ss, 1); ss += __shfl_xor(ss, 2); ss += __shfl_xor(ss, 4); ss += __shfl_xor(ss, 8);
                const float rs = os * __builtin_amdgcn_rsqf(ss * (1.0f / 128.0f) + EPS);
                v4u w; w.x = pk2(o[0] * rs * wa.x, o[1] * rs * wa.y); w.y = pk2(o[2] * rs * wa.z, o[3] * rs * wa.w); w.z = pk2(o[4] * rs * wb.x, o[5] * rs * wb.y); w.w = pk2(o[6] * rs * wb.z, o[7] * rs * wb.w);
                *(v4u*)(rp + col) = w; } } }
    }
}
__device__ __forceinline__ void final_norm_pass(float* out, const bf16* HB, const unsigned* LO, const float* rowss, const float* nw, int gw, int NGW, int lane) {
    const f32x4 wa = *(const f32x4*)(nw + lane * 8), wb = *(const f32x4*)(nw + lane * 8 + 4), wc = *(const f32x4*)(nw + 512 + lane * 8), wd = *(const f32x4*)(nw + 512 + lane * 8 + 4);
    for (int m0 = gw; m0 < M; m0 += 4 * NGW) {
        v4u a[4], c[4]; unsigned la[4], lc[4]; float rs[4];
#pragma unroll
        for (int q = 0; q < 4; ++q) { const int m = m0 + q * NGW; if (m < M) { const bf16* hp = HB + (size_t)m * 1024; a[q] = *(const v4u*)(hp + lane * 8); c[q] = *(const v4u*)(hp + 512 + lane * 8);
#if RESID_LO
            const unsigned* lp = LO + (size_t)m * 128; la[q] = lp[lane]; lc[q] = lp[64 + lane];
#else
            la[q] = 0u; lc[q] = 0u;
#endif
            rs[q] = pg8::rstd_of(rowss, m); } }
#pragma unroll
        for (int q = 0; q < 4; ++q) { const int m = m0 + q * NGW; if (m < M) { float* op = out + (size_t)m * 1024; float f[8]; const float r = rs[q];
            pg8::EpiResid::dec8(a[q], la[q], f); __builtin_nontemporal_store((f32x4){f[0] * r * wa.x, f[1] * r * wa.y, f[2] * r * wa.z, f[3] * r * wa.w}, (f32x4*)(op + lane * 8)); __builtin_nontemporal_store((f32x4){f[4] * r * wb.x, f[5] * r * wb.y, f[6] * r * wb.z, f[7] * r * wb.w}, (f32x4*)(op + lane * 8 + 4));
            pg8::EpiResid::dec8(c[q], lc[q], f); __builtin_nontemporal_store((f32x4){f[0] * r * wc.x, f[1] * r * wc.y, f[2] * r * wc.z, f[3] * r * wc.w}, (f32x4*)(op + 512 + lane * 8)); __builtin_nontemporal_store((f32x4){f[4] * r * wd.x, f[5] * r * wd.y, f[6] * r * wd.z, f[7] * r * wd.w}, (f32x4*)(op + 512 + lane * 8 + 4)); } }
    }
}
typedef GAS unsigned gu32;
constexpr size_t WS_CTL = 0, CTL_ZERO_BYTES = 64 * 1024;
constexpr int XB_MISC_OFF = LDS_BYTES - 64;
#define XB_TMO      128
#define XB_XCNT(j)  (256  + 64 * (j))
#define XB_XSUB(j)  (1280 + 64 * (j))
#define XB_XGEN(j)  (2304 + 64 * (j))
#define XB_TOP      3328
#define XB_TOPGEN   3392
#define XCD_BAR_WORDS 3456
#define XB_SPIN_CAP (1u << 18)

__device__ __forceinline__ unsigned xb_ld(unsigned* p)              { return __hip_atomic_load(p, __ATOMIC_RELAXED, __HIP_MEMORY_SCOPE_AGENT); }
__device__ __forceinline__ unsigned xb_add(unsigned* p, unsigned v) { return __hip_atomic_fetch_add(p, v, __ATOMIC_RELAXED, __HIP_MEMORY_SCOPE_AGENT); }
__device__ __forceinline__ unsigned xb_xcc_id() { return (unsigned)__builtin_amdgcn_s_getreg((3 << 11) | 20) & 0xFu; }
#define XB_SPIN(cond, bar) do { unsigned _sp = 0; while (cond) { __builtin_amdgcn_s_sleep(1); \
    if ((++_sp & 255u) == 0u) { if (xb_ld(&(bar)[XB_TMO])) break; if (_sp > XB_SPIN_CAP) { atomicAdd(&(bar)[XB_TMO], 1u); break; } } } } while (0)

struct XcdBarrier {
    unsigned* bar; unsigned x;
    volatile LAS unsigned* st;
};

__device__ __forceinline__ XcdBarrier xcd_barrier_post(unsigned* bar, volatile LAS unsigned* st) {
    XcdBarrier b; b.bar = bar; b.x = xb_xcc_id(); b.st = st;
    if (threadIdx.x == 0) (void)xb_add(&bar[XB_XCNT(b.x)], 1u);
    return b;
}
__device__ __forceinline__ void xcd_barrier_complete(unsigned* bar, unsigned x, unsigned& nloc, unsigned& nx) {
    const unsigned G = gridDim.x * gridDim.y * gridDim.z;
    unsigned sum, cnt, mine, sp = 0u;
    for (;;) {
        sum = 0u; cnt = 0u; mine = 0u;
#pragma unroll
        for (unsigned j = 0; j < 16; ++j) { const unsigned c = xb_ld(&bar[XB_XCNT(j)]); sum += c; cnt += (c > 0u) ? 1u : 0u; mine = (j == x) ? c : mine; }
        if (sum == G) break;
        __builtin_amdgcn_s_sleep(1);
        if ((++sp & 255u) == 0u) { if (xb_ld(&bar[XB_TMO])) break; if (sp > XB_SPIN_CAP) { atomicAdd(&bar[XB_TMO], 1u); break; } }
    }
    nloc = mine > 0u ? mine : 1u; nx = cnt > 0u ? cnt : 1u;
}

__device__ __forceinline__ void xcd_barrier(const XcdBarrier& b) {
    asm volatile("s_waitcnt vmcnt(0)" ::: "memory");
    __syncthreads();
    if (threadIdx.x == 0) {
        unsigned* bar = b.bar;
        __builtin_amdgcn_s_waitcnt(0);
        unsigned nloc = b.st[0], nx = b.st[1];
        if (nloc == 0u) { xcd_barrier_complete(bar, b.x, nloc, nx); b.st[0] = nloc; b.st[1] = nx; }
        const unsigned old = xb_add(&bar[XB_XSUB(b.x)], 1u);
        const unsigned gen = old / nloc;
        if (old + 1u == (gen + 1u) * nloc) {
            __builtin_amdgcn_fence(__ATOMIC_RELEASE, "agent");
            asm volatile("s_waitcnt vmcnt(0)" ::: "memory");
            const unsigned og = xb_add(&bar[XB_TOP], 1u);
            const unsigned tg = og / nx;
            if (og + 1u == (tg + 1u) * nx) xb_add(&bar[XB_TOPGEN], 1u);
            else XB_SPIN(xb_ld(&bar[XB_TOPGEN]) == tg, bar);
            __builtin_amdgcn_fence(__ATOMIC_ACQUIRE, "agent");
            xb_add(&bar[XB_XGEN(b.x)], 1u);
            asm volatile("s_waitcnt vmcnt(0)" ::: "memory");
        } else {
            XB_SPIN(xb_ld(&bar[XB_XGEN(b.x)]) == gen, bar);
            __builtin_amdgcn_fence(__ATOMIC_ACQUIRE, "agent");
            asm volatile("s_waitcnt vmcnt(0)" ::: "memory");
        }
    }
    __syncthreads();
}
__global__ void __launch_bounds__(NWAVES * 64, 2) mega_fwd(Args a) {
    extern __shared__ __attribute__((aligned(16))) unsigned char lds_raw[];
    LAS unsigned char* lds = (LAS unsigned char*)lds_raw;
    cg::grid_group grid = cg::this_grid();
    if (threadIdx.x < 16) ((LAS unsigned*)(lds + XB_MISC_OFF))[threadIdx.x] = 0u;
    __syncthreads();
    { XcdBarrier b0 = xcd_barrier_post((unsigned*)(a.ws + WS_CTL), (volatile LAS unsigned*)(lds + XB_MISC_OFF)); (void)b0; }
#define GSYNC() do { XcdBarrier xb_; xb_.bar = (unsigned*)(a.ws + WS_CTL); xb_.x = xb_xcc_id(); xb_.st = (volatile LAS unsigned*)(lds + XB_MISC_OFF); xcd_barrier(xb_); } while (0)
#define PHASE_ENV() \
    int tidL = threadIdx.x; asm volatile("" : "+v"(tidL)); const int tid = tidL, lane = tid & 63, wave = __builtin_amdgcn_readfirstlane(tid >> 6); \
    int G = gridDim.x, bx = blockIdx.x; asm volatile("" : "+s"(G), "+s"(bx)); const int vcu = (G % 8 == 0) ? (bx % 8) * (G / 8) + bx / 8 : bx; \
    const int gw = vcu * NWAVES + wave, NGW = G * NWAVES, gtid = bx * (NWAVES * 64) + tid, NGT = G * NWAVES * 64; \
    unsigned char* ws = a.ws; asm volatile("" : "+s"(ws)); \
    float* rowss = (float*)(ws + WS_ROWSS); float* gssb = (float*)(ws + WS_GSS); const float* rope = (const float*)(ws + WS_ROPE); float* dtb = (float*)(ws + WS_DT); \
    bf16* HB = (bf16*)(ws + WS_HB); bf16* BIG = (bf16*)(ws + WS_BIG); \
    bf16* GU1 = (bf16*)(ws + WS_WB + WB_GU1); bf16* D1 = (bf16*)(ws + WS_WB + WB_D1); bf16* GU2 = (bf16*)(ws + WS_WB + WB_GU2); bf16* D2 = (bf16*)(ws + WS_WB + WB_D2); \
    bf16* MI = (bf16*)(ws + WS_WB + WB_MI); bf16* MO = (bf16*)(ws + WS_WB + WB_MO); \
    (void)gw; (void)NGW; (void)gtid; (void)NGT; (void)rowss; (void)gssb; (void)rope; (void)dtb; (void)HB; (void)BIG; (void)GU1; (void)D1; (void)GU2; (void)D2; (void)MI; (void)MO; (void)lane; (void)vcu;
    grid.sync();
    { PHASE_ENV()
    prologue(a, lds, gw, NGW, wave, lane, gtid, NGT); }
    GSYNC();
    for (int lo = 0; lo < DEPTH; ++lo) {
#ifdef DUP_MIX
      for (int opx = (lo == 0) ? 1 : 0; opx < 10; ++opx) { const int op = opx < 5 ? opx : opx - 1; bool dry = (opx == 4);
        if (dry && (lo & 1)) continue;
#else
      for (int op = (lo == 0) ? 1 : 0; op < 10; ++op) { const bool dry = false;
#endif
        int l = lo; asm volatile("" : "+s"(l));
        const int j = l >> 1; const bool even = (l & 1) == 0;
        switch (op) {
        case 0: { PHASE_ENV() const float* const* tab = (const float* const*)(ws + WS_TAB);
            convert_layer(FromTab{tab}, ws, l, lds, gw, NGW, wave, lane); } break;
        case 1: case 8: { PHASE_ENV() const int hf = (op == 8);
            pg8::Gemm g{HB, hf ? GU2 : GU1, M, 2 * DFF, 1024, 1024}; pg8::StaticOrder S; S.init(M, 2 * DFF, G, bx);
            pg8::EpiSwiglu E{BIG, pg8::build_rstd(lds + 131072, rowss + (size_t)((3 * l + 2 * hf) & 1) * M * 16, S)};
#ifdef DUP_GU
            for (int rp = 0; rp < 2; ++rp)
#endif
            pg8::gemm_phase<pg8::EpiSwiglu, pg8::StaticOrder, true, true, 1024, 1024>(lds, g, S, E); } break;
        case 2: case 9: { PHASE_ENV() const float* const* tab = (const float* const*)(ws + WS_TAB);
            pg8::Gemm g{BIG, (op == 2) ? D1 : D2, M, 1024, DFF, DFF}; pg8::StaticOrder S; S.init(M, 1024, G, bx);
            pg8::EpiResid E{HB, (unsigned*)(ws + WS_LO), rowss + (size_t)(((op == 2) ? 3 * l + 1 : 3 * l + 3) & 1) * M * 16, 0.5f};
#ifdef DUP_RESID
            for (int rp = 0; rp < 2; ++rp) { E.scale = rp ? 0.5f : 0.f;
#endif
            pg8::gemm_phase<pg8::EpiResid, pg8::StaticOrder, true, true, DFF, DFF>(lds, g, S, E);
#ifdef DUP_RESID
            }
#endif
            } break;
        case 3: { PHASE_ENV()
            if (even) { pg8::Gemm g{HB, MI, M, 4864, 1024, 1024}; pg8::StaticOrder S; S.init(M, 4864, G, bx);
                pg8::EpiProj E{BIG, dtb, pg8::build_rstd(lds + 131072, rowss + (size_t)((3 * l + 1) & 1) * M * 16, S)};
                pg8::gemm_phase<pg8::EpiProj, pg8::StaticOrder, true, true, 1024, 1024>(lds, g, S, E); }
            else { pg8::Gemm g{HB, MI, M, 3072, 1024, 1024}; pg8::StaticOrder S; S.init(M, 3072, G, bx);
                pg8::EpiQkv E{BIG, pg8::build_rstd(lds + 131072, rowss + (size_t)((3 * l + 1) & 1) * M * 16, S), rope, attn_body::C2};
                pg8::gemm_phase<pg8::EpiQkv, pg8::StaticOrder, true, true, 1024, 1024>(lds, g, S, E); } } break;
        case 4: { if (!even) continue;
            PHASE_ENV() const float* const* tab = (const float* const*)(ws + WS_TAB);
            bc_preconv_pass(BIG, tab[11] + (size_t)j * 4 * 1536, tab[12] + (size_t)j * 1536, gtid, NGT); } break;
        case 5: {
            if (even) { int G = gridDim.x, bx = blockIdx.x; asm volatile("" : "+s"(G), "+s"(bx)); const int vcu = (G % 8 == 0) ? (bx % 8) * (G / 8) + bx / 8 : bx;
                for (int u = vcu; u < 256; u += G) { const int b = u >> 4, h = u & 15; unsigned char* wsu = a.ws; asm volatile("" : "+s"(wsu));
#if defined(DUP_SSD) || defined(DUP_LRU)
                    for (int rp = 0; rp < 2; ++rp) { int dr = (rp == 0); asm volatile("" : "+s"(dr));
#ifndef DUP_LRU
                    ssd_unit(lds, b, h, j, wsu, dr != 0);
#else
                    if (!dr) ssd_unit(lds, b, h, j, wsu, false);
#endif
#ifndef DUP_SSD
                    lru_unit(lds, b, h, j, wsu, dr != 0);
#else
                    if (!dr) lru_unit(lds, b, h, j, wsu, false);
#endif
                    }
#else
                    ssd_unit(lds, b, h, j, wsu, dry);
                    lru_unit(lds, b, h, j, wsu, dry);
#endif
                } }
            else {
#ifndef NO_ATTN
                int G = gridDim.x, bx = blockIdx.x; asm volatile("" : "+s"(G), "+s"(bx)); const int vcu = (G % 8 == 0) ? (bx % 8) * (G / 8) + bx / 8 : bx;
                unsigned char* wsu = a.ws; asm volatile("" : "+s"(wsu)); bf16* BIG = (bf16*)(wsu + WS_BIG);
                const attn_body::AttnTensors AT{(const attn_body::bf16*)BIG, (const attn_body::bf16*)(BIG + (size_t)M * 1024), (const attn_body::bf16*)(BIG + (size_t)2 * M * 1024), (attn_body::bf16*)(BIG + (size_t)3 * M * 1024)};
                attn_body::attn_phase<8>((char*)lds_raw, AT, vcu, G);
#ifdef DUP_ATTN
                attn_body::attn_phase<8>((char*)lds_raw, AT, vcu, G);
#endif
#endif
            } } break;
        case 6: { PHASE_ENV() const float* const* tab = (const float* const*)(ws + WS_TAB);
            if (even) ssd_norm_pass(BIG, gssb, tab[16] + (size_t)j * 1024, gw, NGW, lane);
            else diff_combine_pass(BIG + (size_t)3 * M * 1024, tab[26] + j * 64, tab[27] + j * 64, tab[28] + j * 64, tab[29] + j * 64, tab[30] + j * 128, 0.8f - 0.6f * expf(-0.3f * (float)l), gw, NGW, lane); } break;
        default: { PHASE_ENV() const float* const* tab = (const float* const*)(ws + WS_TAB);
            pg8::StaticOrder S; S.init(M, 1024, G, bx);
            pg8::EpiResid E{HB, (unsigned*)(ws + WS_LO), rowss + (size_t)((3 * l + 2) & 1) * M * 16, 1.0f};
            if (even) { pg8::Gemm g{BIG, MO, M, 1024, 2048, PL}; pg8::gemm_phase<pg8::EpiResid, pg8::StaticOrder, true, true, 2048, PL>(lds, g, S, E); }
            else { pg8::Gemm g{BIG + (size_t)3 * M * 1024, MO, M, 1024, 1024, 2048}; pg8::gemm_phase<pg8::EpiResid, pg8::StaticOrder, true, true, 1024, 2048>(lds, g, S, E); } } break;
        }
        GSYNC();
#ifdef DUP_SYNC
        GSYNC(); GSYNC();
#endif
      }
    }
    { PHASE_ENV()
    const float* const* tab = (const float* const*)(ws + WS_TAB);
    final_norm_pass((float*)tab[33], HB, (const unsigned*)(ws + WS_LO), rowss, tab[32], gw, NGW, lane); }
}

extern "C" void kernel_launch(void* const* d_in, const int* in_sizes, int n_in, void* d_out, int out_size, void* d_ws, size_t ws_size, hipStream_t stream) {
    static int grid = 0;
    if (grid == 0) {
        if (n_in != 33 || out_size != M * 1024 || ws_size < WS_END) { fprintf(stderr, "kernel_launch: unexpected problem (n_in %d, out %d, ws %zu)\n", n_in, out_size, ws_size); grid = -1; return; }
        int dev = 0, cus = 0, per_cu = 0;
        if (hipGetDevice(&dev) != hipSuccess || hipDeviceGetAttribute(&cus, hipDeviceAttributeMultiprocessorCount, dev) != hipSuccess) { grid = -1; return; }
        if (hipFuncSetAttribute((const void*)mega_fwd, hipFuncAttributeMaxDynamicSharedMemorySize, LDS_BYTES) != hipSuccess) { fprintf(stderr, "kernel_launch: hipFuncSetAttribute failed\n"); grid = -1; return; }
        if (hipOccupancyMaxActiveBlocksPerMultiprocessor(&per_cu, (const void*)mega_fwd, NWAVES * 64, LDS_BYTES) != hipSuccess || per_cu < 1) { fprintf(stderr, "kernel_launch: occupancy query says %d\n", per_cu); per_cu = 1; }
        (void)hipGetLastError();
        grid = cus;
    }
    if (grid < 0) return;
    Args a{};
    for (int i = 0; i < 33; ++i) a.in[i] = (const float*)d_in[i];
    a.out = (float*)d_out; a.ws = (unsigned char*)d_ws;
    if (hipMemsetAsync((char*)d_ws + WS_CTL, 0, CTL_ZERO_BYTES, stream) != hipSuccess) { fprintf(stderr, "kernel_launch: memset failed\n"); return; }
    void* args[] = {&a};
    hipError_t e = hipLaunchCooperativeKernel((const void*)mega_fwd, dim3(grid), dim3(NWAVES * 64), args, LDS_BYTES, stream);
    if (e != hipSuccess) fprintf(stderr, "kernel_launch: cooperative launch failed: %s (grid %d)\n", hipGetErrorString(e), grid);
}
```

```cpp
#define RESID_LO 0
#include <hip/hip_runtime.h>
#include <hip/hip_cooperative_groups.h>
#include <hip/hip_bf16.h>
#include <cstdio>
#include <cstdint>
#include <cmath>
namespace cg = cooperative_groups;
namespace pg8 {
#define PG8_LAS __attribute__((address_space(3)))
typedef unsigned short bf16_t;
typedef short bf16x8 __attribute__((ext_vector_type(8)));
typedef float f32x4 __attribute__((ext_vector_type(4)));
typedef unsigned u32x4 __attribute__((ext_vector_type(4)));
constexpr int BM = 256, BK = 64, HALF = 128, HTB = HALF * BK * 2  , STAGE_BYTES = 8 * HTB, NXCD = 8, WGM = 8;

__host__ __device__ __forceinline__ int lds_byte(int r, int c) { const int st = (r >> 4) * 2 + (c >> 5), rr = r & 15, cc = c & 31, ob = rr * 64 + cc * 2; return st * 1024 + (ob ^ (((ob >> 9) & 1) << 5)); }
__host__ __device__ __forceinline__ void stage_rc(int b, int& R, int& C) { const int st = b / 1024, sb = b % 1024, swz = sb ^ (((sb >> 9) & 1) << 5); R = (st >> 1) * 16 + swz / 64; C = (st & 1) * 32 + (swz % 64) / 2; }
__host__ __device__ __forceinline__ int perm32(int rho) { const int n = rho >> 4, i = rho & 15; return 8 * (i >> 2) + 4 * n + (i & 3); }

struct Unit { int pm, pn; };
struct Gemm { const bf16_t* A; const bf16_t* Bt; int M, N, K, lda; };

struct StaticOrder {
    int nM, nN, nwg, G, c;
    __host__ __device__ void init(int M, int N, int G_, int c_) { nM = M / BM; nN = N / BM; nwg = nM * nN; G = G_; c = c_; }
    __host__ __device__ bool next(int i, Unit& u) const {
        const long L = (long)i * G + c; if (L >= nwg) return false;
        int wgid = (int)L; { const int q = nwg / NXCD, r = nwg % NXCD, xcd = wgid % NXCD, off = wgid / NXCD; wgid = (xcd < r ? xcd * (q + 1) : r * (q + 1) + (xcd - r) * q) + off; }
        const int nig = WGM * nN, gid = wgid / nig, fm = gid * WGM, gsz = (nM - fm) < WGM ? (nM - fm) : WGM;
        u.pm = fm + ((wgid % nig) % gsz); u.pn = (wgid % nig) / gsz; return true;
    }
    __device__ __forceinline__ void a_ready(const Unit&) const {}
    __device__ __forceinline__ void done(const Unit&) const {}
};

__device__ __forceinline__ unsigned cvt_pk_bf16(float lo, float hi) { unsigned r; asm volatile("v_cvt_pk_bf16_f32 %0, %1, %2" : "=v"(r) : "v"(lo), "v"(hi)); return r; }
typedef float f32x2 __attribute__((ext_vector_type(2)));
template <class Epi, class Sched, bool ALIGN_EPI = false, bool SP2 = false, int KC = 0, int LDAC = 0>
__device__ __forceinline__ void gemm_phase(PG8_LAS unsigned char* lds, const Gemm g, const Sched& S, const Epi& E) {
    int tid_ = threadIdx.x; asm volatile("" : "+v"(tid_));
    const int tid = tid_, wid = __builtin_amdgcn_readfirstlane(tid >> 6), lane = tid & 63, wr = wid >> 2, wc = wid & 3, fr = lane & 15, fq = lane >> 4;
    const int K = KC ? KC : g.K, nt = K / BK, LDA = LDAC ? LDAC : g.lda;
    unsigned voffA[2], voffB[2];
#pragma unroll
    for (int i = 0; i < 2; ++i) { int R, C; stage_rc(tid * 16 + i * 8192, R, C); const int Rb = Epi::PERM ? ((R & ~31) + perm32(R & 31)) : R;
        voffA[i] = (unsigned)(R * LDA + C) * 2u; voffB[i] = (unsigned)(Rb * K + C) * 2u; }
    const size_t kstep = (size_t)(BK * 2);
    const size_t hstep = (size_t)HALF * K * 2;
    const size_t tstep = 2 * hstep; const size_t hstepA = (size_t)HALF * LDA * 2, tstepA = 2 * hstepA;
    const unsigned ldsw = (unsigned)wid * 1024u;
    const int aoff = lds_byte(wr * 64 + fr, fq * 8), boff = lds_byte(wc * 32 + fr, fq * 8);
#define PG8_SA(b, h) (((b) * 2 + (h)) * HTB)
#define PG8_SB(b, h) ((4 + (b) * 2 + (h)) * HTB)
#define PG8_STAGE(bufoff, gbase, voff) do { _Pragma("unroll") for (int _i = 0; _i < 2; ++_i) \
        __builtin_amdgcn_global_load_lds((const unsigned*)((const char*)(gbase) + (voff)[_i]), (PG8_LAS unsigned*)(lds + (bufoff) + ldsw + _i * 8192), 16, 0, 0); } while (0)
#define PG8_LDA(dst, b, h) do { _Pragma("unroll") for (int m = 0; m < 4; ++m) _Pragma("unroll") for (int k = 0; k < 2; ++k) dst[m][k] = *(const PG8_LAS bf16x8*)(lds + PG8_SA(b, h) + aoff + m * 2048 + k * 1024); } while (0)
#define PG8_LDB(dst, b, h) do { _Pragma("unroll") for (int n = 0; n < 2; ++n) _Pragma("unroll") for (int k = 0; k < 2; ++k) dst[n][k] = *(const PG8_LAS bf16x8*)(lds + PG8_SB(b, h) + boff + n * 2048 + k * 1024); } while (0)
#define PG8_MMA(ai, bj, At, Bt) do { __builtin_amdgcn_s_setprio(1); _Pragma("unroll") for (int m = 0; m < 4; ++m) _Pragma("unroll") for (int n = 0; n < 2; ++n) _Pragma("unroll") for (int k = 0; k < 2; ++k) \
        acc[ai][bj][m][n] = __builtin_amdgcn_mfma_f32_16x16x32_bf16(Bt[n][k], At[m][k], acc[ai][bj][m][n], 0, 0, 0); __builtin_amdgcn_s_setprio(0); } while (0)
#define PG8_WAIT_V(n) asm volatile("s_waitcnt vmcnt(" #n ")" ::: "memory")
#define PG8_WAIT_L(n) asm volatile("s_waitcnt lgkmcnt(" #n ")" ::: "memory")
#define PG8_BAR __builtin_amdgcn_s_barrier()
#define PG8_SCHED __builtin_amdgcn_sched_barrier(0)
    Unit cur, nxt; int ui = 0;
    if (!S.next(0, cur)) return;
    f32x4 acc[2][2][4][2];
#pragma unroll
    for (int a = 0; a < 2; ++a)
#pragma unroll
        for (int b = 0; b < 2; ++b)
#pragma unroll
            for (int m = 0; m < 4; ++m)
#pragma unroll
                for (int n = 0; n < 2; ++n) acc[a][b][m][n] = (f32x4){0.f, 0.f, 0.f, 0.f};
    bf16x8 At[4][2], B0[2][2], B1[2][2];
    const char* cA = (const char*)g.A + (size_t)cur.pm * tstepA; const char* cB = (const char*)g.Bt + (size_t)cur.pn * tstep;
    S.a_ready(cur);
    if constexpr (SP2) {
        PG8_STAGE(PG8_SB(0, 0), cB, voffB); PG8_STAGE(PG8_SB(0, 1), cB + hstep, voffB); PG8_STAGE(PG8_SA(0, 0), cA, voffA); PG8_STAGE(PG8_SA(0, 1), cA + hstepA, voffA);
        if (wr == 1) PG8_BAR;
        PG8_WAIT_V(2); PG8_BAR;
        PG8_STAGE(PG8_SB(1, 0), cB + kstep, voffB); PG8_STAGE(PG8_SA(1, 0), cA + kstep, voffA); PG8_STAGE(PG8_SB(1, 1), cB + hstep + kstep, voffB);
        PG8_WAIT_V(6); PG8_BAR;
    } else {
        PG8_STAGE(PG8_SB(0, 0), cB, voffB); PG8_STAGE(PG8_SA(0, 0), cA, voffA); PG8_STAGE(PG8_SB(0, 1), cB + hstep, voffB); PG8_STAGE(PG8_SA(0, 1), cA + hstepA, voffA);
        if (wr == 1) PG8_BAR;
        PG8_WAIT_V(4); PG8_BAR;
        PG8_STAGE(PG8_SB(1, 0), cB + kstep, voffB); PG8_STAGE(PG8_SA(1, 0), cA + kstep, voffA); PG8_STAGE(PG8_SB(1, 1), cB + hstep + kstep, voffB);
        PG8_WAIT_V(6); PG8_BAR;
    }
    for (;;) {
        const bool has_next = S.next(ui + 1, nxt);
        const char* nA = has_next ? (const char*)g.A + (size_t)nxt.pm * tstepA : cA; const char* nB = has_next ? (const char*)g.Bt + (size_t)nxt.pn * tstep : cB;
        for (int t = 0; t < nt; t += 2) {
            const bool last = (t == nt - 2);
            const char* a1 = cA + (size_t)(t + 1) * kstep;
            const char* a2 = last ? nA : cA + (size_t)(t + 2) * kstep; const char* b2 = last ? nB : cB + (size_t)(t + 2) * kstep;
            const char* a3 = a2 + kstep; const char* b3 = b2 + kstep;
            if (last && has_next) S.a_ready(nxt);
            if constexpr (SP2) {
            PG8_LDB(B0, 0, 0); PG8_LDB(B1, 0, 1); PG8_SCHED; PG8_LDA(At, 0, 0); PG8_STAGE(PG8_SA(1, 1), a1 + hstepA, voffA);
            PG8_WAIT_V(8); PG8_WAIT_L(0); PG8_BAR; PG8_MMA(0, 0, At, B0); PG8_MMA(0, 1, At, B1); PG8_BAR; PG8_SCHED;
            PG8_LDA(At, 0, 1); PG8_STAGE(PG8_SB(0, 0), b2, voffB); PG8_STAGE(PG8_SB(0, 1), b2 + hstep, voffB); PG8_STAGE(PG8_SA(0, 0), a2, voffA);
            PG8_WAIT_V(8); PG8_WAIT_L(0); PG8_BAR; PG8_MMA(1, 0, At, B0); PG8_MMA(1, 1, At, B1); PG8_BAR; PG8_SCHED;
            PG8_LDB(B0, 1, 0); PG8_LDB(B1, 1, 1); PG8_SCHED; PG8_LDA(At, 1, 0); PG8_STAGE(PG8_SA(0, 1), a2 + hstepA, voffA);
            PG8_WAIT_V(8); PG8_WAIT_L(0); PG8_BAR; PG8_MMA(0, 0, At, B0); PG8_MMA(0, 1, At, B1); PG8_BAR; PG8_SCHED;
            PG8_LDA(At, 1, 1); PG8_STAGE(PG8_SB(1, 0), b3, voffB); PG8_STAGE(PG8_SB(1, 1), b3 + hstep, voffB); PG8_STAGE(PG8_SA(1, 0), a3, voffA);
            PG8_WAIT_V(8); PG8_WAIT_L(0); PG8_BAR; PG8_MMA(1, 0, At, B0); PG8_MMA(1, 1, At, B1); PG8_BAR; PG8_SCHED;
            } else {
            PG8_LDB(B0, 0, 0); PG8_SCHED; PG8_LDA(At, 0, 0); PG8_STAGE(PG8_SA(1, 1), a1 + hstepA, voffA);
            PG8_WAIT_L(8); PG8_BAR; PG8_WAIT_L(0); PG8_MMA(0, 0, At, B0); PG8_BAR; PG8_SCHED;
            PG8_LDB(B1, 0, 1); PG8_STAGE(PG8_SB(0, 0), b2, voffB);
            PG8_BAR; PG8_WAIT_L(0); PG8_MMA(0, 1, At, B1); PG8_BAR;
            PG8_LDA(At, 0, 1); PG8_STAGE(PG8_SA(0, 0), a2, voffA);
            PG8_BAR; PG8_WAIT_L(0); PG8_MMA(1, 0, At, B0); PG8_BAR; PG8_SCHED;
            PG8_STAGE(PG8_SB(0, 1), b2 + hstep, voffB);
            PG8_WAIT_V(6); PG8_BAR; PG8_MMA(1, 1, At, B1); PG8_BAR;
            PG8_LDB(B0, 1, 0); PG8_SCHED; PG8_LDA(At, 1, 0); PG8_STAGE(PG8_SA(0, 1), a2 + hstepA, voffA);
            PG8_WAIT_L(8); PG8_BAR; PG8_WAIT_L(0); PG8_MMA(0, 0, At, B0); PG8_BAR; PG8_SCHED;
            PG8_LDB(B1, 1, 1); PG8_STAGE(PG8_SB(1, 0), b3, voffB);
            PG8_BAR; PG8_WAIT_L(0); PG8_MMA(0, 1, At, B1); PG8_BAR;
            PG8_LDA(At, 1, 1); PG8_STAGE(PG8_SA(1, 0), a3, voffA);
            PG8_BAR; PG8_WAIT_L(0); PG8_MMA(1, 0, At, B0); PG8_BAR; PG8_SCHED;
            PG8_STAGE(PG8_SB(1, 1), b3 + hstep, voffB);
            PG8_WAIT_V(6); PG8_BAR; PG8_MMA(1, 1, At, B1); PG8_BAR;
            }
        }
        if constexpr (ALIGN_EPI) { if (wr == 0) PG8_BAR; }
        if constexpr (!Epi::AFTER_DRAIN) { E(acc, cur, wr, wc, fr, fq); S.done(cur); }
        if (!has_next) break;
#pragma unroll
        for (int a = 0; a < 2; ++a)
#pragma unroll
            for (int b = 0; b < 2; ++b)
#pragma unroll
                for (int m = 0; m < 4; ++m)
#pragma unroll
                    for (int n = 0; n < 2; ++n) acc[a][b][m][n] = (f32x4){0.f, 0.f, 0.f, 0.f};
        cur = nxt; cA = nA; cB = nB; ++ui;
        if constexpr (ALIGN_EPI) { if (wr == 1) PG8_BAR; }
    }
    PG8_WAIT_V(0);
    if constexpr (!ALIGN_EPI) { if (wr == 0) PG8_BAR; }
    PG8_BAR;
    if constexpr (Epi::AFTER_DRAIN) { E.fused(acc, cur, wr, wc, fr, fq, lds, wid, lane); S.done(cur); }
#undef PG8_SA
#undef PG8_SB
#undef PG8_STAGE
#undef PG8_LDA
#undef PG8_LDB
#undef PG8_MMA
#undef PG8_WAIT_V
#undef PG8_WAIT_L
#undef PG8_BAR
#undef PG8_SCHED
}
}
namespace pg8 {
constexpr float NORM_EPS = 1e-6f;
#define PG8_GAS __attribute__((address_space(1)))
typedef PG8_GAS f32x4 gf32x4; typedef PG8_GAS u32x4 gu32x4; typedef PG8_GAS float gfloat;
__device__ __forceinline__ float rstd_of(const float* rowss, int row) { const gf32x4* p = (const gf32x4*)(rowss + (size_t)row * 16); const f32x4 a = p[0], b = p[1], c = p[2], d = p[3];
    const float s = (((a[0] + a[1]) + (a[2] + a[3])) + ((b[0] + b[1]) + (b[2] + b[3]))) + (((c[0] + c[1]) + (c[2] + c[3])) + ((d[0] + d[1]) + (d[2] + d[3]))); return __builtin_amdgcn_rsqf(s * (1.0f / 1024.0f) + NORM_EPS); }
struct RstdTab {
    int p0, p1, p2, p3; const PG8_LAS float* tab; const float* rowss;
    __device__ __forceinline__ float get(int pm, int row) const {
        if (pm == p0) return tab[(row & 255)]; if (pm == p1) return tab[256 + (row & 255)]; if (pm == p2) return tab[512 + (row & 255)]; if (pm == p3) return tab[768 + (row & 255)];
        return rstd_of(rowss, row); }
};
template <class Sched> __device__ __forceinline__ RstdTab build_rstd(PG8_LAS unsigned char* lds_free, const float* rowss, const Sched& S) {
    RstdTab t; t.p0 = t.p1 = t.p2 = t.p3 = -1; t.tab = (const PG8_LAS float*)lds_free; t.rowss = rowss;
    Unit u;
    for (int i = 0; S.next(i, u); ++i) { const int pm = u.pm;
        if (pm != t.p0 && pm != t.p1 && pm != t.p2 && pm != t.p3) { if (t.p0 < 0) t.p0 = pm; else if (t.p1 < 0) t.p1 = pm; else if (t.p2 < 0) t.p2 = pm; else if (t.p3 < 0) t.p3 = pm; } }
    int tid_ = threadIdx.x; asm volatile("" : "+v"(tid_));
    for (int e = tid_; e < 1024; e += 512) { const int k = e >> 8, r = e & 255; const int pm = (k == 0) ? t.p0 : (k == 1) ? t.p1 : (k == 2) ? t.p2 : t.p3;
        if (pm >= 0) ((PG8_LAS float*)lds_free)[e] = rstd_of(rowss, pm * 256 + r); }
    asm volatile("s_waitcnt vmcnt(0) lgkmcnt(0)" ::: "memory"); __builtin_amdgcn_s_barrier(); asm volatile("" ::: "memory");
    return t;
}
__device__ __forceinline__ float silu_f(float x) { return x * __builtin_amdgcn_rcpf(1.0f + __expf(-x)); }
struct EpiSwiglu {
    static constexpr bool PERM = true, AFTER_DRAIN = false;
    bf16_t* O; RstdTab rt;
    __device__ __forceinline__ void operator()(const f32x4 (&acc)[2][2][4][2], const Unit& u, int wr, int wc, int fr, int fq) const {
        const int row0 = u.pm * BM + wr * 64 + fr, col0 = u.pn * 128 + wc * 32 + 8 * fq;
#pragma unroll
        for (int ai = 0; ai < 2; ++ai)
#pragma unroll
            for (int m = 0; m < 4; ++m) { const int row = row0 + ai * HALF + m * 16; const float rs = rt.get(u.pm, row);
                float o[8];
#pragma unroll
                for (int n = 0; n < 2; ++n)
#pragma unroll
                    for (int j = 0; j < 4; ++j) { const float g = acc[ai][0][m][n][j] * rs, up = acc[ai][1][m][n][j] * rs; o[n * 4 + j] = silu_f(g) * up; }
                u32x4 w; w.x = cvt_pk_bf16(o[0], o[1]); w.y = cvt_pk_bf16(o[2], o[3]); w.z = cvt_pk_bf16(o[4], o[5]); w.w = cvt_pk_bf16(o[6], o[7]);
                *(gu32x4*)(O + (size_t)row * 2816 + col0) = w; }
    }
};
#ifndef RESID_LO
#define RESID_LO 1
#endif
struct EpiResid {
    static constexpr bool PERM = true, AFTER_DRAIN = false;
    bf16_t* HB; unsigned* LO; float* rowss_next; float scale;
    static __device__ __forceinline__ float dec_lo(unsigned hw, unsigned nib) { return __uint_as_float(((hw << 16) | (nib << 12)) - (RESID_LO ? 0x7800u : 0u)); }
    static __device__ __forceinline__ float dec_hi(unsigned hw, unsigned nib) { return __uint_as_float(((hw & 0xffff0000u) | (nib << 12)) - (RESID_LO ? 0x7800u : 0u)); }
    static __device__ __forceinline__ unsigned enc(float h) { return __float_as_uint(h) + 0x8000u; }
    static __device__ __forceinline__ void dec8(const u32x4 hb, const unsigned lq, float (&f)[8]) {
        f[0] = dec_lo(hb.x, lq & 0xfu); f[1] = dec_hi(hb.x, (lq >> 4) & 0xfu); f[2] = dec_lo(hb.y, (lq >> 8) & 0xfu); f[3] = dec_hi(hb.y, (lq >> 12) & 0xfu);
        f[4] = dec_lo(hb.z, (lq >> 16) & 0xfu); f[5] = dec_hi(hb.z, (lq >> 20) & 0xfu); f[6] = dec_lo(hb.w, (lq >> 24) & 0xfu); f[7] = dec_hi(hb.w, lq >> 28);
    }
    static __device__ __forceinline__ unsigned nib8(const unsigned (&e)[8]) {
        return ((e[0] >> 12) & 0xfu) | ((e[1] >> 8) & 0xf0u) | ((e[2] >> 4) & 0xf00u) | (e[3] & 0xf000u) | ((e[4] << 4) & 0xf0000u) | ((e[5] << 8) & 0xf00000u) | ((e[6] << 12) & 0xf000000u) | ((e[7] << 16) & 0xf0000000u);
    }
    __device__ __forceinline__ void operator()(const f32x4 (&acc)[2][2][4][2], const Unit& u, int wr, int wc, int fr, int fq) const {
        const int row0 = u.pm * BM + wr * 64 + fr, col0 = u.pn * BM + wc * 32 + 8 * fq;
#pragma unroll
        for (int ai = 0; ai < 2; ++ai)
#pragma unroll
            for (int m = 0; m < 4; ++m) { const int row = row0 + ai * HALF + m * 16; bf16_t* bp = HB + (size_t)row * 1024 + col0; unsigned* lp = LO + (size_t)row * 128 + (col0 >> 3); float ss = 0.f;
#pragma unroll
                for (int bj = 0; bj < 2; ++bj) { const u32x4 old = *(const gu32x4*)(bp + bj * HALF);
#if RESID_LO
                    const unsigned lq = lp[bj * (HALF / 8)];
#else
                    const unsigned lq = 0u;
#endif
                    float h[8]; dec8(old, lq, h);
#pragma unroll
                    for (int j = 0; j < 4; ++j) { h[j] += acc[ai][bj][m][0][j] * scale; h[4 + j] += acc[ai][bj][m][1][j] * scale; }
#pragma unroll
                    for (int j = 0; j < 8; ++j) ss += h[j] * h[j];
#if RESID_LO
                    unsigned e[8];
#pragma unroll
                    for (int j = 0; j < 8; ++j) e[j] = enc(h[j]);
                    u32x4 w; w.x = (e[0] >> 16) | (e[1] & 0xffff0000u); w.y = (e[2] >> 16) | (e[3] & 0xffff0000u); w.z = (e[4] >> 16) | (e[5] & 0xffff0000u); w.w = (e[6] >> 16) | (e[7] & 0xffff0000u);
                    *(u32x4*)(bp + bj * HALF) = w;
                    lp[bj * (HALF / 8)] = nib8(e);
#else
                    u32x4 w; w.x = cvt_pk_bf16(h[0], h[1]); w.y = cvt_pk_bf16(h[2], h[3]); w.z = cvt_pk_bf16(h[4], h[5]); w.w = cvt_pk_bf16(h[6], h[7]);
                    *(gu32x4*)(bp + bj * HALF) = w;
#endif
                }
                ss += __shfl_xor(ss, 16); ss += __shfl_xor(ss, 32);
                if (fq == 0) ((gfloat*)rowss_next)[(size_t)row * 16 + u.pn * 4 + wc] = ss; }
    }
};
struct EpiProj {
    static constexpr bool PERM = true, AFTER_DRAIN = false;
    bf16_t* P; float* DT; RstdTab rt;
    __device__ __forceinline__ void operator()(const f32x4 (&acc)[2][2][4][2], const Unit& u, int wr, int wc, int fr, int fq) const {
        const int row0 = u.pm * BM + wr * 64 + fr, col0 = u.pn * BM + wc * 32 + 8 * fq;
#pragma unroll
        for (int ai = 0; ai < 2; ++ai)
#pragma unroll
            for (int m = 0; m < 4; ++m) { const int row = row0 + ai * HALF + m * 16; const float rs = rt.get(u.pm, row);
                if (u.pn < 18) {
#pragma unroll
                    for (int bj = 0; bj < 2; ++bj) { const f32x4 v0 = acc[ai][bj][m][0] * rs, v1 = acc[ai][bj][m][1] * rs;
                        u32x4 w; w.x = cvt_pk_bf16(v0[0], v0[1]); w.y = cvt_pk_bf16(v0[2], v0[3]); w.z = cvt_pk_bf16(v1[0], v1[1]); w.w = cvt_pk_bf16(v1[2], v1[3]);
                        *(gu32x4*)(P + (size_t)row * 4608 + col0 + bj * HALF) = w; }
                } else if (wc == 0 && fq < 2) {
                    *(gf32x4*)(DT + (size_t)row * 16 + 8 * fq) = acc[ai][0][m][0] * rs; *(gf32x4*)(DT + (size_t)row * 16 + 8 * fq + 4) = acc[ai][0][m][1] * rs; }
            }
    }
};
struct EpiQkv {
    static constexpr bool PERM = true, AFTER_DRAIN = false;
    bf16_t* QKV; RstdTab rt; const float* rope; float qscale;
    __device__ __forceinline__ void operator()(const f32x4 (&acc)[2][2][4][2], const Unit& u, int wr, int wc, int fr, int fq) const {
        const int sect = u.pn >> 2; bf16_t* base = QKV + (size_t)sect * ((size_t)32768 * 1024);
        const int row0 = u.pm * BM + wr * 64 + fr, col0 = (u.pn & 3) * BM + wc * 32 + 8 * fq;
        const float sc = sect == 0 ? qscale : 1.0f; const bool rot = (sect < 2), mine = ((wc & 1) == 0) && (fq < 2);
#pragma unroll
        for (int ai = 0; ai < 2; ++ai)
#pragma unroll
            for (int m = 0; m < 4; ++m) { const int row = row0 + ai * HALF + m * 16; const float rs = rt.get(u.pm, row);
                f32x4 c0 = {1.f, 1.f, 1.f, 1.f}, c1 = c0, s0 = {0.f, 0.f, 0.f, 0.f}, s1 = s0;
                if (rot && mine) { const float* rp = rope + (size_t)(row & 2047) * 16; c0 = *(const gf32x4*)rp; c1 = *(const gf32x4*)(rp + 4); s0 = *(const gf32x4*)(rp + 8); s1 = *(const gf32x4*)(rp + 12);
                    if (fq == 0) { s0 = -s0; s1 = -s1; } }
#pragma unroll
                for (int bj = 0; bj < 2; ++bj) { f32x4 v0 = acc[ai][bj][m][0] * rs, v1 = acc[ai][bj][m][1] * rs;
                    if (rot) { f32x4 p0, p1;
#pragma unroll
                        for (int j = 0; j < 4; ++j) { p0[j] = __shfl_xor(v0[j], 16); p1[j] = __shfl_xor(v1[j], 16); }
                        v0 = v0 * c0 + p0 * s0; v1 = v1 * c1 + p1 * s1; }
                    v0 = v0 * sc; v1 = v1 * sc;
                    u32x4 w; w.x = cvt_pk_bf16(v0[0], v0[1]); w.y = cvt_pk_bf16(v0[2], v0[3]); w.z = cvt_pk_bf16(v1[0], v1[1]); w.w = cvt_pk_bf16(v1[2], v1[3]);
                    *(gu32x4*)(base + (size_t)row * 1024 + col0 + bj * HALF) = w; }
            }
    }
};
}
#include <hip/hip_bf16.h>
#include <cmath>
namespace attn_body {
using bf16=__hip_bfloat16;
using bf16x8=__attribute__((ext_vector_type(8)))short;
using s16x4=__attribute__((ext_vector_type(4)))short;
using f32x16=__attribute__((ext_vector_type(16)))float;
using u32x4=__attribute__((ext_vector_type(4)))unsigned;
constexpr int BATCH=16,SEQ=2048,D=64,DM=1024,OP=2048;
constexpr int NW=8,QBLK=32,QB=QBLK*NW,KVBLK=64,NQB=SEQ/QB;
constexpr int ATTN_PITCH=DM, ATTN_UNIT_ROWS=QB;
__device__ __forceinline__ int crow(int r,int hi){return (r&3)+8*(r>>2)+4*hi;}
#define SBAR() __builtin_amdgcn_sched_barrier(0)
__device__ __forceinline__ void cmask(f32x16&p0,f32x16&p1,int jb,int qrel,int hi){
  const float NEG=-INFINITY; int kb=64*jb+4*hi;
  #pragma unroll
  for(int r=0;r<16;++r){int kv=kb+(r&3)+8*(r>>2); if(kv>qrel)p0[r]=NEG; if(kv+32>qrel)p1[r]=NEG;}
}

constexpr int NSLOT=3, SLOTB=8192;
constexpr int LDS_K=0, LDS_V=NSLOT*SLOTB, LDS_WS=2*NSLOT*SLOTB, LDS_OST=LDS_WS+NW*64*4, LDS_BYTES=LDS_OST+NW*4096;
constexpr float C2=0.125f*1.4426950408889634f;
__device__ __forceinline__ void glds16(const void*gsrc,unsigned lds_dst){unsigned keep;
  asm volatile("s_mov_b32 %0, m0\n\ts_mov_b32 m0, %2\n\ts_nop 0\n\tglobal_load_lds_dwordx4 %1, off\n\ts_mov_b32 m0, %0":"=&s"(keep):"v"(gsrc),"s"(lds_dst):"memory");}
__device__ __forceinline__ float max3f(float a,float b,float c){float r;asm("v_max3_f32 %0, %1, %2, %3":"=v"(r):"v"(a),"v"(b),"v"(c));return r;}
__device__ __forceinline__ float max2f(float a,float b){float r;asm("v_max_f32_e32 %0, %1, %2":"=v"(r):"v"(a),"v"(b));return r;}
__device__ __forceinline__ float fadd_s(float a,float b){float r;asm("v_add_f32_e32 %0, %1, %2":"=v"(r):"v"(a),"v"(b));return r;}
__device__ __forceinline__ float fsub_s(float a,float b){float r;asm("v_sub_f32_e32 %0, %1, %2":"=v"(r):"v"(a),"v"(b));return r;}
typedef float f32x2_t __attribute__((ext_vector_type(2))); typedef __bf16 bf16x2_t __attribute__((ext_vector_type(2)));
__device__ __forceinline__ unsigned cvtpk_s(float lo,float hi){f32x2_t v={lo,hi};bf16x2_t b=__builtin_convertvector(v,bf16x2_t);return __builtin_bit_cast(unsigned,b);}
#define WAIT_BAR(N) asm volatile("s_waitcnt vmcnt(" #N ") lgkmcnt(0)\n\ts_barrier":::"memory")

__device__ __forceinline__ void qkt(f32x16&p0,f32x16&p1,const char*Kslot,const bf16x8*qr,const f32x16&negm,int r32,int hi){
  const char*kb=Kslot+hi*1024+r32*16;
  #pragma unroll
  for(int d0=0;d0<4;++d0){
    const bf16x8 b0=*reinterpret_cast<const bf16x8*>(kb+d0*2048);
    const bf16x8 b1=*reinterpret_cast<const bf16x8*>(kb+d0*2048+512);
    if(d0==0){p0=__builtin_amdgcn_mfma_f32_32x32x16_bf16(b0,qr[0],negm,0,0,0);p1=__builtin_amdgcn_mfma_f32_32x32x16_bf16(b1,qr[0],negm,0,0,0);}
    else{p0=__builtin_amdgcn_mfma_f32_32x32x16_bf16(b0,qr[d0],p0,0,0,0);p1=__builtin_amdgcn_mfma_f32_32x32x16_bf16(b1,qr[d0],p1,0,0,0);}}
}
typedef __attribute__((address_space(3))) const char* lds_cptr;
typedef short v4i16_t __attribute__((ext_vector_type(4)));
__device__ __forceinline__ void kload8(bf16x8*kf,lds_cptr kp){
  kf[0]=*(const __attribute__((address_space(3))) bf16x8*)(kp);      kf[1]=*(const __attribute__((address_space(3))) bf16x8*)(kp+512);
  kf[2]=*(const __attribute__((address_space(3))) bf16x8*)(kp+2048); kf[3]=*(const __attribute__((address_space(3))) bf16x8*)(kp+2560);
  kf[4]=*(const __attribute__((address_space(3))) bf16x8*)(kp+4096); kf[5]=*(const __attribute__((address_space(3))) bf16x8*)(kp+4608);
  kf[6]=*(const __attribute__((address_space(3))) bf16x8*)(kp+6144); kf[7]=*(const __attribute__((address_space(3))) bf16x8*)(kp+6656);
}
__device__ __forceinline__ void kload2(bf16x8*kf,lds_cptr kp,int j){ kf[2*j]=*(const __attribute__((address_space(3))) bf16x8*)(kp+j*2048); kf[2*j+1]=*(const __attribute__((address_space(3))) bf16x8*)(kp+j*2048+512); }
__device__ __forceinline__ s16x4 vtr(lds_cptr p){ return __builtin_bit_cast(s16x4,__builtin_amdgcn_ds_read_tr16_b64_v4i16((__attribute__((address_space(3))) v4i16_t*)p)); }
__device__ __forceinline__ float rowmax(const f32x16&p0,const f32x16&p1){
  float a=max3f(p0[0],p0[1],p1[0]),b=max3f(p0[2],p0[3],p1[1]);a=max3f(a,p1[2],p1[3]);
  #pragma unroll
  for(int r=4;r<16;r+=4){a=max3f(a,p0[r],p0[r+1]);b=max3f(b,p0[r+2],p0[r+3]);a=max3f(a,p1[r],p1[r+1]);b=max3f(b,p1[r+2],p1[r+3]);}
  const float m=max2f(a,b);
  auto rr=__builtin_amdgcn_permlane32_swap(__float_as_uint(m),__float_as_uint(m),false,false);
  return max2f(__uint_as_float(rr[0]),__uint_as_float(rr[1]));
}
__device__ __forceinline__ void pv(f32x16*o,int vb,bf16x8 pa0,bf16x8 pa1,bf16x8 pa2,bf16x8 pa3){
  #pragma unroll
  for(int d0=0;d0<2;++d0){s16x4 lo[4],hi[4];
    #pragma unroll
    for(int ks=0;ks<4;++ks){
      asm volatile("ds_read_b64_tr_b16 %0,%1 offset:%c2":"=&v"(lo[ks]):"v"(vb),"i"(d0*4096+ks*1024):"memory");
      asm volatile("ds_read_b64_tr_b16 %0,%1 offset:%c2":"=&v"(hi[ks]):"v"(vb),"i"(d0*4096+ks*1024+512):"memory");}
    asm volatile("s_waitcnt lgkmcnt(0)":::"memory");SBAR();
    #define PK(k) (bf16x8){lo[k][0],lo[k][1],lo[k][2],lo[k][3],hi[k][0],hi[k][1],hi[k][2],hi[k][3]}
    o[d0]=__builtin_amdgcn_mfma_f32_32x32x16_bf16(pa0,PK(0),o[d0],0,0,0);
    o[d0]=__builtin_amdgcn_mfma_f32_32x32x16_bf16(pa1,PK(1),o[d0],0,0,0);
    o[d0]=__builtin_amdgcn_mfma_f32_32x32x16_bf16(pa2,PK(2),o[d0],0,0,0);
    o[d0]=__builtin_amdgcn_mfma_f32_32x32x16_bf16(pa3,PK(3),o[d0],0,0,0);
    #undef PK
  }
}

#ifndef ATTN_STORE16
#define ATTN_STORE16(p,v) (*(u32x4*)(p)=(v))
#endif
template<int THRL> __device__ __forceinline__ void attn_unit(int b,int qcol,int vcol,int ocol,int qb,const bf16*Q,const bf16*__restrict__ K,const bf16*__restrict__ V,bf16*O,char*shm){
  int tid_=threadIdx.x; asm volatile("":"+v"(tid_)); const int tid=tid_,lane=tid&63,r32=lane&31,hi=lane>>5; const int wid=__builtin_amdgcn_readfirstlane(tid>>6);
  const long rowbase=(long)b*SEQ; const int q0=qb*QB;
  const bf16*Qw=Q+(rowbase+q0+wid*QBLK)*DM+qcol;
  const bf16*Kh=K+rowbase*DM+qcol,*Vh=V+rowbase*DM+vcol;
  const unsigned lds0=(unsigned)(uintptr_t)shm;
  float*wsf=(float*)(shm+LDS_WS)+wid*64;
  const bf16*ksrc=Kh+(long)lane*DM+wid*8;
  const bf16*vsrc=Vh+(long)(16*(wid&3)+(lane>>2))*DM+(wid>>2)*32+(lane&3)*8;
  const unsigned kdst=lds0+LDS_K+wid*1024, vdst=lds0+LDS_V+wid*1024;
  #define DMA_K(t,slot) glds16(ksrc+(long)(t)*KVBLK*DM,(unsigned)__builtin_amdgcn_readfirstlane(kdst+(slot)))
  #define DMA_V(t,slot) glds16(vsrc+(long)(t)*KVBLK*DM,(unsigned)__builtin_amdgcn_readfirstlane(vdst+(slot)))
  const int vb0=(int)(lds0+LDS_V)+((lane>>4)&1)*32+(lane&3)*8+(4*hi+((lane&15)>>2))*64;
  const char*Kbase=shm+LDS_K; bf16x8 kf[8];
  const lds_cptr shm3=(lds_cptr)shm; const lds_cptr kp0=shm3+LDS_K+hi*1024+r32*16; const lds_cptr vp0=shm3+LDS_V+((lane>>4)&1)*32+(lane&3)*8+(4*hi+((lane&15)>>2))*64;
  const int NT=(q0+QB)/KVBLK;
  DMA_K(0,0);DMA_V(0,0);DMA_K(1,SLOTB);
  bf16x8 qr[4];
  #pragma unroll
  for(int d0=0;d0<4;++d0)qr[d0]=*reinterpret_cast<const bf16x8*>(&Qw[(long)r32*DM+d0*16+hi*8]);
  float mhat=0.f,l_reg=0.f;f32x16 o[2];o[0]=f32x16{};o[1]=f32x16{};f32x16 negm=f32x16{};asm volatile("":"+v"(negm));
  const int qrel=wid*QBLK+r32;
  #define CMASK(P0,P1,t) do{int jb_=(t)-(NT-4); if(jb_>=0)cmask(P0,P1,jb_,qrel,hi);}while(0)
  bool resc=false;
  #define START(P0,P1) do{ const float rm=rowmax(P0,P1); resc=false; \
    { const float dl=rm; mhat=fadd_s(mhat,dl); \
      _Pragma("unroll") for(int r=0;r<16;++r){P0[r]=fsub_s(P0[r],dl);P1[r]=fsub_s(P1[r],dl);} \
      _Pragma("unroll") for(int r=0;r<16;++r)negm[r]=-mhat; asm volatile("":"+v"(negm)); } \
    _Pragma("unroll") for(int r=0;r<16;++r)P0[r]=__builtin_amdgcn_exp2f(P0[r]); }while(0)
  #define RESC() do{ if(resc){ asm volatile("s_waitcnt lgkmcnt(0)":::"memory"); \
      _Pragma("unroll") for(int d_=0;d_<2;++d_) _Pragma("unroll") for(int r=0;r<16;++r)o[d_][r]*=wsf[crow(r,hi)]; } }while(0)
  f32x16 pA0,pA1,pB0,pB1;
  int sl_prev=0,sl_cur=0,sl_next=SLOTB;
  #define ROT() do{sl_prev=sl_cur;sl_cur=sl_next;sl_next=(sl_next==(NSLOT-1)*SLOTB)?0:sl_next+SLOTB;}while(0)
  DMA_K(2,2*SLOTB);
  WAIT_BAR(3);
  qkt(pA0,pA1,Kbase,qr,negm,r32,hi);asm volatile("s_nop 15\n\ts_nop 7":"+v"(pA0),"+v"(pA1));CMASK(pA0,pA1,0);
  START(pA0,pA1);
  _Pragma("unroll") for(int r=0;r<16;++r)pA1[r]=__builtin_amdgcn_exp2f(pA1[r]);
  WAIT_BAR(0);
  DMA_K(3,0);DMA_V(1,SLOTB);
  ROT();
  kload8(kf,kp0+sl_cur);
  WAIT_BAR(2);
  s16x4 vlo[8],vhi[8]; u32x4 pw0,pw1,pw2,pw3;
  #define PKW(P,B) cvtpk_s(P[B],P[B+1])
  #define PAF(k) __builtin_bit_cast(bf16x8,pw##k)
  #define VFR(i) (bf16x8){vlo[i][0],vlo[i][1],vlo[i][2],vlo[i][3],vhi[i][0],vhi[i][1],vhi[i][2],vhi[i][3]}
  #define PIN(x) asm volatile("":"+v"(x))
  #define MX3(a,b,c) __builtin_fmaxf(__builtin_fmaxf((a),(b)),(c))
  #define GAPA(MF,A0,A1,A2,A3,W0,W1,PW) do{ MF; sacc+=A0; sacc+=A1; sacc+=A2; sacc+=A3; PIN(sacc); W0; W1; PIN(PW); SBAR(); }while(0)
  #define EX(v) __builtin_amdgcn_exp2f(v)
  #define GAPB(MF,X,B) do{ MF; X[B]=EX(X[B]); X[B+1]=EX(X[B+1]); X[B+2]=EX(X[B+2]); X[B+3]=EX(X[B+3]); PIN(X); SBAR(); }while(0)
  #define VRD(i) do{ vlo[i]=vtr(vp_+(((i)>>2)*4096+((i)&3)*1024)); vhi[i]=vtr(vp_+(((i)>>2)*4096+((i)&3)*1024+512)); }while(0)
  #define KRD(G,j) do{ if(G){ kload2(kf,kp0+sl_next,j); SBAR(); } }while(0)
  #define STEP(C0,C1,P0,P1,t,GK,GV,GL) do{ SBAR(); \
    const lds_cptr vp_=vp0+sl_prev; \
    VRD(0); SBAR(); float sacc=(P0[0]+P0[1]); \
    GAPA(C0=__builtin_amdgcn_mfma_f32_32x32x16_bf16(kf[0],qr[0],negm,0,0,0), P0[2],P0[3],P0[4],P0[5],     pw0[0]=PKW(P0,0), pw0[1]=PKW(P0,2), pw0); \
    VRD(4); SBAR(); GAPA(C1=__builtin_amdgcn_mfma_f32_32x32x16_bf16(kf[1],qr[0],negm,0,0,0), P0[6],P0[7],P0[8],P0[9],     pw0[2]=PKW(P0,4), pw0[3]=PKW(P0,6), pw0); \
    VRD(1); SBAR(); GAPA(C0=__builtin_amdgcn_mfma_f32_32x32x16_bf16(kf[2],qr[1],C0,0,0,0),   P0[10],P0[11],P0[12],P0[13], pw1[0]=PKW(P0,8), pw1[1]=PKW(P0,10), pw1); \
    VRD(5); SBAR(); GAPA(C1=__builtin_amdgcn_mfma_f32_32x32x16_bf16(kf[3],qr[1],C1,0,0,0),   P0[14],P0[15],P1[0],P1[1],   pw1[2]=PKW(P0,12),pw1[3]=PKW(P0,14), pw1); \
    VRD(2); SBAR(); GAPA(C0=__builtin_amdgcn_mfma_f32_32x32x16_bf16(kf[4],qr[2],C0,0,0,0),   P1[2],P1[3],P1[4],P1[5],     pw2[0]=PKW(P1,0), pw2[1]=PKW(P1,2), pw2); \
    VRD(6); SBAR(); GAPA(C1=__builtin_amdgcn_mfma_f32_32x32x16_bf16(kf[5],qr[2],C1,0,0,0),   P1[6],P1[7],P1[8],P1[9],     pw2[2]=PKW(P1,4), pw2[3]=PKW(P1,6), pw2); \
    VRD(3); SBAR(); GAPA(C0=__builtin_amdgcn_mfma_f32_32x32x16_bf16(kf[6],qr[3],C0,0,0,0),   P1[10],P1[11],P1[12],P1[13], pw3[0]=PKW(P1,8), pw3[1]=PKW(P1,10), pw3); \
    VRD(7); SBAR(); GAPA(C1=__builtin_amdgcn_mfma_f32_32x32x16_bf16(kf[7],qr[3],C1,0,0,0),   P1[14],P1[15],0.f,0.f,       pw3[2]=PKW(P1,12),pw3[3]=PKW(P1,14), pw3); \
    l_reg+=sacc; \
    if(GK){DMA_K((t)+3,sl_cur);} if(GV){DMA_V((t)+1,sl_next);} \
    CMASK(C0,C1,t); \
    { float a=MX3(C0[0],C0[1],C1[0]),b=MX3(C0[2],C0[3],C1[1]); a=MX3(a,C1[2],C1[3]); \
      _Pragma("unroll") for(int r=4;r<16;r+=4){a=MX3(a,C0[r],C0[r+1]);b=MX3(b,C0[r+2],C0[r+3]);a=MX3(a,C1[r],C1[r+1]);b=MX3(b,C1[r+2],C1[r+3]);} \
      float rm=__builtin_fmaxf(a,b); { auto rr=__builtin_amdgcn_permlane32_swap(__float_as_uint(rm),__float_as_uint(rm),false,false); rm=__builtin_fmaxf(__uint_as_float(rr[0]),__uint_as_float(rr[1])); } \
      resc=false; \
      if(__builtin_expect(__any(rm>(float)THRL),0)){ const float dl=__builtin_fmaxf(rm,0.f); mhat+=dl; \
        _Pragma("unroll") for(int r=0;r<16;++r){C0[r]-=dl;C1[r]-=dl;} \
        _Pragma("unroll") for(int r=0;r<16;++r)negm[r]=-mhat; asm volatile("":"+v"(negm)); \
        const float f=__builtin_amdgcn_exp2f(-dl); l_reg*=f; if(hi==0)wsf[r32]=f; resc=true; } } \
    SBAR(); \
    GAPB(o[0]=__builtin_amdgcn_mfma_f32_32x32x16_bf16(PAF(0),VFR(0),o[0],0,0,0), C0,0); \
    GAPB(o[1]=__builtin_amdgcn_mfma_f32_32x32x16_bf16(PAF(0),VFR(4),o[1],0,0,0), C0,4); \
    KRD(GL,0); GAPB(o[0]=__builtin_amdgcn_mfma_f32_32x32x16_bf16(PAF(1),VFR(1),o[0],0,0,0), C0,8); \
    KRD(GL,1); GAPB(o[1]=__builtin_amdgcn_mfma_f32_32x32x16_bf16(PAF(1),VFR(5),o[1],0,0,0), C0,12); \
    KRD(GL,2); GAPB(o[0]=__builtin_amdgcn_mfma_f32_32x32x16_bf16(PAF(2),VFR(2),o[0],0,0,0), C1,0); \
    KRD(GL,3); GAPB(o[1]=__builtin_amdgcn_mfma_f32_32x32x16_bf16(PAF(2),VFR(6),o[1],0,0,0), C1,4); \
    GAPB(o[0]=__builtin_amdgcn_mfma_f32_32x32x16_bf16(PAF(3),VFR(3),o[0],0,0,0), C1,8); \
    GAPB(o[1]=__builtin_amdgcn_mfma_f32_32x32x16_bf16(PAF(3),VFR(7),o[1],0,0,0), C1,12); \
    }while(0)
  int t=1;
  #undef CMASK
  #define CMASK(P0,P1,t) do{}while(0)
  for(;t+5<NT;t+=2){
    STEP(pB0,pB1,pA0,pA1,t,true,true,true);     WAIT_BAR(2); RESC(); ROT();
    STEP(pA0,pA1,pB0,pB1,t+1,true,true,true);   WAIT_BAR(2); RESC(); ROT();
  }
  #undef CMASK
  #define CMASK(P0,P1,t) do{int jb_=(t)-(NT-4); if(jb_>=0)cmask(P0,P1,jb_,qrel,hi);}while(0)
  #define ENDW(tt) do{ if((tt)+3<NT){WAIT_BAR(2);} else if((tt)+2<NT){WAIT_BAR(1);} else {WAIT_BAR(0);} }while(0)
  for(;t+1<NT;t+=2){
    STEP(pB0,pB1,pA0,pA1,t,(t+3<NT),(t+1<NT),(t+1<NT));       ENDW(t);   RESC(); ROT();
    STEP(pA0,pA1,pB0,pB1,t+1,(t+4<NT),(t+2<NT),(t+2<NT));     ENDW(t+1); RESC(); ROT();
  }
  STEP(pB0,pB1,pA0,pA1,NT-1,false,false,false); RESC();
  { float sacc=pB0[0]+pB0[1]; _Pragma("unroll") for(int r=2;r<16;++r)sacc+=pB0[r]; _Pragma("unroll") for(int r=0;r<16;++r)sacc+=pB1[r]; l_reg+=sacc;
    pw0=(u32x4){PKW(pB0,0),PKW(pB0,2),PKW(pB0,4),PKW(pB0,6)};pw1=(u32x4){PKW(pB0,8),PKW(pB0,10),PKW(pB0,12),PKW(pB0,14)};pw2=(u32x4){PKW(pB1,0),PKW(pB1,2),PKW(pB1,4),PKW(pB1,6)};pw3=(u32x4){PKW(pB1,8),PKW(pB1,10),PKW(pB1,12),PKW(pB1,14)};
    SBAR(); pv(o,vb0+sl_cur,PAF(0),PAF(1),PAF(2),PAF(3)); }
  #undef PKW
  #undef PAF
  #undef VFR
  #undef PIN
  #undef MX3
  #undef GAPA
  #undef GAPB
  #undef EX
  #undef VRD
  #undef KRD
  #undef STEP
  #undef ENDW
  {auto rr=__builtin_amdgcn_permlane32_swap(__float_as_uint(l_reg),__float_as_uint(l_reg),false,false);l_reg=__uint_as_float(rr[0])+__uint_as_float(rr[1]);}
  if(hi==0)wsf[32+r32]=l_reg;asm volatile("s_waitcnt lgkmcnt(0)":::"memory");
  float rli[16];
  #pragma unroll
  for(int r=0;r<16;++r)rli[r]=__builtin_amdgcn_rcpf(wsf[32+crow(r,hi)]);
  bf16*Ow=O+(rowbase+q0+wid*QBLK)*OP+ocol;
  { bf16*stg=(bf16*)(shm+LDS_OST)+wid*2048;
    #pragma unroll
    for(int r=0;r<16;++r){const int orow=crow(r,hi);
      #pragma unroll
      for(int d0=0;d0<2;++d0)stg[orow*64+d0*32+r32]=__float2bfloat16(o[d0][r]*rli[r]);}
    asm volatile("s_waitcnt lgkmcnt(0)":::"memory");
    #pragma unroll
    for(int i=0;i<4;++i){const int row=i*8+(lane>>3),ch=lane&7; const u32x4 v=*(const u32x4*)(stg+row*64+ch*8); ATTN_STORE16(Ow+(long)row*OP+ch*8,v);} }
  asm volatile("s_waitcnt lgkmcnt(0)\n\ts_barrier":::"memory");
  #undef DMA_K
  #undef DMA_V
  #undef CMASK
  #undef START
  #undef RESC
  #undef ROT
}
constexpr int ATTN_LDS_BYTES=LDS_BYTES;
struct AttnTensors { const bf16* Q; const bf16* K; const bf16* V; bf16* O; };
struct AttnUnit { int b, qcol, vcol, ocol, qb; };
template<int THRL=8> __device__ __forceinline__ void attn_phase(char*lds,const AttnTensors&T,int vcu,int G){
  for(int su=vcu;su<256;su+=G){ const int b=su>>4,h=(su>>1)&7,c=su&1;
    for(int i=0;i<16;++i){ const int half=i>>3,qb=7-(i&7);
      attn_unit<THRL>(b,(h*2+c)*64,h*128+half*64,c*1024+h*128+half*64,qb,T.Q,T.K,T.V,T.O,lds); } }
}
#undef SBAR
#undef WAIT_BAR
}
constexpr int NWAVES = 8;
constexpr int BATCH = 16, SEQ = 2048, DM_ = 1024, M = BATCH * SEQ, DFF = 2816, DEPTH = 4;
constexpr int PL = 4608;
constexpr int OFF_Z = 0, OFF_GATE = 1024, OFF_XA = 2048, OFF_B = 3072, OFF_C = 3328, OFF_XB = 3584;
constexpr float EPS = 1e-6f;
constexpr size_t MiB = 1u << 20;
constexpr size_t WS_ROWSS = 1 * MiB;
constexpr size_t WS_GSS = 5 * MiB;
constexpr size_t WS_ROPE = 7 * MiB;
constexpr size_t WS_DT = 7 * MiB + 512 * 1024;
constexpr size_t WS_WB = 10 * MiB;
constexpr size_t WB_GU1 = 0, WB_D1 = 11 * MiB, WB_GU2 = WB_D1 + 5 * MiB + 512 * 1024, WB_D2 = WB_GU2 + 11 * MiB, WB_MI = WB_D2 + 5 * MiB + 512 * 1024, WB_MO = WB_MI + 9 * MiB + 512 * 1024;
static_assert(WB_MO + 4 * MiB <= 48 * MiB, "weights");
constexpr size_t WS_HB = 58 * MiB;
constexpr size_t WS_BIG = 122 * MiB;
constexpr size_t WS_LO = 442 * MiB;
constexpr size_t WS_END = 474 * MiB;
constexpr int LDS_BYTES = 163840;

#define GAS __attribute__((address_space(1)))
#define LAS __attribute__((address_space(3)))
typedef unsigned short bf16;
typedef unsigned v4u __attribute__((ext_vector_type(4)));
typedef unsigned v2u __attribute__((ext_vector_type(2)));
typedef float f32x4 __attribute__((ext_vector_type(4)));
typedef short bf16x8 __attribute__((ext_vector_type(8)));
#define LDS_WAIT() asm volatile("s_waitcnt lgkmcnt(0)" ::: "memory")
__device__ __forceinline__ unsigned pk2(float lo, float hi) { return pg8::cvt_pk_bf16(lo, hi); }
__device__ __forceinline__ float bflo(unsigned w) { return __uint_as_float(w << 16); }
__device__ __forceinline__ float bfhi(unsigned w) { return __uint_as_float(w & 0xffff0000u); }
__device__ __forceinline__ float bf1(bf16 v) { return __uint_as_float((unsigned)v << 16); }
__device__ __forceinline__ float wave_sum(float v) {
#pragma unroll
    for (int o = 1; o < 64; o <<= 1) v += __shfl_xor(v, o);
    return v;
}
__device__ __forceinline__ float silu_f(float x) { return x * __builtin_amdgcn_rcpf(1.0f + __expf(-x)); }
__device__ __forceinline__ float sigmoid_f(float x) { return __builtin_amdgcn_rcpf(1.0f + __expf(-x)); }

struct Args { const float* in[33]; float* out; unsigned char* ws; };
struct FromArgs { const Args& a; __device__ __forceinline__ const float* operator()(int i) const { return a.in[i]; } };
struct FromTab { const float* const* t; __device__ __forceinline__ const float* operator()(int i) const { return t[i]; } };
constexpr size_t WS_TAB = 512 * 1024;

__device__ __forceinline__ void cvt_item(const float* W, int K, int Nsrc, int c0, int ncols, bf16* WT, int drow0, int mode, const float* kscale, LAS float* scr, int item, int lane) {
    const int nblk = (ncols + 63) / 64, kb = item / nblk, nb = item % nblk, k0 = 64 * kb, n0 = 64 * nb;
    const int l16 = lane & 15, kr = lane >> 4; const bool cok = (n0 + 4 * l16) < ncols;
    const float* src = W + (size_t)(k0 + kr) * Nsrc + c0 + n0 + 4 * l16;
    f32x4 v[16];
#pragma unroll
    for (int i = 0; i < 16; ++i) v[i] = cok ? __builtin_nontemporal_load((const f32x4*)(src + (size_t)(4 * i) * Nsrc)) : (f32x4){0.f, 0.f, 0.f, 0.f};
    const int c = lane & 7;
    f32x4 ks0 = {1.f, 1.f, 1.f, 1.f}, ks1 = ks0;
    if (kscale) { ks0 = *(const f32x4*)(kscale + k0 + 8 * c); ks1 = *(const f32x4*)(kscale + k0 + 8 * c + 4); }
#pragma unroll
    for (int i = 0; i < 16; ++i) { LAS float* d = scr + (4 * i + kr) * 65 + 4 * l16; d[0] = v[i][0]; d[1] = v[i][1]; d[2] = v[i][2]; d[3] = v[i][3]; }
    LDS_WAIT(); asm volatile("" ::: "memory");
    const int dbase = (mode == 0) ? (drow0 + n0) : ((n0 >> 7) * 256 + (n0 & 127) + (mode == 2 ? 128 : 0));
#pragma unroll
    for (int jj = 0; jj < 8; ++jj) { const int n = (lane >> 3) + 8 * jj; const LAS float* sp = scr + (8 * c) * 65 + n;
        v4u o; o.x = pk2(sp[0 * 65] * ks0[0], sp[1 * 65] * ks0[1]); o.y = pk2(sp[2 * 65] * ks0[2], sp[3 * 65] * ks0[3]); o.z = pk2(sp[4 * 65] * ks1[0], sp[5 * 65] * ks1[1]); o.w = pk2(sp[6 * 65] * ks1[2], sp[7 * 65] * ks1[3]);
        if (n0 + n < ncols) *(v4u*)(WT + (size_t)(dbase + n) * K + k0 + 8 * c) = o; }
    LDS_WAIT(); asm volatile("" ::: "memory");
}
#define CVT_SEC(W, K, Nsrc, c0, ncols, WT, drow0, mode, ksc) { const int cnt_ = ((K) / 64) * (((ncols) + 63) / 64); if (r < cnt_) { cvt_item(W, K, Nsrc, c0, ncols, WT, drow0, mode, ksc, scr, r, lane); continue; } r -= cnt_; }
template <class PS> __device__ __forceinline__ void convert_layer(const PS& P, unsigned char* wsb, int l, LAS unsigned char* lds, int gw, int NGW, int wave, int lane) {
    LAS float* scr = (LAS float*)(lds + wave * 16896);
    unsigned char* wb = wsb + WS_WB; const int j = l >> 1;
    const size_t FW = (size_t)1024 * 2816;
    const float* g1 = P(2) + l * FW; const float* u1 = P(3) + l * FW; const float* d1 = P(4) + l * FW;
    const float* g2 = P(7) + l * FW; const float* u2 = P(8) + l * FW; const float* d2 = P(9) + l * FW;
    const float* n1 = P(1) + l * 1024; const float* nm = P(5) + l * 1024; const float* n2 = P(6) + l * 1024;
    const float* win = P(10) + (size_t)j * 1024 * 4624; const float* wout = P(24) + (size_t)j * 2048 * 1024;
    const float* wqkv = P(25) + (size_t)j * 1024 * 3072; const float* wo = P(31) + (size_t)j * 1024 * 1024;
    bf16* GU1 = (bf16*)(wb + WB_GU1); bf16* D1 = (bf16*)(wb + WB_D1); bf16* GU2 = (bf16*)(wb + WB_GU2); bf16* D2 = (bf16*)(wb + WB_D2); bf16* MI = (bf16*)(wb + WB_MI); bf16* MO = (bf16*)(wb + WB_MO);
    const bool even = (l & 1) == 0;
    for (int it = gw; ; it += NGW) {
        int r = it;
        CVT_SEC(g1, 1024, 2816, 0, 2816, GU1, 0, 1, n1)
        CVT_SEC(u1, 1024, 2816, 0, 2816, GU1, 0, 2, n1)
        CVT_SEC(d1, 2816, 1024, 0, 1024, D1, 0, 0, nullptr)
        CVT_SEC(g2, 1024, 2816, 0, 2816, GU2, 0, 1, n2)
        CVT_SEC(u2, 1024, 2816, 0, 2816, GU2, 0, 2, n2)
        CVT_SEC(d2, 2816, 1024, 0, 1024, D2, 0, 0, nullptr)
        if (even) {
            CVT_SEC(win, 1024, 4624, 0, 1024, MI, 0, 0, nm)
            CVT_SEC(win, 1024, 4624, 1024, 1536, MI, 2048, 0, nm)
            CVT_SEC(win, 1024, 4624, 2560, 16, MI, 4608, 0, nm)
            CVT_SEC(win, 1024, 4624, 2576, 1024, MI, 1024, 0, nm)
            CVT_SEC(win, 1024, 4624, 3600, 1024, MI, 3584, 0, nm)
            CVT_SEC(wout, 2048, 1024, 0, 1024, MO, 0, 0, nullptr)
        } else {
            CVT_SEC(wqkv, 1024, 3072, 0, 3072, MI, 0, 0, nm)
            CVT_SEC(wo, 1024, 1024, 0, 1024, MO, 0, 0, nullptr)
        }
        break;
    }
}
__device__ __forceinline__ void prologue(const Args& a, LAS unsigned char* lds, int gw, int NGW, int wave, int lane, int gtid, int NGT) {
    float* rowss = (float*)(a.ws + WS_ROWSS); bf16* HB = (bf16*)(a.ws + WS_HB);
    for (int m = gw; m < M; m += NGW) {
        const f32x4* xr = (const f32x4*)(a.in[0] + (size_t)m * 1024) + lane; v2u* hb = (v2u*)(HB + (size_t)m * 1024) + lane;
        float s = 0.f;
#pragma unroll
        for (int j = 0; j < 4; ++j) { const f32x4 v = __builtin_nontemporal_load(xr + 64 * j); s += (v.x * v.x + v.y * v.y) + (v.z * v.z + v.w * v.w);
#if RESID_LO
            const unsigned e0 = pg8::EpiResid::enc(v.x), e1 = pg8::EpiResid::enc(v.y), e2 = pg8::EpiResid::enc(v.z), e3 = pg8::EpiResid::enc(v.w);
            v2u w; w.x = (e0 >> 16) | (e1 & 0xffff0000u); w.y = (e2 >> 16) | (e3 & 0xffff0000u); hb[64 * j] = w;
            const unsigned n4 = ((e0 >> 12) & 0xfu) | ((e1 >> 8) & 0xf0u) | ((e2 >> 4) & 0xf00u) | (e3 & 0xf000u);
            const unsigned nn = __shfl_xor(n4, 1);
            if ((lane & 1) == 0) ((unsigned*)(a.ws + WS_LO))[(size_t)m * 128 + ((lane + 64 * j) >> 1)] = n4 | (nn << 16);
#else
            v2u w; w.x = pk2(v.x, v.y); w.y = pk2(v.z, v.w); hb[64 * j] = w;
#endif
        }
        s = wave_sum(s); if (lane < 16) rowss[(size_t)m * 16 + lane] = (lane == 0) ? s : 0.f;
    }
    { float* rope = (float*)(a.ws + WS_ROPE);
      for (int i = gtid; i < 2048 * 8; i += NGT) { const int t = i >> 3, k = i & 7; const float inv = exp2f(-(float)k * (18.931568569324174f / 8.0f)); const float ang = (float)t * inv;
          float rev = ang * 0.15915494309189535f; rev -= floorf(rev); rope[t * 16 + k] = __builtin_amdgcn_cosf(rev); rope[t * 16 + 8 + k] = __builtin_amdgcn_sinf(rev); } }
    if (threadIdx.x == 0) { const float** tab = (const float**)(a.ws + WS_TAB);
#pragma unroll
        for (int i = 0; i < 33; ++i) tab[i] = a.in[i];
        tab[33] = a.out; }
    convert_layer(FromArgs{a}, a.ws, 0, lds, gw, NGW, wave, lane);
}

#define WG_BAR() do { asm volatile("s_waitcnt lgkmcnt(0)" ::: "memory"); __builtin_amdgcn_s_barrier(); asm volatile("" ::: "memory"); } while (0)
#define MFMA16(a, b, c) __builtin_amdgcn_mfma_f32_16x16x32_bf16(a, b, c, 0, 0, 0)
#define LDF(off) (*(const LAS bf16x8*)(lds + (off)))
constexpr int P2 = 272;
constexpr int L_C = 0, L_B = 34816, L_BWT = 69632, L_XT = 104448, L_S = 121856, L_CSALL = 139264  , L_DTALL = 147456  ;
__device__ __forceinline__ void unpack8(const v4u r, float (&f)[8]) { f[0] = bflo(r.x); f[1] = bfhi(r.x); f[2] = bflo(r.y); f[3] = bfhi(r.y); f[4] = bflo(r.z); f[5] = bfhi(r.z); f[6] = bflo(r.w); f[7] = bfhi(r.w); }

constexpr size_t BC2_OFF = (size_t)M * PL;
__device__ __forceinline__ void bc_preconv_pass(bf16* BIG, const float* cw, const float* cb, int gtid, int NGT) {
    const int cg = gtid & 63, ch = 1024 + cg * 8;
    float w[4][8], bias[8];
#pragma unroll
    for (int k = 0; k < 4; ++k) { const f32x4 wa = *(const f32x4*)(cw + k * 1536 + ch), wb = *(const f32x4*)(cw + k * 1536 + ch + 4);
        w[k][0] = wa.x; w[k][1] = wa.y; w[k][2] = wa.z; w[k][3] = wa.w; w[k][4] = wb.x; w[k][5] = wb.y; w[k][6] = wb.z; w[k][7] = wb.w; }
    { const f32x4 ba = *(const f32x4*)(cb + ch), bb = *(const f32x4*)(cb + ch + 4); bias[0] = ba.x; bias[1] = ba.y; bias[2] = ba.z; bias[3] = ba.w; bias[4] = bb.x; bias[5] = bb.y; bias[6] = bb.z; bias[7] = bb.w; }
    if ((NGT & 63) != 0) return;
    for (int it = gtid; it < 64 * 4096; it += NGT) { const int strip = it >> 6; const int r0 = strip * 8, tb = r0 & (SEQ - 1);
        v4u raw[11];
#pragma unroll
        for (int s = 0; s < 11; ++s) { const bool ok = (tb + s - 3 >= 0); const v4u t_ = __builtin_nontemporal_load((const GAS v4u*)(BIG + (size_t)(ok ? r0 + s - 3 : r0) * PL + OFF_B + cg * 8)); const unsigned mk = ok ? 0xffffffffu : 0u; raw[s] = (v4u){t_.x & mk, t_.y & mk, t_.z & mk, t_.w & mk}; }
#pragma unroll
        for (int s = 0; s < 8; ++s) { float val[8];
#pragma unroll
            for (int c = 0; c < 8; ++c) val[c] = bias[c];
#pragma unroll
            for (int k = 0; k < 4; ++k) { float f[8]; unpack8(raw[s + k], f);
#pragma unroll
                for (int c = 0; c < 8; ++c) val[c] += w[k][c] * f[c]; }
#pragma unroll
            for (int c = 0; c < 8; ++c) val[c] = silu_f(val[c]);
            v4u o; o.x = pk2(val[0], val[1]); o.y = pk2(val[2], val[3]); o.z = pk2(val[4], val[5]); o.w = pk2(val[6], val[7]);
            *(GAS v4u*)(BIG + BC2_OFF + (size_t)(r0 + s) * 512 + cg * 8) = o; }
    }
}
__device__ __forceinline__ void ssd_unit(LAS unsigned char* lds, int b, int h, int j, unsigned char* ws, const bool DRY) {
    int tid_ = threadIdx.x; asm volatile("" : "+v"(tid_));
    const int tid = tid_, wid = __builtin_amdgcn_readfirstlane(tid >> 6), lane = tid & 63, fr = lane & 15, fq = lane >> 4;
    const int g = h >> 3;
    { unsigned zz = 0u; asm volatile("" : "+v"(zz)); for (int i = tid; i < 17408 / 16; i += 512) *(LAS v4u*)(lds + L_S + i * 16) = (v4u){zz, zz, zz, zz}; }
    f32x4 S[4];
#pragma unroll
    for (int i = 0; i < 4; ++i) S[i] = (f32x4){0.f, 0.f, 0.f, 0.f};
    const int p0 = (wid & 3) * 16, n0 = (wid >> 2) * 64;
    const int xcg8 = tid & 7, xts = tid >> 3;
    float dt_bias, a_h, d_h; { const float* const* tab0 = (const float* const*)(ws + WS_TAB); dt_bias = tab0[13][j * 16 + h]; a_h = -__expf(tab0[14][j * 16 + h]); d_h = tab0[15][j * 16 + h]; }
    float xw[4][8], xbias[8];
    { const float* const* tab0 = (const float* const*)(ws + WS_TAB); const float* cw = tab0[11] + (size_t)j * 4 * 1536; const float* cb = tab0[12] + (size_t)j * 1536; const int ch = h * 64 + xcg8 * 8;
#pragma unroll
      for (int k = 0; k < 4; ++k) { const f32x4 wa = *(const f32x4*)(cw + k * 1536 + ch), wb = *(const f32x4*)(cw + k * 1536 + ch + 4);
          xw[k][0] = wa.x; xw[k][1] = wa.y; xw[k][2] = wa.z; xw[k][3] = wa.w; xw[k][4] = wb.x; xw[k][5] = wb.y; xw[k][6] = wb.z; xw[k][7] = wb.w; }
      const f32x4 ba = *(const f32x4*)(cb + ch), bb = *(const f32x4*)(cb + ch + 4); xbias[0] = ba.x; xbias[1] = ba.y; xbias[2] = ba.z; xbias[3] = ba.w; xbias[4] = bb.x; xbias[5] = bb.y; xbias[6] = bb.z; xbias[7] = bb.w; }
    {
        const GAS float* dtp = (const GAS float*)(ws + WS_DT) + ((size_t)b * SEQ + 4 * tid) * 16 + h;
        float d[4], p[4];
#pragma unroll
        for (int i = 0; i < 4; ++i) { const float x = dtp[i * 16] + dt_bias; d[i] = x > 20.f ? x : log1pf(__expf(x)); }
        p[0] = d[0] * a_h; p[1] = p[0] + d[1] * a_h; p[2] = p[1] + d[2] * a_h; p[3] = p[2] + d[3] * a_h;
        float sc = p[3];
#pragma unroll
        for (int o = 1; o < 32; o <<= 1) { const float v = __shfl_up(sc, o); if ((lane & 31) >= o) sc += v; }
        const float ex = sc - p[3];
        *(LAS f32x4*)(lds + L_CSALL + tid * 16) = (f32x4){ex + p[0], ex + p[1], ex + p[2], ex + p[3]}; *(LAS f32x4*)(lds + L_DTALL + tid * 16) = (f32x4){d[0], d[1], d[2], d[3]};
    }
    WG_BAR();
    for (int chunk = 0; chunk < 16; ++chunk) {
        const int t0 = chunk * 128; const size_t row0 = (size_t)b * SEQ + t0;
        unsigned char* wsl = ws; asm volatile("" : "+s"(wsl));
        bf16* proj = (bf16*)(wsl + WS_BIG); const float* const* tab = (const float* const*)(wsl + WS_TAB);
        const LAS float* csA = (const LAS float*)(lds + L_CSALL) + t0; const LAS float* dtA = (const LAS float*)(lds + L_DTALL) + t0;
        {
            int tl = tid; asm volatile("" : "+v"(tl)); const int cgp = tl & 31, ts = tl >> 5; const bool isB = cgp < 16;
            const bf16* src = proj + BC2_OFF + (row0 + 8 * ts) * 512 + (isB ? 0 : 256) + g * 128 + (cgp & 15) * 8;
            v4u raw[8];
#pragma unroll
            for (int s = 0; s < 8; ++s) raw[s] = *(const GAS v4u*)(src + (size_t)s * 512);
#pragma unroll
            for (int s = 0; s < 8; ++s) *(LAS v4u*)(lds + (isB ? L_B : L_C) + (8 * ts + s) * P2 + (cgp & 15) * 16) = raw[s];
            if (isB) {
                float val[8][8], wj[8];
#pragma unroll
                for (int s = 0; s < 8; ++s) { unpack8(raw[s], val[s]); wj[s] = dtA[8 * ts + s] * __expf(csA[127] - csA[8 * ts + s]); }
#pragma unroll
                for (int c = 0; c < 8; ++c) { v4u o; o.x = pk2(val[0][c] * wj[0], val[1][c] * wj[1]); o.y = pk2(val[2][c] * wj[2], val[3][c] * wj[3]); o.z = pk2(val[4][c] * wj[4], val[5][c] * wj[5]); o.w = pk2(val[6][c] * wj[6], val[7][c] * wj[7]);
                    *(LAS v4u*)(lds + L_BWT + ((cgp & 15) * 8 + c) * P2 + (8 * ts) * 2) = o; }
            }
        }
        {
            const int cg8 = xcg8, ts = xts, col = OFF_XA + h * 64 + cg8 * 8;
            v4u raw[5];
#pragma unroll
            for (int s = 0; s < 5; ++s) { const int t = t0 + 2 * ts + s - 3; const v4u t_ = *(const GAS v4u*)(proj + ((size_t)b * SEQ + (t >= 0 ? t : 0)) * PL + col); const unsigned mk = (t >= 0) ? 0xffffffffu : 0u; raw[s] = (v4u){t_.x & mk, t_.y & mk, t_.z & mk, t_.w & mk}; }
            float val[2][8];
#pragma unroll
            for (int s = 0; s < 2; ++s) {
#pragma unroll
                for (int c = 0; c < 8; ++c) val[s][c] = xbias[c];
#pragma unroll
                for (int k = 0; k < 4; ++k) { float f[8]; unpack8(raw[s + k], f);
#pragma unroll
                    for (int c = 0; c < 8; ++c) val[s][c] += xw[k][c] * f[c]; }
#pragma unroll
                for (int c = 0; c < 8; ++c) val[s][c] = silu_f(val[s][c]);
            }
#pragma unroll
            for (int c = 0; c < 8; ++c) *(LAS unsigned*)(lds + L_XT + (cg8 * 8 + c) * P2 + (2 * ts) * 2) = pk2(val[0][c], val[1][c]);
        }
        WG_BAR();
        const int irow = 16 * wid + fr;
        v2u zr[4];
#pragma unroll
        for (int pt = 0; pt < 4; ++pt) zr[pt] = *(const GAS v2u*)(proj + (row0 + irow) * PL + OFF_Z + h * 64 + 16 * pt + 4 * fq);
        f32x4 cbv[8], yo[4];
#pragma unroll
        for (int i = 0; i < 8; ++i) cbv[i] = (f32x4){0.f, 0.f, 0.f, 0.f};
#pragma unroll
        for (int i = 0; i < 4; ++i) yo[i] = (f32x4){0.f, 0.f, 0.f, 0.f};
        { const float cd = __expf(csA[127]);
#pragma unroll
          for (int i = 0; i < 4; ++i) S[i] = S[i] * cd; }
#pragma unroll
        for (int kk = 0; kk < 4; ++kk) {
            const bf16x8 cf = LDF(L_C + irow * P2 + kk * 64 + fq * 16);
#pragma unroll
            for (int jt = 0; jt < 8; ++jt) if (jt <= wid) cbv[jt] = MFMA16(LDF(L_B + (16 * jt + fr) * P2 + kk * 64 + fq * 16), cf, cbv[jt]);
#pragma unroll
            for (int pt = 0; pt < 4; ++pt) yo[pt] = MFMA16(LDF(L_S + (16 * pt + fr) * P2 + kk * 64 + fq * 16), cf, yo[pt]);
            const bf16x8 xf = LDF(L_XT + (p0 + fr) * P2 + kk * 64 + fq * 16);
#pragma unroll
            for (int nt = 0; nt < 4; ++nt) S[nt] = MFMA16(LDF(L_BWT + (n0 + 16 * nt + fr) * P2 + kk * 64 + fq * 16), xf, S[nt]);
        }
        WG_BAR();
        const float csi = csA[irow];
#pragma unroll
        for (int jt = 0; jt < 8; ++jt) { const int j0 = 16 * jt + 4 * fq; v2u o = {0u, 0u};
            if (jt <= wid) { const f32x4 csj = *(const LAS f32x4*)(csA + j0), dtj = *(const LAS f32x4*)(dtA + j0); float gv[4];
#pragma unroll
                for (int r = 0; r < 4; ++r) gv[r] = (j0 + r <= irow) ? cbv[jt][r] * __expf(csi - csj[r]) * dtj[r] : 0.f;
                o.x = pk2(gv[0], gv[1]); o.y = pk2(gv[2], gv[3]); }
            *(LAS v2u*)(lds + L_B + irow * P2 + j0 * 2) = o; }
#pragma unroll
        for (int nt = 0; nt < 4; ++nt) { v2u o; o.x = pk2(S[nt][0], S[nt][1]); o.y = pk2(S[nt][2], S[nt][3]); *(LAS v2u*)(lds + L_S + (p0 + fr) * P2 + (n0 + 16 * nt + 4 * fq) * 2) = o; }
        WG_BAR();
        { const float ei = __expf(csi); f32x4 y[4]; float* gss = (float*)(wsl + WS_GSS);
#pragma unroll
          for (int pt = 0; pt < 4; ++pt) y[pt] = yo[pt] * ei;
#pragma unroll
          for (int kk = 0; kk < 4; ++kk) { const bf16x8 gf = LDF(L_B + irow * P2 + kk * 64 + fq * 16);
#pragma unroll
              for (int pt = 0; pt < 4; ++pt) y[pt] = MFMA16(LDF(L_XT + (16 * pt + fr) * P2 + kk * 64 + fq * 16), gf, y[pt]); }
          float ss = 0.f;
#pragma unroll
          for (int pt = 0; pt < 4; ++pt) { float o[4]; const float zf[4] = {bflo(zr[pt].x), bfhi(zr[pt].x), bflo(zr[pt].y), bfhi(zr[pt].y)};
#pragma unroll
              for (int r = 0; r < 4; ++r) { const int p = 16 * pt + 4 * fq + r; const float xv = bf1(*(const LAS bf16*)(lds + L_XT + p * P2 + irow * 2));
                  const float yv = (y[pt][r] + d_h * xv) * silu_f(zf[r]); o[r] = yv; ss += yv * yv; }
              v2u w; w.x = pk2(o[0], o[1]); w.y = pk2(o[2], o[3]); if (!DRY) *(GAS v2u*)(proj + (row0 + irow) * PL + OFF_Z + h * 64 + 16 * pt + 4 * fq) = w; }
          ss += __shfl_xor(ss, 16); ss += __shfl_xor(ss, 32);
          if (fq == 0 && !DRY) ((GAS float*)gss)[(row0 + irow) * 16 + h] = ss; }
        WG_BAR();
    }
}
constexpr int P1 = 144;
constexpr int L_WRA = 0, L_WIX = 9216, L_XBM = 18432, L_AS = 36864, L_US = 71680, L_SEGA = 106496, L_SEGH = 108544, L_CARRY = 110592;
__device__ __forceinline__ void lru_unit(LAS unsigned char* lds, int b, int blk, int j, unsigned char* ws, const bool DRY) {
    int tid_ = threadIdx.x; asm volatile("" : "+v"(tid_));
    const int tid = tid_, wid = __builtin_amdgcn_readfirstlane(tid >> 6), lane = tid & 63, fr = lane & 15, fq = lane >> 4;
    const int cbase = blk * 64;
    const float* const* tab = (const float* const*)(ws + WS_TAB);
    const float* cw = tab[17] + (size_t)j * 4 * 1024; const float* cb = tab[18] + (size_t)j * 1024; const float* wra = tab[19] + ((size_t)j * 16 + blk) * 4096; const float* wix = tab[21] + ((size_t)j * 16 + blk) * 4096;
    const float* bra = tab[20] + (size_t)j * 1024; const float* bix = tab[22] + (size_t)j * 1024; const float* lam = tab[23] + (size_t)j * 1024;
    for (int q = 0; q < 8; ++q) { const int e = tid + 512 * q, i = e >> 6, j = e & 63;
        *(LAS bf16*)(lds + L_WRA + j * P1 + i * 2) = (bf16)(pk2(wra[e], 0.f) & 0xffffu); *(LAS bf16*)(lds + L_WIX + j * P1 + i * 2) = (bf16)(pk2(wix[e], 0.f) & 0xffffu); }
    if (tid < 128) ((LAS float*)(lds + L_CARRY))[tid] = 0.f;
    f32x4 braV[4], bixV[4], spV[4];
#pragma unroll
    for (int jt = 0; jt < 4; ++jt) { const int j0 = cbase + 16 * jt + 4 * fq; braV[jt] = *(const f32x4*)(bra + j0); bixV[jt] = *(const f32x4*)(bix + j0); const f32x4 lv = *(const f32x4*)(lam + j0);
#pragma unroll
        for (int r = 0; r < 4; ++r) { const float x = -lv[r]; spV[jt][r] = -8.0f * (x > 20.f ? x : log1pf(__expf(x))); } }
    const int cg8 = tid & 7, ts = tid >> 3, cch = cbase + cg8 * 8;
    float w[4][8], bias[8];
#pragma unroll
    for (int k = 0; k < 4; ++k) { const f32x4 wa = *(const f32x4*)(cw + k * 1024 + cch), wb = *(const f32x4*)(cw + k * 1024 + cch + 4);
        w[k][0] = wa.x; w[k][1] = wa.y; w[k][2] = wa.z; w[k][3] = wa.w; w[k][4] = wb.x; w[k][5] = wb.y; w[k][6] = wb.z; w[k][7] = wb.w; }
    { const f32x4 ba = *(const f32x4*)(cb + cch), bb = *(const f32x4*)(cb + cch + 4); bias[0] = ba.x; bias[1] = ba.y; bias[2] = ba.z; bias[3] = ba.w; bias[4] = bb.x; bias[5] = bb.y; bias[6] = bb.z; bias[7] = bb.w; }
    WG_BAR();
    for (int tile = 0; tile < 16; ++tile) {
        const int t0 = tile * 128; const size_t row0 = (size_t)b * SEQ + t0;
        unsigned char* wsl = ws; asm volatile("" : "+s"(wsl)); bf16* proj = (bf16*)(wsl + WS_BIG);
        {
            v4u raw[5];
#pragma unroll
            for (int s = 0; s < 5; ++s) { const int t = t0 + 2 * ts + s - 3; const v4u t_ = *(const GAS v4u*)(proj + ((size_t)b * SEQ + (t >= 0 ? t : 0)) * PL + OFF_XB + cch); const unsigned mk = (t >= 0) ? 0xffffffffu : 0u; raw[s] = (v4u){t_.x & mk, t_.y & mk, t_.z & mk, t_.w & mk}; }
#pragma unroll
            for (int s = 0; s < 2; ++s) { float val[8];
#pragma unroll
                for (int c = 0; c < 8; ++c) val[c] = bias[c];
#pragma unroll
                for (int k = 0; k < 4; ++k) { float f[8]; unpack8(raw[s + k], f);
#pragma unroll
                    for (int c = 0; c < 8; ++c) val[c] += w[k][c] * f[c]; }
                v4u o; o.x = pk2(val[0], val[1]); o.y = pk2(val[2], val[3]); o.z = pk2(val[4], val[5]); o.w = pk2(val[6], val[7]);
                *(LAS v4u*)(lds + L_XBM + (2 * ts + s) * P1 + cg8 * 16) = o; }
        }
        WG_BAR();
        {
            const int trow = 16 * wid + fr; f32x4 R[4], I[4];
#pragma unroll
            for (int i = 0; i < 4; ++i) { R[i] = (f32x4){0.f, 0.f, 0.f, 0.f}; I[i] = R[i]; }
#pragma unroll
            for (int kk = 0; kk < 2; ++kk) { const bf16x8 xf = LDF(L_XBM + trow * P1 + kk * 64 + fq * 16);
#pragma unroll
                for (int jt = 0; jt < 4; ++jt) { R[jt] = MFMA16(LDF(L_WRA + (16 * jt + fr) * P1 + kk * 64 + fq * 16), xf, R[jt]); I[jt] = MFMA16(LDF(L_WIX + (16 * jt + fr) * P1 + kk * 64 + fq * 16), xf, I[jt]); } }
#pragma unroll
            for (int jt = 0; jt < 4; ++jt) { const v2u xw = *(const LAS v2u*)(lds + L_XBM + trow * P1 + (16 * jt + 4 * fq) * 2); const float xb[4] = {bflo(xw.x), bfhi(xw.x), bflo(xw.y), bfhi(xw.y)}; f32x4 av, uv;
#pragma unroll
                for (int r = 0; r < 4; ++r) { const float rg = sigmoid_f(R[jt][r] + braV[jt][r]), ig = sigmoid_f(I[jt][r] + bixV[jt][r]); const float la = rg * spV[jt][r];
                    av[r] = __expf(la); uv[r] = __builtin_amdgcn_sqrtf(fmaxf(1.0f - __expf(2.0f * la), 0.f)) * ig * xb[r]; }
                *(LAS f32x4*)(lds + L_AS + trow * P2 + (16 * jt + 4 * fq) * 4) = av; *(LAS f32x4*)(lds + L_US + trow * P2 + (16 * jt + 4 * fq) * 4) = uv; }
        }
        WG_BAR();
        {
            const int c = lane; bf16 gv[16];
#pragma unroll
            for (int s = 0; s < 16; ++s) gv[s] = ((const GAS bf16*)proj)[(row0 + 16 * wid + s) * PL + OFF_GATE + cbase + c];
            float hl = 0.f, ap = 1.f;
#pragma unroll
            for (int s = 0; s < 16; ++s) { LAS float* pa = (LAS float*)(lds + L_AS + (16 * wid + s) * P2) + c; LAS float* pu = (LAS float*)(lds + L_US + (16 * wid + s) * P2) + c;
                const float av = *pa, uv = *pu; hl = av * hl + uv; ap *= av; *pu = hl; *pa = ap; }
            ((LAS float*)(lds + L_SEGA))[wid * 64 + c] = ap; ((LAS float*)(lds + L_SEGH))[wid * 64 + c] = hl;
            WG_BAR();
            float hin = ((LAS float*)(lds + L_CARRY))[(tile & 1) * 64 + c];
            for (int q = 0; q < wid; ++q) hin = ((LAS float*)(lds + L_SEGA))[q * 64 + c] * hin + ((LAS float*)(lds + L_SEGH))[q * 64 + c];
            if (wid == 7) ((LAS float*)(lds + L_CARRY))[((tile + 1) & 1) * 64 + c] = ap * hin + hl;
#pragma unroll
            for (int s = 0; s < 16; ++s) { const float hv = ((LAS float*)(lds + L_US + (16 * wid + s) * P2))[c] + ((LAS float*)(lds + L_AS + (16 * wid + s) * P2))[c] * hin;
                const float x = bf1(gv[s]); const float ge = x * sigmoid_f(1.5957691216057308f * (x + 0.044715f * x * x * x));
                if (!DRY) ((GAS bf16*)proj)[(row0 + 16 * wid + s) * PL + OFF_GATE + cbase + c] = (bf16)(pk2(ge * hv, 0.f) & 0xffffu); }
        }
        WG_BAR();
    }
}
__device__ __forceinline__ void ssd_norm_pass(bf16* proj, const float* gss, const float* nw, int gw, int NGW, int lane) {
    const f32x4 w0a = *(const f32x4*)(nw + lane * 8), w0b = *(const f32x4*)(nw + lane * 8 + 4), w1a = *(const f32x4*)(nw + 512 + lane * 8), w1b = *(const f32x4*)(nw + 512 + lane * 8 + 4);
    for (int m0 = gw; m0 < M; m0 += 4 * NGW) {
        f32x4 ga[4], gb[4], gc[4], gd[4]; v4u a[4], c[4];
#pragma unroll
        for (int q = 0; q < 4; ++q) { const int m = m0 + q * NGW; if (m < M) { const f32x4* gp = (const f32x4*)(gss + (size_t)m * 16); ga[q] = gp[0]; gb[q] = gp[1]; gc[q] = gp[2]; gd[q] = gp[3];
            const bf16* rp = proj + (size_t)m * PL; a[q] = *(const v4u*)(rp + lane * 8); c[q] = *(const v4u*)(rp + 512 + lane * 8); } }
#pragma unroll
        for (int q = 0; q < 4; ++q) { const int m = m0 + q * NGW; if (m < M) { bf16* rp = proj + (size_t)m * PL;
            const float r0 = __builtin_amdgcn_rsqf((((ga[q][0] + ga[q][1]) + (ga[q][2] + ga[q][3])) + ((gb[q][0] + gb[q][1]) + (gb[q][2] + gb[q][3]))) * (1.0f / 512.0f) + EPS), r1 = __builtin_amdgcn_rsqf((((gc[q][0] + gc[q][1]) + (gc[q][2] + gc[q][3])) + ((gd[q][0] + gd[q][1]) + (gd[q][2] + gd[q][3]))) * (1.0f / 512.0f) + EPS);
            float f[8]; v4u o;
            unpack8(a[q], f); o.x = pk2(f[0] * r0 * w0a.x, f[1] * r0 * w0a.y); o.y = pk2(f[2] * r0 * w0a.z, f[3] * r0 * w0a.w); o.z = pk2(f[4] * r0 * w0b.x, f[5] * r0 * w0b.y); o.w = pk2(f[6] * r0 * w0b.z, f[7] * r0 * w0b.w); *(v4u*)(rp + lane * 8) = o;
            unpack8(c[q], f); o.x = pk2(f[0] * r1 * w1a.x, f[1] * r1 * w1a.y); o.y = pk2(f[2] * r1 * w1a.z, f[3] * r1 * w1a.w); o.z = pk2(f[4] * r1 * w1b.x, f[5] * r1 * w1b.y); o.w = pk2(f[6] * r1 * w1b.z, f[7] * r1 * w1b.w); *(v4u*)(rp + 512 + lane * 8) = o; } }
    }
}
__device__ __forceinline__ void diff_combine_pass(bf16* O, const float* lq1, const float* lk1, const float* lq2, const float* lk2, const float* subln, float lambda_init, int gw, int NGW, int lane) {
    const float lamv = __expf(wave_sum(lq1[lane] * lk1[lane])) - __expf(wave_sum(lq2[lane] * lk2[lane])) + lambda_init;
    const int e0 = (lane & 15) * 8; const f32x4 wa = *(const f32x4*)(subln + e0), wb = *(const f32x4*)(subln + e0 + 4); const float os = 1.0f - lambda_init;
    for (int m0 = gw; m0 < M; m0 += 4 * NGW) {
        v4u a[4][2], c[4][2];
#pragma unroll
        for (int q = 0; q < 4; ++q) { const int m = m0 + q * NGW; if (m < M) { const bf16* rp = O + (size_t)m * 2048;
#pragma unroll
            for (int hf = 0; hf < 2; ++hf) { a[q][hf] = *(const v4u*)(rp + hf * 512 + lane * 8); c[q][hf] = *(const v4u*)(rp + 1024 + hf * 512 + lane * 8); } } }
#pragma unroll
        for (int q = 0; q < 4; ++q) { const int m = m0 + q * NGW; if (m < M) { bf16* rp = O + (size_t)m * 2048;
#pragma unroll
            for (int hf = 0; hf < 2; ++hf) { const int col = hf * 512 + lane * 8; float f1[8], f2[8], o[8]; unpack8(a[q][hf], f1); unpack8(c[q][hf], f2); float ss = 0.f;
#pragma unroll
                for (int i = 0; i < 8; ++i) { o[i] = f1[i] - lamv * f2[i]; ss += o[i] * o[i]; }
                ss += __shfl_xor(ss, 1); ss += __shfl_xor(ss, 2); ss += __shfl_xor(ss, 4); ss += __shfl_xor(ss, 8);
                const float rs = os * __builtin_amdgcn_rsqf(ss * (1.0f / 128.0f) + EPS);
                v4u w; w.x = pk2(o[0] * rs * wa.x, o[1] * rs * wa.y); w.y = pk2(o[2] * rs * wa.z, o[3] * rs * wa.w); w.z = pk2(o[4] * rs * wb.x, o[5] * rs * wb.y); w.w = pk2(o[6] * rs * wb.z, o[7] * rs * wb.w);
                *(v4u*)(rp + col) = w; } } }
    }
}
__device__ __forceinline__ void final_norm_pass(float* out, const bf16* HB, const unsigned* LO, const float* rowss, const float* nw, int gw, int NGW, int lane) {
    const f32x4 wa = *(const f32x4*)(nw + lane * 8), wb = *(const f32x4*)(nw + lane * 8 + 4), wc = *(const f32x4*)(nw + 512 + lane * 8), wd = *(const f32x4*)(nw + 512 + lane * 8 + 4);
    for (int m0 = gw; m0 < M; m0 += 4 * NGW) {
        v4u a[4], c[4]; unsigned la[4], lc[4]; float rs[4];
#pragma unroll
        for (int q = 0; q < 4; ++q) { const int m = m0 + q * NGW; if (m < M) { const bf16* hp = HB + (size_t)m * 1024; a[q] = *(const v4u*)(hp + lane * 8); c[q] = *(const v4u*)(hp + 512 + lane * 8);
#if RESID_LO
            const unsigned* lp = LO + (size_t)m * 128; la[q] = lp[lane]; lc[q] = lp[64 + lane];
#else
            la[q] = 0u; lc[q] = 0u;
#endif
            rs[q] = pg8::rstd_of(rowss, m); } }
#pragma unroll
        for (int q = 0; q < 4; ++q) { const int m = m0 + q * NGW; if (m < M) { float* op = out + (size_t)m * 1024; float f[8]; const float r = rs[q];
            pg8::EpiResid::dec8(a[q], la[q], f); __builtin_nontemporal_store((f32x4){f[0] * r * wa.x, f[1] * r * wa.y, f[2] * r * wa.z, f[3] * r * wa.w}, (f32x4*)(op + lane * 8)); __builtin_nontemporal_store((f32x4){f[4] * r * wb.x, f[5] * r * wb.y, f[6] * r * wb.z, f[7] * r * wb.w}, (f32x4*)(op + lane * 8 + 4));
            pg8::EpiResid::dec8(c[q], lc[q], f); __builtin_nontemporal_store((f32x4){f[0] * r * wc.x, f[1] * r * wc.y, f[2] * r * wc.z, f[3] * r * wc.w}, (f32x4*)(op + 512 + lane * 8)); __builtin_nontemporal_store((f32x4){f[4] * r * wd.x, f[5] * r * wd.y, f[6] * r * wd.z, f[7] * r * wd.w}, (f32x4*)(op + 512 + lane * 8 + 4)); } }
    }
}
typedef GAS unsigned gu32;
constexpr size_t WS_CTL = 0, CTL_ZERO_BYTES = 64 * 1024;
constexpr int XB_MISC_OFF = LDS_BYTES - 64;
#define XB_TMO      128
#define XB_XCNT(j)  (256  + 64 * (j))
#define XB_XSUB(j)  (1280 + 64 * (j))
#define XB_XGEN(j)  (2304 + 64 * (j))
#define XB_TOP      3328
#define XB_TOPGEN   3392
#define XCD_BAR_WORDS 3456
#define XB_SPIN_CAP (1u << 18)

__device__ __forceinline__ unsigned xb_ld(unsigned* p)              { return __hip_atomic_load(p, __ATOMIC_RELAXED, __HIP_MEMORY_SCOPE_AGENT); }
__device__ __forceinline__ unsigned xb_add(unsigned* p, unsigned v) { return __hip_atomic_fetch_add(p, v, __ATOMIC_RELAXED, __HIP_MEMORY_SCOPE_AGENT); }
__device__ __forceinline__ unsigned xb_xcc_id() { return (unsigned)__builtin_amdgcn_s_getreg((3 << 11) | 20) & 0xFu; }
#define XB_SPIN(cond, bar) do { unsigned _sp = 0; while (cond) { __builtin_amdgcn_s_sleep(1); \
    if ((++_sp & 255u) == 0u) { if (xb_ld(&(bar)[XB_TMO])) break; if (_sp > XB_SPIN_CAP) { atomicAdd(&(bar)[XB_TMO], 1u); break; } } } } while (0)

struct XcdBarrier {
    unsigned* bar; unsigned x;
    volatile LAS unsigned* st;
};

__device__ __forceinline__ XcdBarrier xcd_barrier_post(unsigned* bar, volatile LAS unsigned* st) {
    XcdBarrier b; b.bar = bar; b.x = xb_xcc_id(); b.st = st;
    if (threadIdx.x == 0) (void)xb_add(&bar[XB_XCNT(b.x)], 1u);
    return b;
}
__device__ __forceinline__ void xcd_barrier_complete(unsigned* bar, unsigned x, unsigned& nloc, unsigned& nx) {
    const unsigned G = gridDim.x * gridDim.y * gridDim.z;
    unsigned sum, cnt, mine, sp = 0u;
    for (;;) {
        sum = 0u; cnt = 0u; mine = 0u;
#pragma unroll
        for (unsigned j = 0; j < 16; ++j) { const unsigned c = xb_ld(&bar[XB_XCNT(j)]); sum += c; cnt += (c > 0u) ? 1u : 0u; mine = (j == x) ? c : mine; }
        if (sum == G) break;
        __builtin_amdgcn_s_sleep(1);
        if ((++sp & 255u) == 0u) { if (xb_ld(&bar[XB_TMO])) break; if (sp > XB_SPIN_CAP) { atomicAdd(&bar[XB_TMO], 1u); break; } }
    }
    nloc = mine > 0u ? mine : 1u; nx = cnt > 0u ? cnt : 1u;
}

__device__ __forceinline__ void xcd_barrier(const XcdBarrier& b) {
    asm volatile("s_waitcnt vmcnt(0)" ::: "memory");
    __syncthreads();
    if (threadIdx.x == 0) {
        unsigned* bar = b.bar;
        __builtin_amdgcn_s_waitcnt(0);
        unsigned nloc = b.st[0], nx = b.st[1];
        if (nloc == 0u) { xcd_barrier_complete(bar, b.x, nloc, nx); b.st[0] = nloc; b.st[1] = nx; }
        const unsigned old = xb_add(&bar[XB_XSUB(b.x)], 1u);
        const unsigned gen = old / nloc;
        if (old + 1u == (gen + 1u) * nloc) {
            __builtin_amdgcn_fence(__ATOMIC_RELEASE, "agent");
            asm volatile("s_waitcnt vmcnt(0)" ::: "memory");
            const unsigned og = xb_add(&bar[XB_TOP], 1u);
            const unsigned tg = og / nx;
            if (og + 1u == (tg + 1u) * nx) xb_add(&bar[XB_TOPGEN], 1u);
            else XB_SPIN(xb_ld(&bar[XB_TOPGEN]) == tg, bar);
            __builtin_amdgcn_fence(__ATOMIC_ACQUIRE, "agent");
            xb_add(&bar[XB_XGEN(b.x)], 1u);
            asm volatile("s_waitcnt vmcnt(0)" ::: "memory");
        } else {
            XB_SPIN(xb_ld(&bar[XB_XGEN(b.x)]) == gen, bar);
            __builtin_amdgcn_fence(__ATOMIC_ACQUIRE, "agent");
            asm volatile("s_waitcnt vmcnt(0)" ::: "memory");
        }
    }
    __syncthreads();
}
__global__ void __launch_bounds__(NWAVES * 64, 2) mega_fwd(Args a) {
    extern __shared__ __attribute__((aligned(16))) unsigned char lds_raw[];
    LAS unsigned char* lds = (LAS unsigned char*)lds_raw;
    cg::grid_group grid = cg::this_grid();
    if (threadIdx.x < 16) ((LAS unsigned*)(lds + XB_MISC_OFF))[threadIdx.x] = 0u;
    __syncthreads();
    { XcdBarrier b0 = xcd_barrier_post((unsigned*)(a.ws + WS_CTL), (volatile LAS unsigned*)(lds + XB_MISC_OFF)); (void)b0; }
#define GSYNC() do { XcdBarrier xb_; xb_.bar = (unsigned*)(a.ws + WS_CTL); xb_.x = xb_xcc_id(); xb_.st = (volatile LAS unsigned*)(lds + XB_MISC_OFF); xcd_barrier(xb_); } while (0)
#define PHASE_ENV() \
    int tidL = threadIdx.x; asm volatile("" : "+v"(tidL)); const int tid = tidL, lane = tid & 63, wave = __builtin_amdgcn_readfirstlane(tid >> 6); \
    int G = gridDim.x, bx = blockIdx.x; asm volatile("" : "+s"(G), "+s"(bx)); const int vcu = (G % 8 == 0) ? (bx % 8) * (G / 8) + bx / 8 : bx; \
    const int gw = vcu * NWAVES + wave, NGW = G * NWAVES, gtid = bx * (NWAVES * 64) + tid, NGT = G * NWAVES * 64; \
    unsigned char* ws = a.ws; asm volatile("" : "+s"(ws)); \
    float* rowss = (float*)(ws + WS_ROWSS); float* gssb = (float*)(ws + WS_GSS); const float* rope = (const float*)(ws + WS_ROPE); float* dtb = (float*)(ws + WS_DT); \
    bf16* HB = (bf16*)(ws + WS_HB); bf16* BIG = (bf16*)(ws + WS_BIG); \
    bf16* GU1 = (bf16*)(ws + WS_WB + WB_GU1); bf16* D1 = (bf16*)(ws + WS_WB + WB_D1); bf16* GU2 = (bf16*)(ws + WS_WB + WB_GU2); bf16* D2 = (bf16*)(ws + WS_WB + WB_D2); \
    bf16* MI = (bf16*)(ws + WS_WB + WB_MI); bf16* MO = (bf16*)(ws + WS_WB + WB_MO); \
    (void)gw; (void)NGW; (void)gtid; (void)NGT; (void)rowss; (void)gssb; (void)rope; (void)dtb; (void)HB; (void)BIG; (void)GU1; (void)D1; (void)GU2; (void)D2; (void)MI; (void)MO; (void)lane; (void)vcu;
    grid.sync();
    { PHASE_ENV()
    prologue(a, lds, gw, NGW, wave, lane, gtid, NGT); }
    GSYNC();
    for (int lo = 0; lo < DEPTH; ++lo) {
#ifdef DUP_MIX
      for (int opx = (lo == 0) ? 1 : 0; opx < 10; ++opx) { const int op = opx < 5 ? opx : opx - 1; bool dry = (opx == 4);
        if (dry && (lo & 1)) continue;
#else
      for (int op = (lo == 0) ? 1 : 0; op < 10; ++op) { const bool dry = false;
#endif
        int l = lo; asm volatile("" : "+s"(l));
        const int j = l >> 1; const bool even = (l & 1) == 0;
        switch (op) {
        case 0: { PHASE_ENV() const float* const* tab = (const float* const*)(ws + WS_TAB);
            convert_layer(FromTab{tab}, ws, l, lds, gw, NGW, wave, lane); } break;
        case 1: case 8: { PHASE_ENV() const int hf = (op == 8);
            pg8::Gemm g{HB, hf ? GU2 : GU1, M, 2 * DFF, 1024, 1024}; pg8::StaticOrder S; S.init(M, 2 * DFF, G, bx);
            pg8::EpiSwiglu E{BIG, pg8::build_rstd(lds + 131072, rowss + (size_t)((3 * l + 2 * hf) & 1) * M * 16, S)};
#ifdef DUP_GU
            for (int rp = 0; rp < 2; ++rp)
#endif
            pg8::gemm_phase<pg8::EpiSwiglu, pg8::StaticOrder, true, true, 1024, 1024>(lds, g, S, E); } break;
        case 2: case 9: { PHASE_ENV() const float* const* tab = (const float* const*)(ws + WS_TAB);
            pg8::Gemm g{BIG, (op == 2) ? D1 : D2, M, 1024, DFF, DFF}; pg8::StaticOrder S; S.init(M, 1024, G, bx);
            pg8::EpiResid E{HB, (unsigned*)(ws + WS_LO), rowss + (size_t)(((op == 2) ? 3 * l + 1 : 3 * l + 3) & 1) * M * 16, 0.5f};
#ifdef DUP_RESID
            for (int rp = 0; rp < 2; ++rp) { E.scale = rp ? 0.5f : 0.f;
#endif
            pg8::gemm_phase<pg8::EpiResid, pg8::StaticOrder, true, true, DFF, DFF>(lds, g, S, E);
#ifdef DUP_RESID
            }
#endif
            } break;
        case 3: { PHASE_ENV()
            if (even) { pg8::Gemm g{HB, MI, M, 4864, 1024, 1024}; pg8::StaticOrder S; S.init(M, 4864, G, bx);
                pg8::EpiProj E{BIG, dtb, pg8::build_rstd(lds + 131072, rowss + (size_t)((3 * l + 1) & 1) * M * 16, S)};
                pg8::gemm_phase<pg8::EpiProj, pg8::StaticOrder, true, true, 1024, 1024>(lds, g, S, E); }
            else { pg8::Gemm g{HB, MI, M, 3072, 1024, 1024}; pg8::StaticOrder S; S.init(M, 3072, G, bx);
                pg8::EpiQkv E{BIG, pg8::build_rstd(lds + 131072, rowss + (size_t)((3 * l + 1) & 1) * M * 16, S), rope, attn_body::C2};
                pg8::gemm_phase<pg8::EpiQkv, pg8::StaticOrder, true, true, 1024, 1024>(lds, g, S, E); } } break;
        case 4: { if (!even) continue;
            PHASE_ENV() const float* const* tab = (const float* const*)(ws + WS_TAB);
            bc_preconv_pass(BIG, tab[11] + (size_t)j * 4 * 1536, tab[12] + (size_t)j * 1536, gtid, NGT); } break;
        case 5: {
            if (even) { int G = gridDim.x, bx = blockIdx.x; asm volatile("" : "+s"(G), "+s"(bx)); const int vcu = (G % 8 == 0) ? (bx % 8) * (G / 8) + bx / 8 : bx;
                for (int u = vcu; u < 256; u += G) { const int b = u >> 4, h = u & 15; unsigned char* wsu = a.ws; asm volatile("" : "+s"(wsu));
#if defined(DUP_SSD) || defined(DUP_LRU)
                    for (int rp = 0; rp < 2; ++rp) { int dr = (rp == 0); asm volatile("" : "+s"(dr));
#ifndef DUP_LRU
                    ssd_unit(lds, b, h, j, wsu, dr != 0);
#else
                    if (!dr) ssd_unit(lds, b, h, j, wsu, false);
#endif
#ifndef DUP_SSD
                    lru_unit(lds, b, h, j, wsu, dr != 0);
#else
                    if (!dr) lru_unit(lds, b, h, j, wsu, false);
#endif
                    }
#else
                    ssd_unit(lds, b, h, j, wsu, dry);
                    lru_unit(lds, b, h, j, wsu, dry);
#endif
                } }
            else {
#ifndef NO_ATTN
                int G = gridDim.x, bx = blockIdx.x; asm volatile("" : "+s"(G), "+s"(bx)); const int vcu = (G % 8 == 0) ? (bx % 8) * (G / 8) + bx / 8 : bx;
                unsigned char* wsu = a.ws; asm volatile("" : "+s"(wsu)); bf16* BIG = (bf16*)(wsu + WS_BIG);
                const attn_body::AttnTensors AT{(const attn_body::bf16*)BIG, (const attn_body::bf16*)(BIG + (size_t)M * 1024), (const attn_body::bf16*)(BIG + (size_t)2 * M * 1024), (attn_body::bf16*)(BIG + (size_t)3 * M * 1024)};
                attn_body::attn_phase<8>((char*)lds_raw, AT, vcu, G);
#ifdef DUP_ATTN
                attn_body::attn_phase<8>((char*)lds_raw, AT, vcu, G);
#endif
#endif
            } } break;
        case 6: { PHASE_ENV() const float* const* tab = (const float* const*)(ws + WS_TAB);
            if (even) ssd_norm_pass(BIG, gssb, tab[16] + (size_t)j * 1024, gw, NGW, lane);
            else diff_combine_pass(BIG + (size_t)3 * M * 1024, tab[26] + j * 64, tab[27] + j * 64, tab[28] + j * 64, tab[29] + j * 64, tab[30] + j * 128, 0.8f - 0.6f * expf(-0.3f * (float)l), gw, NGW, lane); } break;
        default: { PHASE_ENV() const float* const* tab = (const float* const*)(ws + WS_TAB);
            pg8::StaticOrder S; S.init(M, 1024, G, bx);
            pg8::EpiResid E{HB, (unsigned*)(ws + WS_LO), rowss + (size_t)((3 * l + 2) & 1) * M * 16, 1.0f};
            if (even) { pg8::Gemm g{BIG, MO, M, 1024, 2048, PL}; pg8::gemm_phase<pg8::EpiResid, pg8::StaticOrder, true, true, 2048, PL>(lds, g, S, E); }
            else { pg8::Gemm g{BIG + (size_t)3 * M * 1024, MO, M, 1024, 1024, 2048}; pg8::gemm_phase<pg8::EpiResid, pg8::StaticOrder, true, true, 1024, 2048>(lds, g, S, E); } } break;
        }
        GSYNC();
#ifdef DUP_SYNC
        GSYNC(); GSYNC();
#endif
      }
    }
    { PHASE_ENV()
    const float* const* tab = (const float* const*)(ws + WS_TAB);
    final_norm_pass((float*)tab[33], HB, (const unsigned*)(ws + WS_LO), rowss, tab[32], gw, NGW, lane); }
}

extern "C" void kernel_launch(void* const* d_in, const int* in_sizes, int n_in, void* d_out, int out_size, void* d_ws, size_t ws_size, hipStream_t stream) {
    static int grid = 0;
    if (grid == 0) {
        if (n_in != 33 || out_size != M * 1024 || ws_size < WS_END) { fprintf(stderr, "kernel_launch: unexpected problem (n_in %d, out %d, ws %zu)\n", n_in, out_size, ws_size); grid = -1; return; }
        int dev = 0, cus = 0, per_cu = 0;
        if (hipGetDevice(&dev) != hipSuccess || hipDeviceGetAttribute(&cus, hipDeviceAttributeMultiprocessorCount, dev) != hipSuccess) { grid = -1; return; }
        if (hipFuncSetAttribute((const void*)mega_fwd, hipFuncAttributeMaxDynamicSharedMemorySize, LDS_BYTES) != hipSuccess) { fprintf(stderr, "kernel_launch: hipFuncSetAttribute failed\n"); grid = -1; return; }
        if (hipOccupancyMaxActiveBlocksPerMultiprocessor(&per_cu, (const void*)mega_fwd, NWAVES * 64, LDS_BYTES) != hipSuccess || per_cu < 1) { fprintf(stderr, "kernel_launch: occupancy query says %d\n", per_cu); per_cu = 1; }
        (void)hipGetLastError();
        grid = cus;
    }
    if (grid < 0) return;
    Args a{};
    for (int i = 0; i < 33; ++i) a.in[i] = (const float*)d_in[i];
    a.out = (float*)d_out; a.ws = (unsigned char*)d_ws;
    if (hipMemsetAsync((char*)d_ws + WS_CTL, 0, CTL_ZERO_BYTES, stream) != hipSuccess) { fprintf(stderr, "kernel_launch: memset failed\n"); return; }
    void* args[] = {&a};
    hipError_t e = hipLaunchCooperativeKernel((const void*)mega_fwd, dim3(grid), dim3(NWAVES * 64), args, LDS_BYTES, stream);
    if (e != hipSuccess) fprintf(stderr, "kernel_launch: cooperative launch failed: %s (grid %d)\n", hipGetErrorString(e), grid);
}
```
